# Optimizing an MI355X kernel written in HIP

```python
import jax
import jax.numpy as jnp
from jax import lax
import numpy as np

D_MODEL = 1024
BATCH = 4
SEQ = 4096
DEPTH = 4

D_MIX = D_MODEL
CONV_CH = D_MIX // 4
CONV_K = 31
CONV_IN = 2 * CONV_CH
MLA_NOPE = 64
MLA_ROPE = 32
MLA_V = 64
MLA_QK = MLA_NOPE + MLA_ROPE
MLA_OUT = D_MIX // 2
MLA_HEADS = MLA_OUT // MLA_V
MLA_Q_LORA = D_MODEL // 4
MLA_KV_LORA = D_MODEL // 8
MLA_IN = MLA_Q_LORA + MLA_KV_LORA + MLA_ROPE
ROPE_THETA = 10000.0
Q_BLOCK = 128
RWKV_HEAD = 64
RWKV_CH = D_MIX - CONV_CH - MLA_OUT
RWKV_HEADS = RWKV_CH // RWKV_HEAD
DECAY_LORA = 64
ICLR_LORA = 64
GATE_LORA = 128
RWKV_IN = 3 * RWKV_CH + DECAY_LORA + ICLR_LORA + GATE_LORA
IN_COLS = CONV_IN + MLA_IN + RWKV_IN
D_FF = ((8 * D_MODEL // 3 + 127) // 128) * 128
N_EXPERTS = 8
TOP_K = 2
MOE_FF = 7 * D_MODEL // 2
MOE_BLOCK = 256
N_DENSE = (DEPTH + 1) // 2
N_MOE = DEPTH // 2
N_MOD = 6
RMS_EPS = 1e-6
LN_EPS = 1e-5
RWKV_GN_EPS = 64e-5

kernel_name = 'hybrid_parallel_group_block'


def _rms_norm(x, gain):
    xf = x.astype(jnp.float32)
    y = xf * lax.rsqrt(jnp.mean(xf * xf, axis=-1, keepdims=True) + RMS_EPS)
    return (y * gain.astype(jnp.float32)).astype(x.dtype)


def _layer_norm(x, gain, bias, eps):
    xf = x.astype(jnp.float32)
    xc = xf - jnp.mean(xf, axis=-1, keepdims=True)
    var = jnp.mean(xc * xc, axis=-1, keepdims=True)
    y = xc * lax.rsqrt(var + eps) * gain.astype(jnp.float32) + bias.astype(jnp.float32)
    return y.astype(x.dtype)


def _rope(x, cos, sin):
    xf = x.astype(jnp.float32)
    x1, x2 = jnp.split(xf, 2, axis=-1)
    y = jnp.concatenate([x1 * cos - x2 * sin, x1 * sin + x2 * cos], axis=-1)
    return y.astype(x.dtype)


def _conformer_conv(u, conv_w, conv_b, ln_g, ln_b):
    a, g = jnp.split(u, 2, axis=-1)
    z = a * jax.nn.sigmoid(g)
    z = lax.conv_general_dilated(z, conv_w[:, None, :].astype(z.dtype), window_strides=(1,), padding=[(CONV_K - 1, 0)], dimension_numbers=('NWC', 'WIO', 'NWC'), feature_group_count=CONV_CH)
    z = z + conv_b
    return jax.nn.silu(_layer_norm(z, ln_g, ln_b, LN_EPS))


def _causal_attention(q, k, v):
    b, t, h, dq = q.shape
    nb = t // Q_BLOCK
    scale = float(dq) ** -0.5
    q_blocks = q.reshape(b, nb, Q_BLOCK, h, dq).swapaxes(0, 1)
    k_pos = jnp.arange(t)

    def block(args):
        q_blk, start = args
        s = jnp.einsum('bqhd,bkhd->bhqk', q_blk, k, preferred_element_type=jnp.float32) * scale
        q_pos = start + jnp.arange(Q_BLOCK)
        s = jnp.where(k_pos[None, :] <= q_pos[:, None], s, -jnp.inf)
        p = jax.nn.softmax(s, axis=-1).astype(v.dtype)
        return jnp.einsum('bhqk,bkhd->bqhd', p, v)

    o = lax.map(block, (q_blocks, jnp.arange(nb) * Q_BLOCK))
    return o.swapaxes(0, 1).reshape(b, t, h, v.shape[-1])


def _mla(u, cos, sin, q_norm_g, w_uq, kv_norm_g, w_ukv, qk_q_g, qk_k_g):
    b, t, _ = u.shape
    c_q, c_kv, k_rope = jnp.split(u, [MLA_Q_LORA, MLA_Q_LORA + MLA_KV_LORA], axis=-1)
    q = (_rms_norm(c_q, q_norm_g) @ w_uq).reshape(b, t, MLA_HEADS, MLA_QK)
    kv = (_rms_norm(c_kv, kv_norm_g) @ w_ukv).reshape(b, t, MLA_HEADS, MLA_NOPE + MLA_V)
    k_nope, v = jnp.split(kv, [MLA_NOPE], axis=-1)
    k_rope = jnp.broadcast_to(k_rope[:, :, None, :], (b, t, MLA_HEADS, MLA_ROPE))
    k = jnp.concatenate([k_nope, k_rope], axis=-1)
    q = _rms_norm(q, qk_q_g)
    k = _rms_norm(k, qk_k_g)
    q = jnp.concatenate([q[..., :MLA_NOPE], _rope(q[..., MLA_NOPE:], cos, sin)], axis=-1)
    k = jnp.concatenate([k[..., :MLA_NOPE], _rope(k[..., MLA_NOPE:], cos, sin)], axis=-1)
    o = _causal_attention(q, k, v)
    return o.reshape(b, t, MLA_OUT)


def _wkv7_scan(r, w, k, v, a, b):
    bsz = r.shape[0]

    def step(s, inp):
        r_t, w_t, k_t, v_t, a_t, b_t = inp
        sa = jnp.einsum('bhij,bhj->bhi', s, a_t)
        s = s * w_t[:, :, None, :] + sa[..., None] * b_t[:, :, None, :] + v_t[..., None] * k_t[:, :, None, :]
        return s, jnp.einsum('bhij,bhj->bhi', s, r_t)

    s0 = jnp.zeros((bsz, RWKV_HEADS, RWKV_HEAD, RWKV_HEAD), jnp.float32)
    xs = [z.swapaxes(0, 1) for z in (r, w, k, v, a, b)]
    _, y = lax.scan(step, s0, xs)
    return y.swapaxes(0, 1)


def _rwkv7_mix(u, mu, w0, w_up, a0, a_up, g_up, k_k, k_a, r_k, ln_g, ln_b):
    dt = u.dtype
    bsz, t, _ = u.shape
    f32 = jnp.float32
    uf = u.astype(f32)
    prev = jnp.pad(uf, ((0, 0), (1, 0), (0, 0)))[:, :-1]
    uf = uf + (prev - uf) * mu.astype(f32)
    s1 = RWKV_CH
    s3 = 3 * RWKV_CH
    r, k, v, wd, ad, gd = jnp.split(uf, [s1, 2 * s1, s3, s3 + DECAY_LORA, s3 + DECAY_LORA + ICLR_LORA], axis=-1)
    w_log = -jax.nn.softplus(-(w0.astype(f32) + jnp.tanh(wd) @ w_up.astype(f32))) - 0.5
    decay = jnp.exp(-jnp.exp(w_log))
    a = jax.nn.sigmoid(a0.astype(f32) + ad @ a_up.astype(f32))
    g = jax.nn.sigmoid(gd) @ g_up.astype(f32)
    hs = (bsz, t, RWKV_HEADS, RWKV_HEAD)
    kk = (k * k_k.astype(f32)).reshape(hs)
    kk = kk / jnp.maximum(jnp.linalg.norm(kk, axis=-1, keepdims=True), 1e-12)
    k = k * (1.0 + (a - 1.0) * k_a.astype(f32))
    r, k, v, decay, a = [z.reshape(hs) for z in (r, k, v, decay, a)]
    y = _wkv7_scan(r, decay, k, v, -kk, kk * a)
    y = _layer_norm(y, ln_g.reshape(RWKV_HEADS, RWKV_HEAD), ln_b.reshape(RWKV_HEADS, RWKV_HEAD), RWKV_GN_EPS)
    y = y + jnp.sum(r * k * r_k.astype(f32), axis=-1, keepdims=True) * v
    return (y.reshape(bsz, t, RWKV_CH) * g).astype(dt)


def _swiglu(h, w_gate, w_up, w_down):
    return (jax.nn.silu(h @ w_gate) * (h @ w_up)) @ w_down


def _moe_swiglu(h, router, w_gate, w_up, w_down):
    b, t, d = h.shape
    xf = h.reshape(-1, d)
    n_tok = xf.shape[0]
    probs = jax.nn.softmax((xf @ router).astype(jnp.float32), axis=-1)
    top_p, top_e = lax.top_k(probs, TOP_K)
    top_p = top_p / jnp.sum(top_p, axis=-1, keepdims=True)
    flat_e = top_e.reshape(-1)
    flat_p = top_p.reshape(-1)
    n_assign = n_tok * TOP_K
    order = jnp.argsort(flat_e)
    sorted_e = flat_e[order]
    counts = jnp.bincount(flat_e, length=N_EXPERTS)
    starts = jnp.cumsum(counts) - counts
    padded = (counts + MOE_BLOCK - 1) // MOE_BLOCK * MOE_BLOCK
    pad_ends = jnp.cumsum(padded)
    pad_starts = pad_ends - padded
    dest = pad_starts[sorted_e] + jnp.arange(n_assign) - starts[sorted_e]
    cap = -(-n_assign // MOE_BLOCK) * MOE_BLOCK + N_EXPERTS * MOE_BLOCK
    n_blk = cap // MOE_BLOCK
    slot_tok = jnp.zeros((cap,), jnp.int32).at[dest].set((order // TOP_K).astype(jnp.int32))
    slot_w = jnp.zeros((cap,), jnp.float32).at[dest].set(flat_p[order])
    blk_e = jnp.minimum(jnp.searchsorted(pad_ends, jnp.arange(n_blk) * MOE_BLOCK, side='right'), N_EXPERTS - 1)
    xs = xf[slot_tok].reshape(n_blk, MOE_BLOCK, d)

    def expert_block(args):
        xb, e = args
        return _swiglu(xb, w_gate[e], w_up[e], w_down[e])

    ys = lax.map(expert_block, (xs, blk_e)).reshape(cap, d)
    out = jnp.zeros((n_tok, d), jnp.float32).at[slot_tok].add(ys.astype(jnp.float32) * slot_w[:, None])
    return out.astype(h.dtype).reshape(b, t, d)


def setup_inputs(seed: int = 0) -> dict:
    key = jax.random.key(seed)
    ks = iter(jax.random.split(key, 48))
    L = DEPTH

    def nrm(shape, scale):
        return jax.random.normal(next(ks), shape, jnp.float32) * scale

    def gain(shape):
        return 1.0 + nrm(shape, 0.05)

    x = nrm((BATCH, SEQ, D_MODEL), 1.0)
    c = nrm((BATCH, D_MODEL), 1.0)
    positions = jnp.arange(SEQ, dtype=jnp.int32)[None, :] + jax.random.randint(next(ks), (BATCH, 1), 0, SEQ, dtype=jnp.int32)
    return {
        'x': x,
        'c': c,
        'positions': positions,
        'ada_w': nrm((D_MODEL, N_MOD * D_MODEL), 0.5 * D_MODEL ** -0.5),
        'ada_b': nrm((N_MOD * D_MODEL,), 0.02),
        'ada_layer_bias': nrm((L, N_MOD * D_MODEL), 0.02),
        'norm1_g': gain((L, D_MODEL)),
        'norm2_g': gain((L, D_MODEL)),
        'w_in': nrm((L, D_MODEL, IN_COLS), D_MODEL ** -0.5),
        'w_out': nrm((L, D_MIX, D_MODEL), D_MIX ** -0.5),
        'conv_w': nrm((L, CONV_K, CONV_CH), CONV_K ** -0.5),
        'conv_b': nrm((L, CONV_CH), 0.02),
        'conv_ln_g': gain((L, CONV_CH)),
        'conv_ln_b': nrm((L, CONV_CH), 0.02),
        'mla_q_norm_g': gain((L, MLA_Q_LORA)),
        'mla_w_uq': nrm((L, MLA_Q_LORA, MLA_HEADS * MLA_QK), MLA_Q_LORA ** -0.5),
        'mla_kv_norm_g': gain((L, MLA_KV_LORA)),
        'mla_w_ukv': nrm((L, MLA_KV_LORA, MLA_HEADS * (MLA_NOPE + MLA_V)), MLA_KV_LORA ** -0.5),
        'qk_norm_q': gain((L, MLA_QK)),
        'qk_norm_k': gain((L, MLA_QK)),
        'rwkv_mu': jax.random.uniform(next(ks), (L, RWKV_IN), jnp.float32, 0.0, 1.0),
        'rwkv_w0': nrm((L, RWKV_CH), 0.5) - 0.5,
        'rwkv_w_up': nrm((L, DECAY_LORA, RWKV_CH), 0.1),
        'rwkv_a0': nrm((L, RWKV_CH), 0.5),
        'rwkv_a_up': nrm((L, ICLR_LORA, RWKV_CH), 0.5 * ICLR_LORA ** -0.5),
        'rwkv_g_up': nrm((L, GATE_LORA, RWKV_CH), GATE_LORA ** -0.5),
        'rwkv_k_k': 0.85 + nrm((L, RWKV_CH), 0.05),
        'rwkv_k_a': gain((L, RWKV_CH)),
        'rwkv_r_k': nrm((L, RWKV_HEADS, RWKV_HEAD), 0.1),
        'rwkv_ln_g': gain((L, RWKV_CH)),
        'rwkv_ln_b': nrm((L, RWKV_CH), 0.02),
        'ffn_w_gate': nrm((N_DENSE, D_MODEL, D_FF), D_MODEL ** -0.5),
        'ffn_w_up': nrm((N_DENSE, D_MODEL, D_FF), D_MODEL ** -0.5),
        'ffn_w_down': nrm((N_DENSE, D_FF, D_MODEL), D_FF ** -0.5),
        'moe_router': nrm((N_MOE, D_MODEL, N_EXPERTS), D_MODEL ** -0.5),
        'moe_w_gate': nrm((N_MOE, N_EXPERTS, D_MODEL, MOE_FF), D_MODEL ** -0.5),
        'moe_w_up': nrm((N_MOE, N_EXPERTS, D_MODEL, MOE_FF), D_MODEL ** -0.5),
        'moe_w_down': nrm((N_MOE, N_EXPERTS, MOE_FF, D_MODEL), MOE_FF ** -0.5),
    }


def reference(x, c, positions, ada_w, ada_b, ada_layer_bias, norm1_g, norm2_g, w_in, w_out, conv_w, conv_b, conv_ln_g, conv_ln_b, mla_q_norm_g, mla_w_uq, mla_kv_norm_g, mla_w_ukv, qk_norm_q, qk_norm_k, rwkv_mu, rwkv_w0, rwkv_w_up, rwkv_a0, rwkv_a_up, rwkv_g_up, rwkv_k_k, rwkv_k_a, rwkv_r_k, rwkv_ln_g, rwkv_ln_b, ffn_w_gate, ffn_w_up, ffn_w_down, moe_router, moe_w_gate, moe_w_up, moe_w_down):
    inv_freq = ROPE_THETA ** (-jnp.arange(0, MLA_ROPE, 2, dtype=jnp.float32) / MLA_ROPE)
    ang = positions.astype(jnp.float32)[..., None] * inv_freq
    cos = jnp.cos(ang)[:, :, None, :]
    sin = jnp.sin(ang)[:, :, None, :]
    cond = jax.nn.silu(c) @ ada_w + ada_b
    for layer in range(DEPTH):
        mod = cond + ada_layer_bias[layer]
        sh1, sc1, gt1, sh2, sc2, gt2 = [m[:, None, :] for m in jnp.split(mod, N_MOD, axis=-1)]
        h = _rms_norm(x, norm1_g[layer]) * (1.0 + sc1) + sh1
        u = h @ w_in[layer]
        u_conv, u_mla, u_rwkv = jnp.split(u, [CONV_IN, CONV_IN + MLA_IN], axis=-1)
        y_conv = _conformer_conv(u_conv, conv_w[layer], conv_b[layer], conv_ln_g[layer], conv_ln_b[layer])
        y_mla = _mla(u_mla, cos, sin, mla_q_norm_g[layer], mla_w_uq[layer], mla_kv_norm_g[layer], mla_w_ukv[layer], qk_norm_q[layer], qk_norm_k[layer])
        y_rwkv = _rwkv7_mix(u_rwkv, rwkv_mu[layer], rwkv_w0[layer], rwkv_w_up[layer], rwkv_a0[layer], rwkv_a_up[layer], rwkv_g_up[layer], rwkv_k_k[layer], rwkv_k_a[layer], rwkv_r_k[layer], rwkv_ln_g[layer], rwkv_ln_b[layer])
        mixed = jnp.concatenate([y_conv, y_mla, y_rwkv], axis=-1)
        x = x + gt1 * (mixed @ w_out[layer])
        h = _rms_norm(x, norm2_g[layer]) * (1.0 + sc2) + sh2
        i = layer // 2
        if layer % 2 == 0:
            f = _swiglu(h, ffn_w_gate[i], ffn_w_up[i], ffn_w_down[i])
        else:
            f = _moe_swiglu(h, moe_router[i], moe_w_gate[i], moe_w_up[i], moe_w_down[i])
        x = x + gt2 * f
    return x
```

```cpp
#ifndef DENSE_DN8
#define DENSE_DN8 1
#endif
#include <hip/hip_runtime.h>
#include <cstdio>
#include <cstdint>

#ifndef MK_ONE_LAUNCH
#define MK_ONE_LAUNCH 1
#endif

#define GAS __attribute__((address_space(1)))
#define LAS __attribute__((address_space(3)))
#define DI __device__ __forceinline__
typedef unsigned short bf16_t;
typedef short bf16x8 __attribute__((ext_vector_type(8)));
typedef short s16x4 __attribute__((ext_vector_type(4)));
typedef float f32x4 __attribute__((ext_vector_type(4)));
typedef float f32x2 __attribute__((ext_vector_type(2)));
typedef float f32x16 __attribute__((ext_vector_type(16)));
typedef unsigned u32x4 __attribute__((ext_vector_type(4)));
typedef unsigned u32x2 __attribute__((ext_vector_type(2)));
typedef __bf16 bf16x2_t __attribute__((ext_vector_type(2)));
typedef int v4i_t __attribute__((ext_vector_type(4)));
typedef int v8i_t __attribute__((ext_vector_type(8)));

constexpr int NB = 4, SEQ = 4096, DM = 1024, M = NB * SEQ, NL = 4;
constexpr int INC = 1952, INCP = 2048;
constexpr int U_CQ = 512, U_CKV = 768, U_KR = 896, U_RW = 928;
constexpr int NH = 8, DQK = 96, DNOPE = 64, DROPE = 32, DV = 64;
constexpr int RH = 4, RN = 64, RC = 256;
constexpr int FF = 2816, MFF = 3584, NE = 8;
constexpr int CONVK = 31, CONVC = 256;
constexpr int MOE_CAP = 34816;
constexpr int NWAVES = 8, NTHREADS = 512;

constexpr size_t MiB = 1u << 20;
constexpr size_t WS_CTL = 0, CTL_BYTES = 1 * MiB;
constexpr size_t WS_COND = 1 * MiB;
constexpr size_t WS_COS = 2 * MiB, WS_SIN = 3 * MiB;
constexpr size_t WS_WIN = 4 * MiB;
constexpr size_t WS_WOUT = 20 * MiB;
constexpr size_t WS_WUQ = 28 * MiB;
constexpr size_t WS_WUKV = 30 * MiB;
constexpr size_t WS_LORA = 32 * MiB;
constexpr size_t WS_FGU = 34 * MiB;
constexpr size_t WS_FD = 56 * MiB;
constexpr size_t WS_MGU = 68 * MiB;
constexpr size_t WS_MD = 292 * MiB;
constexpr size_t WS_H = 404 * MiB;
constexpr size_t WS_YS = 436 * MiB;
constexpr size_t WS_MOE = 504 * MiB;
constexpr size_t WS_MIX = 508 * MiB;
constexpr size_t WS_U = WS_MIX;
constexpr size_t WS_MIXED = WS_MIX + 64 * MiB;
constexpr size_t WS_QRAW = WS_MIX + 96 * MiB;
constexpr size_t WS_KVRAW = WS_MIX + 120 * MiB;
constexpr size_t WS_Q = WS_MIX + 152 * MiB;
constexpr size_t WS_K = WS_MIX + 176 * MiB;
constexpr size_t WS_VT = WS_MIX + 200 * MiB;
constexpr size_t WS_RR = WS_MIX + 216 * MiB;
constexpr size_t WS_RK = WS_MIX + 224 * MiB;
constexpr size_t WS_RV = WS_MIX + 232 * MiB;
constexpr size_t WS_RKK = WS_MIX + 240 * MiB;
constexpr size_t WS_RB = WS_MIX + 248 * MiB;
constexpr size_t WS_RG = WS_MIX + 256 * MiB;
constexpr size_t WS_RLW = WS_MIX + 264 * MiB;
constexpr size_t WS_RY = WS_MIX + 280 * MiB;
constexpr size_t WS_LIN = WS_MIX + 296 * MiB;
constexpr size_t WS_LOUT = WS_MIX + 304 * MiB;
constexpr size_t WS_XS8 = WS_MIX + 128 * MiB;
constexpr size_t WS_ACT = WS_MIX;
constexpr size_t WS_YSF = WS_MIX + 256 * MiB;
constexpr size_t WS_CHK = WS_MIX + 330 * MiB;
constexpr size_t WS_END = WS_MIX + 362 * MiB;
static_assert((size_t)MOE_CAP * MFF * 2 <= 330 * MiB, "act fits");
constexpr size_t MOE_LTOK = 0;
constexpr size_t MOE_TE = 512 * 1024;
constexpr size_t MOE_TR = MOE_TE + 128 * 1024;
constexpr size_t MOE_TP = MOE_TR + 128 * 1024;
constexpr int CW_CNT = 64;
constexpr int CW_LATE = 448;
constexpr int CW_QH = 512;
constexpr int CW_BAR = 4096;

DI float shx(float v, int k) {
    if (k == 32) { auto rr = __builtin_amdgcn_permlane32_swap(__float_as_uint(v), __float_as_uint(v), false, false); const float a = __uint_as_float(rr[0]), b = __uint_as_float(rr[1]);
        return (__builtin_amdgcn_mbcnt_hi(~0u, __builtin_amdgcn_mbcnt_lo(~0u, 0u)) < 32u) ? b : a; }
    switch (k) {
        case 1: return __int_as_float(__builtin_amdgcn_ds_swizzle(__float_as_int(v), (1 << 10) | 0x1f));
        case 2: return __int_as_float(__builtin_amdgcn_ds_swizzle(__float_as_int(v), (2 << 10) | 0x1f));
        case 4: return __int_as_float(__builtin_amdgcn_ds_swizzle(__float_as_int(v), (4 << 10) | 0x1f));
        case 8: return __int_as_float(__builtin_amdgcn_ds_swizzle(__float_as_int(v), (8 << 10) | 0x1f));
        default: return __int_as_float(__builtin_amdgcn_ds_swizzle(__float_as_int(v), (16 << 10) | 0x1f));
    }
}
DI float shx32_sum(float v) { auto rr = __builtin_amdgcn_permlane32_swap(__float_as_uint(v), __float_as_uint(v), false, false); return __uint_as_float(rr[0]) + __uint_as_float(rr[1]); }
DI float shx32_max(float v) { auto rr = __builtin_amdgcn_permlane32_swap(__float_as_uint(v), __float_as_uint(v), false, false); return fmaxf(__uint_as_float(rr[0]), __uint_as_float(rr[1])); }
DI float wave_sum(float v) {
#pragma unroll
    for (int o = 1; o < 32; o <<= 1) v += shx(v, o);
    v = shx32_sum(v);
    return v;
}
DI float wave_max(float v) {
#pragma unroll
    for (int o = 1; o < 32; o <<= 1) v = fmaxf(v, shx(v, o));
    v = shx32_max(v);
    return v;
}
DI unsigned pk2(float lo, float hi) { f32x2 v = {lo, hi}; bf16x2_t b = __builtin_convertvector(v, bf16x2_t); return __builtin_bit_cast(unsigned, b); }
DI bf16_t f2bf(float f) { return (bf16_t)(pk2(f, 0.f) & 0xffffu); }
DI float bf2f(bf16_t b) { return __uint_as_float((unsigned)b << 16); }
DI float sigmoidf_(float x) { return 1.f / (1.f + __expf(-x)); }
DI float siluf_(float x) { return x * __builtin_amdgcn_rcpf(1.f + __expf(-x)); }
DI float fsigmoid(float x) { return __builtin_amdgcn_rcpf(1.f + __expf(-x)); }
DI float ftanh(float x) { return 2.f * __builtin_amdgcn_rcpf(1.f + __expf(-2.f * x)) - 1.f; }
DI float ozero() { float z = 0.f; asm volatile("" : "+v"(z)); return z; }
DI int crow(int reg, int h) { return (reg & 3) + 8 * (reg >> 2) + 4 * h; }
DI float bflo(unsigned w) { return __uint_as_float(w << 16); }
DI float bfhi(unsigned w) { return __uint_as_float(w & 0xffff0000u); }
DI void unpack8(const u32x4& w, float* f) { f[0] = bflo(w.x); f[1] = bfhi(w.x); f[2] = bflo(w.y); f[3] = bfhi(w.y); f[4] = bflo(w.z); f[5] = bfhi(w.z); f[6] = bflo(w.w); f[7] = bfhi(w.w); }
DI u32x4 pack8(const float* f) { u32x4 w; w.x = pk2(f[0], f[1]); w.y = pk2(f[2], f[3]); w.z = pk2(f[4], f[5]); w.w = pk2(f[6], f[7]); return w; }
DI f32x4 ld4(const float* p) { return *(const f32x4*)p; }
DI unsigned pk4_fp8(float a, float b, float c, float d) { int w; asm volatile("" : "=v"(w));   w = __builtin_amdgcn_cvt_pk_fp8_f32(a, b, w, false); w = __builtin_amdgcn_cvt_pk_fp8_f32(c, d, w, true); return (unsigned)w; }

#define XB_TMO      128
#define XB_XCNT(j)  (256  + 64 * (j))
#define XB_XSUB(j)  (1280 + 64 * (j))
#define XB_XGEN(j)  (2304 + 64 * (j))
#define XB_TOP      3328
#define XB_TOPGEN   3392
#define XCD_BAR_WORDS 3456
#define XB_SPIN_CAP (1u << 18)
__device__ __forceinline__ unsigned xb_ld(unsigned* p)              { asm volatile("" : "+v"(p));   return __hip_atomic_load(p, __ATOMIC_RELAXED, __HIP_MEMORY_SCOPE_AGENT); }
__device__ __forceinline__ unsigned xb_add(unsigned* p, unsigned v) { return __hip_atomic_fetch_add(p, v, __ATOMIC_RELAXED, __HIP_MEMORY_SCOPE_AGENT); }
__device__ __forceinline__ unsigned xb_xcc_id() { return (unsigned)__builtin_amdgcn_s_getreg((3 << 11) | 20) & 0xFu; }
#define XB_SPIN(cond, bar) do { unsigned _sp = 0; while (cond) { __builtin_amdgcn_s_sleep(1); \
    if ((++_sp & 255u) == 0u) { if (xb_ld(&(bar)[XB_TMO])) break; if (_sp > XB_SPIN_CAP) { atomicAdd(&(bar)[XB_TMO], 1u); break; } } } } while (0)
struct XcdBarrier { unsigned* bar; unsigned x; volatile LAS unsigned* st; };
__device__ __forceinline__ XcdBarrier xcd_barrier_post(unsigned* bar, volatile LAS unsigned* st) {
    XcdBarrier b; b.bar = bar; b.x = xb_xcc_id(); b.st = st;
    if (threadIdx.x == 0) (void)xb_add(&bar[XB_XCNT(b.x)], 1u);
    return b;
}
__device__ __forceinline__ void xcd_barrier_complete(unsigned* bar, unsigned x, unsigned& nloc, unsigned& nx) {
    const unsigned G = gridDim.x * gridDim.y * gridDim.z;
    unsigned sum, cnt, mine, sp = 0u;
    for (;;) {
        sum = 0u; cnt = 0u; mine = 0u;
#pragma unroll
        for (unsigned j = 0; j < 16; ++j) { const unsigned c = xb_ld(&bar[XB_XCNT(j)]); sum += c; cnt += (c > 0u) ? 1u : 0u; mine = (j == x) ? c : mine; }
        if (sum == G) break;
        __builtin_amdgcn_s_sleep(1);
        if ((++sp & 255u) == 0u) { if (xb_ld(&bar[XB_TMO])) break; if (sp > XB_SPIN_CAP) { atomicAdd(&bar[XB_TMO], 1u); break; } }
    }
    nloc = mine > 0u ? mine : 1u; nx = cnt > 0u ? cnt : 1u;
}
__device__ __forceinline__ void xcd_barrier(const XcdBarrier& b, int tid_) {
    asm volatile("s_waitcnt vmcnt(0)" ::: "memory");
    __syncthreads();
    if (tid_ == 0) {
        unsigned* bar = b.bar;
        __builtin_amdgcn_s_waitcnt(0);
        unsigned nloc = b.st[0], nx = b.st[1];
        if (nloc == 0u) { xcd_barrier_complete(bar, b.x, nloc, nx); b.st[0] = nloc; b.st[1] = nx; }
        const unsigned old = xb_add(&bar[XB_XSUB(b.x)], 1u);
        const unsigned gen = old / nloc;
        if (old + 1u == (gen + 1u) * nloc) {
            __builtin_amdgcn_fence(__ATOMIC_RELEASE, "agent");
            asm volatile("s_waitcnt vmcnt(0)" ::: "memory");
            const unsigned og = xb_add(&bar[XB_TOP], 1u);
            const unsigned tg = og / nx;
            if (og + 1u == (tg + 1u) * nx) xb_add(&bar[XB_TOPGEN], 1u);
            else XB_SPIN(xb_ld(&bar[XB_TOPGEN]) == tg, bar);
            __builtin_amdgcn_fence(__ATOMIC_ACQUIRE, "agent");
            xb_add(&bar[XB_XGEN(b.x)], 1u);
            asm volatile("s_waitcnt vmcnt(0)" ::: "memory");
        } else {
            XB_SPIN(xb_ld(&bar[XB_XGEN(b.x)]) == gen, bar);
            __builtin_amdgcn_fence(__ATOMIC_ACQUIRE, "agent");
            asm volatile("s_waitcnt vmcnt(0)" ::: "memory");
        }
    }
    __syncthreads();
}

struct Args { const void* in[38]; float* out; unsigned char* ws; int ph_lo, ph_hi; };
enum { I_X = 0, I_C, I_POS, I_ADAW, I_ADAB, I_ADALB, I_N1G, I_N2G, I_WIN, I_WOUT, I_CONVW, I_CONVB, I_CONVLG, I_CONVLB, I_QNG, I_WUQ, I_KVNG, I_WUKV, I_QKQ, I_QKK,
       I_RMU, I_RW0, I_RWUP, I_RA0, I_RAUP, I_RGUP, I_RKK, I_RKA, I_RRK, I_RLNG, I_RLNB, I_FG, I_FU, I_FD, I_ROUTER, I_MG, I_MU, I_MD };

#define CAS __attribute__((address_space(4)))
struct Ctx {
    const CAS char* ka; unsigned char* ws; LAS unsigned char* lds;
    int tid, lane, wave, gw, NGW, gtid, NT;
};
#define KARG(C_, off, T) (*(T const CAS*)((C_).ka + (off)))
#define INF(i) KARG(C, 8 * (i), const float*)
#define OUTP(C_) KARG(C_, 304, float*)

constexpr float GLU_GS = -1.4426950408889634f, GLU_US = -0.6931471805599453f;
DI void tr_load(const float* W, int K, int N, int item, int lane, f32x4 (&t)[16]) {
    const int nblk = (N + 63) / 64, kb = item / nblk, nb = item % nblk, k0 = 64 * kb, n0 = 64 * nb;
    const int lr = lane >> 4, lc = (lane & 15) * 4;
    const bool cvalid = (n0 + lc) < N;
#pragma unroll
    for (int i = 0; i < 16; ++i) t[i] = cvalid ? *(const f32x4*)(W + (size_t)(k0 + 4 * i + lr) * N + n0 + lc) : (f32x4){0.f, 0.f, 0.f, 0.f};
}
DI void tr_emit(const f32x4 (&t)[16], int K, int N, bf16_t* WT, int ldk, int mode, LAS float* scr, int item, int lane, float f8scale, float wmul) {
    const int nblk = (N + 63) / 64, kb = item / nblk, nb = item % nblk, k0 = 64 * kb, n0 = 64 * nb;
    const int lr = lane >> 4, lc = (lane & 15) * 4;
#pragma unroll
    for (int i = 0; i < 16; ++i) *(LAS f32x4*)(scr + (4 * i + lr) * 68 + lc) = t[i];
    asm volatile("s_waitcnt lgkmcnt(0)" ::: "memory");
    const int c = lane & 7;
    const int r0 = (mode == 0) ? n0 : ((n0 / 128) * 256 + (n0 % 128) + (mode == 2 ? 128 : 0));
#pragma unroll
    for (int j = 0; j < 8; ++j) { const int n = (lane >> 3) + 8 * j; const LAS float* sp = scr + (8 * c) * 68 + n;
        if (f8scale != 0.f) { u32x2 o8; o8.x = pk4_fp8(sp[0 * 68] * f8scale, sp[1 * 68] * f8scale, sp[2 * 68] * f8scale, sp[3 * 68] * f8scale); o8.y = pk4_fp8(sp[4 * 68] * f8scale, sp[5 * 68] * f8scale, sp[6 * 68] * f8scale, sp[7 * 68] * f8scale);
            if (n0 + n < N) *(u32x2*)((unsigned char*)WT + (size_t)(r0 + n) * ldk + k0 + 8 * c) = o8; }
        else { u32x4 o; o.x = pk2(sp[0 * 68] * wmul, sp[1 * 68] * wmul); o.y = pk2(sp[2 * 68] * wmul, sp[3 * 68] * wmul); o.z = pk2(sp[4 * 68] * wmul, sp[5 * 68] * wmul); o.w = pk2(sp[6 * 68] * wmul, sp[7 * 68] * wmul);
            if (n0 + n < N) *(u32x4*)(WT + (size_t)(r0 + n) * ldk + k0 + 8 * c) = o; } }
    asm volatile("s_waitcnt lgkmcnt(0)" ::: "memory");
}
DI void tr_load8(const float* W, int K, int N, int item, int lane, f32x4 (&t)[16]) {
    const int nblk = N / 32, kb = item / nblk, nb = item % nblk, k0 = 128 * kb, n0 = 32 * nb;
    const int lr = lane >> 3, lc = (lane & 7) * 4;
#pragma unroll
    for (int i = 0; i < 16; ++i) t[i] = *(const f32x4*)(W + (size_t)(k0 + 8 * i + lr) * N + n0 + lc);
}
DI void tr_emit8(const f32x4 (&t)[16], int K, int N, unsigned char* WT, int ldk, int mode, LAS float* scr, int item, int lane, float f8scale) {
    const int nblk = N / 32, kb = item / nblk, nb = item % nblk, k0 = 128 * kb, n0 = 32 * nb;
    const int lr = lane >> 3, lc = (lane & 7) * 4;
#pragma unroll
    for (int i = 0; i < 16; ++i) *(LAS f32x4*)(scr + (8 * i + lr) * 36 + lc) = t[i];
    asm volatile("s_waitcnt lgkmcnt(0)" ::: "memory");
    const int n = lane & 31, h = lane >> 5;
    const int r0 = (mode == 0) ? n0 : ((n0 / 128) * 256 + (n0 % 128) + (mode == 2 ? 128 : 0));
    unsigned char* rowp = WT + (size_t)(r0 + n) * ldk + k0;
#pragma unroll
    for (int j = 0; j < 4; ++j) { const int pc = 2 * j + h; const LAS float* sp = scr + (16 * pc) * 36 + n; u32x4 o;
        o.x = pk4_fp8(sp[0 * 36] * f8scale, sp[1 * 36] * f8scale, sp[2 * 36] * f8scale, sp[3 * 36] * f8scale); o.y = pk4_fp8(sp[4 * 36] * f8scale, sp[5 * 36] * f8scale, sp[6 * 36] * f8scale, sp[7 * 36] * f8scale);
        o.z = pk4_fp8(sp[8 * 36] * f8scale, sp[9 * 36] * f8scale, sp[10 * 36] * f8scale, sp[11 * 36] * f8scale); o.w = pk4_fp8(sp[12 * 36] * f8scale, sp[13 * 36] * f8scale, sp[14 * 36] * f8scale, sp[15 * 36] * f8scale);
        *(u32x4*)(rowp + 16 * pc) = o; }
    asm volatile("s_waitcnt lgkmcnt(0)" ::: "memory");
}
DI void transpose_item(const float* W, int K, int N, bf16_t* WT, int ldk, int mode, LAS float* scr, int item, int lane, float f8scale = 0.f, float wmul = 1.f) {
    f32x4 t[16];
    if (f8scale != 0.f) { tr_load8(W, K, N, item, lane, t); tr_emit8(t, K, N, (unsigned char*)WT, ldk, mode, scr, item, lane, f8scale); }
    else { tr_load(W, K, N, item, lane, t); tr_emit(t, K, N, WT, ldk, mode, scr, item, lane, f8scale, wmul); }
}

struct TrItem { const float* W; int K, N; bf16_t* WT; int ldk, mode; float f8, wm; int item; bool ok; };
DI TrItem tr_decode(const Ctx& C, int g) {
    TrItem r; r.ok = false; r.W = nullptr; r.K = 64; r.N = 64; r.WT = nullptr; r.ldk = 0; r.mode = 0; r.f8 = 0.f; r.wm = 1.f; r.item = 0;
    bool done = false;
#define TJ(in_, K_, N_, dst_, ldk_, mode_, nmat_, ss_, dsb_, f8_, wm_) if (!done) { const int per = ((K_) / 64) * (((N_) + 63) / 64), tot = per * (nmat_); \
        if (g < tot) { const int mi = g / per; r.item = g - mi * per; r.W = INF(in_) + (size_t)mi * (ss_); r.K = (K_); r.N = (N_); r.WT = (bf16_t*)(C.ws + (dst_) + (size_t)mi * (dsb_)); r.ldk = (ldk_); r.mode = (mode_); r.f8 = (f8_); r.wm = (wm_); r.ok = true; done = true; } else g -= tot; }
    TJ(I_MG, 1024, MFF, WS_MGU, 1024, 1, 16, (size_t)1024 * MFF, (size_t)2 * MFF * 1024, 64.f * GLU_GS, 1.f)
    TJ(I_MU, 1024, MFF, WS_MGU, 1024, 2, 16, (size_t)1024 * MFF, (size_t)2 * MFF * 1024, 64.f * GLU_US, 1.f)
    TJ(I_MD, MFF, 1024, WS_MD, MFF, 0, 8, (size_t)MFF * 1024, (size_t)1024 * MFF, 64.f, 1.f)
    TJ(I_WIN, 1024, INC, WS_WIN, 1024, 0, NL, (size_t)1024 * INC, (size_t)INCP * 1024 * 2, 0.f, 1.f)
    TJ(I_WOUT, 1024, 1024, WS_WOUT, 1024, 0, NL, (size_t)1024 * 1024, (size_t)1024 * 1024 * 2, 0.f, 1.f)
    TJ(I_WUQ, 256, 768, WS_WUQ, 256, 0, NL, (size_t)256 * 768, (size_t)768 * 256 * 2, 0.f, 1.f)
    TJ(I_FG, 1024, FF, WS_FGU, 1024, 1, 2, (size_t)1024 * FF, (size_t)2 * FF * 1024 * 2, 0.f, GLU_GS)
    TJ(I_FU, 1024, FF, WS_FGU, 1024, 2, 2, (size_t)1024 * FF, (size_t)2 * FF * 1024 * 2, 0.f, GLU_US)
    TJ(I_WUKV, 128, 1024, WS_WUKV, 256, 0, NL, (size_t)128 * 1024, (size_t)1024 * 256 * 2, 0.f, 1.f)
    TJ(I_RWUP, 64, 256, WS_LORA, 256, 0, NL, (size_t)64 * 256, (size_t)768 * 256 * 2, 0.f, 1.f)
    TJ(I_RAUP, 64, 256, WS_LORA + (size_t)(256 * 256 + 64) * 2, 256, 0, NL, (size_t)64 * 256, (size_t)768 * 256 * 2, 0.f, 1.f)
    TJ(I_RGUP, 128, 256, WS_LORA + (size_t)(512 * 256 + 128) * 2, 256, 0, NL, (size_t)128 * 256, (size_t)768 * 256 * 2, 0.f, 1.f)
#if DENSE_DN8
    TJ(I_FD, FF, 1024, WS_FD, FF, 0, 2, (size_t)FF * 1024, (size_t)1024 * FF, 64.f, 1.f)
#else
    TJ(I_FD, FF, 1024, WS_FD, FF, 0, 2, (size_t)FF * 1024, (size_t)1024 * FF * 2, 0.f, 1.f)
#endif
#undef TJ
    return r;
}

DI void phase_prologue(Ctx C) {
    LAS float* scr = (LAS float*)(C.lds + (C.wave < 7 ? C.wave * 18432 : 131072 + 4096));
    {
        TrItem cur = tr_decode(C, C.gw); f32x4 t[16];
        if (cur.ok) { if (cur.f8 != 0.f) tr_load8(cur.W, cur.K, cur.N, cur.item, C.lane, t); else tr_load(cur.W, cur.K, cur.N, cur.item, C.lane, t); }
        for (int g = C.gw; cur.ok; g += C.NGW) {
            const TrItem nxt = tr_decode(C, g + C.NGW); f32x4 tn[16];
            if (nxt.ok) { if (nxt.f8 != 0.f) tr_load8(nxt.W, nxt.K, nxt.N, nxt.item, C.lane, tn); else tr_load(nxt.W, nxt.K, nxt.N, nxt.item, C.lane, tn); }
            if (cur.f8 != 0.f) tr_emit8(t, cur.K, cur.N, (unsigned char*)cur.WT, cur.ldk, cur.mode, scr, cur.item, C.lane, cur.f8);
            else tr_emit(t, cur.K, cur.N, cur.WT, cur.ldk, cur.mode, scr, cur.item, C.lane, cur.f8, cur.wm);
#pragma unroll
            for (int i = 0; i < 16; ++i) t[i] = tn[i];
            cur = nxt;
        }
    }
    {
        for (int i = C.gtid; i < NL * 96 * 1024; i += C.NT) { const int l = i / (96 * 1024), r = i % (96 * 1024); ((bf16_t*)(C.ws + WS_WIN))[(size_t)l * INCP * 1024 + (size_t)INC * 1024 + r] = 0; }
        for (int i = C.gtid; i < NL * 1024 * 16; i += C.NT) { const int row = i >> 4, c = i & 15; *(u32x4*)((bf16_t*)(C.ws + WS_WUKV) + (size_t)row * 256 + 128 + c * 8) = (u32x4){0u, 0u, 0u, 0u}; }
        for (int i = C.gtid; i < NL * 768 * 32; i += C.NT) { const int row = i >> 5, c8 = (i & 31) * 8, n = row % 768;
            const bool z = (n < 256) ? (c8 >= 64) : (n < 512) ? (c8 < 64 || c8 >= 128) : (c8 < 128);
            if (z) *(u32x4*)((bf16_t*)(C.ws + WS_LORA) + (size_t)row * 256 + c8) = (u32x4){0u, 0u, 0u, 0u}; }
        const int* pos = KARG(C, 8 * I_POS, const int*);
        for (int i = C.gtid; i < M * 16; i += C.NT) { const int m = i >> 4, f = i & 15; const float inv = powf(10000.0f, -(float)(2 * f) / 32.0f); const float ang = (float)pos[m] * inv;
            ((float*)(C.ws + WS_COS))[i] = cosf(ang); ((float*)(C.ws + WS_SIN))[i] = sinf(ang); }
    }
    {
        LAS float* red = (LAS float*)(C.lds);
        LAS float* sc = (LAS float*)(C.lds + 8192);
        __syncthreads();
        if (blockIdx.x < 6144 / 64) { for (int i = C.tid; i < 4096; i += NTHREADS) sc[(i & 1023) * 4 + (i >> 10)] = siluf_(INF(I_C)[i]); }
        for (int it = blockIdx.x; it < 6144 / 64; it += gridDim.x) {
            __syncthreads();
            const int n = it * 64 + C.lane; float acc[4] = {0.f, 0.f, 0.f, 0.f};
#pragma unroll 8
            for (int k = C.wave * 128; k < C.wave * 128 + 128; ++k) { const float w = INF(I_ADAW)[(size_t)k * 6144 + n]; const f32x4 s4 = *(const LAS f32x4*)(sc + k * 4);
#pragma unroll
                for (int b = 0; b < 4; ++b) acc[b] += s4[b] * w; }
#pragma unroll
            for (int b = 0; b < 4; ++b) red[(C.wave * 4 + b) * 64 + C.lane] = acc[b];
            __syncthreads();
            if (C.tid < 256) { const int b = C.tid >> 6, l = C.tid & 63; float s = INF(I_ADAB)[it * 64 + l];
                for (int w = 0; w < 8; ++w) s += red[(w * 4 + b) * 64 + l];
                ((float*)(C.ws + WS_COND))[b * 6144 + it * 64 + l] = s; }
        }
        __syncthreads();
    }
}


DI void late_convert(Ctx C, unsigned* qctr) {
    LAS float* scr = (LAS float*)(C.lds + (C.wave < 7 ? C.wave * 18432 : 131072 + 4096));
    constexpr int P_M = 16 * 56, NTOT = 8 * P_M;
    for (;;) {
        unsigned base = 0; if (C.lane == 0) base = __hip_atomic_fetch_add(qctr, 8u, __ATOMIC_RELAXED, __HIP_MEMORY_SCOPE_AGENT);
        base = __builtin_amdgcn_readfirstlane(base);
        if (base >= (unsigned)NTOT) break;
        for (int q = 0; q < 8; ++q) { const int it = (int)base + q; if (it >= NTOT) break; const int mi = 8 + it / P_M;
            transpose_item(INF(I_MD) + (size_t)mi * MFF * 1024, MFF, 1024, (bf16_t*)(C.ws + WS_MD + (size_t)mi * 1024 * MFF), MFF, 0, scr, it % P_M, C.lane, 64.f); }
    }
}

DI void phase_norm(Ctx C, int layer, int which_norm, bool combine_prev, bool route) {
    const float* xin = (layer == 0 && which_norm == 0) ? INF(I_X) : OUTP(C);
    float* xout = OUTP(C);
    bf16_t* H = (bf16_t*)(C.ws + WS_H);
    const int prev = layer - 1, mi_prev = prev >> 1;
    unsigned* ctl = (unsigned*)(C.ws + WS_CTL);
    const float* cond = (const float*)(C.ws + WS_COND); const float* lbias = INF(I_ADALB);
    LAS float* rt = (LAS float*)C.lds;
    const int mi = layer >> 1;
    LAS int* sel_e = (LAS int*)(C.lds + 40960); LAS float* sel_p = (LAS float*)(C.lds + 40960 + 4096); LAS int* lcnt = (LAS int*)(C.lds + 40960 + 8192);
    if (route) { const float* R = INF(I_ROUTER) + (size_t)mi * DM * NE;
        for (int i = C.tid; i < DM * NE; i += NTHREADS) rt[(i & 7) * DM + (i >> 3)] = R[i];
        if (C.tid < 16) lcnt[C.tid] = 0;
        __syncthreads(); }
    int pst[8]; int row0t = 0x7fffffff, kparts = 1; unsigned part_elems = 0u;
    if (combine_prev) { const unsigned* cnt = ctl + CW_CNT + 16 * mi_prev; int acc = 0, tiles = 0;
#pragma unroll
        for (int e = 0; e < 8; ++e) { pst[e] = acc; const int te_ = ((int)cnt[e] + 255) / 256; acc += te_ * 256; tiles += te_; }
        if (prev == NL - 1) { const int nU = tiles * 4, G = (int)gridDim.x, nFull = (nU / G) * G, nT = nU - nFull;
            if (nT > 0) kparts = (nT * 7 <= G) ? 7 : (nT * 2 <= G) ? 2 : 1;
            if (kparts > 1) { const int t0 = nFull / 4; int tcum = 0;
#pragma unroll
                for (int e = 0; e < 8; ++e) { const int te_ = ((int)cnt[e] + 255) / 256; if (t0 >= tcum && t0 < tcum + te_) row0t = pst[e] + (t0 - tcum) * 256; tcum += te_; }
                part_elems = (unsigned)((tiles - t0) * 256) * (unsigned)DM; } } }
    const int rpw = (M + C.NGW - 1) / C.NGW, m0 = C.gw * rpw, m1 = (m0 + rpw < M) ? m0 + rpw : M;
    int bcur = -1; f32x4 scl[4], sft[4], gtp[4];
    const int wsh = which_norm == 0 ? 0 : 3, wsc = wsh + 1;
    f32x4 vn[4];
    if (m0 < m1) {
#pragma unroll
        for (int j = 0; j < 4; ++j) vn[j] = *(const f32x4*)(xin + (size_t)m0 * DM + C.lane * 4 + 256 * j); }
    for (int m = m0; m < m1; ++m) {
        const int b = m / SEQ;
        if (b != bcur) { bcur = b;
#pragma unroll
            for (int j = 0; j < 4; ++j) { const int c = C.lane * 4 + 256 * j;
                if (which_norm != 2) { const f32x4 g = ld4(INF(which_norm == 0 ? I_N1G : I_N2G) + layer * DM + c);
                    scl[j] = g * (1.f + ld4(cond + b * 6144 + wsc * 1024 + c) + ld4(lbias + layer * 6144 + wsc * 1024 + c)); sft[j] = ld4(cond + b * 6144 + wsh * 1024 + c) + ld4(lbias + layer * 6144 + wsh * 1024 + c); }
                if (combine_prev) gtp[j] = ld4(cond + b * 6144 + 5 * 1024 + c) + ld4(lbias + prev * 6144 + 5 * 1024 + c); } }
        f32x4 v[4];
#pragma unroll
        for (int j = 0; j < 4; ++j) v[j] = vn[j];
        if (m + 1 < m1) {
#pragma unroll
            for (int j = 0; j < 4; ++j) vn[j] = *(const f32x4*)(xin + (size_t)(m + 1) * DM + C.lane * 4 + 256 * j); }
        if (combine_prev) {
            const int* te = (const int*)(C.ws + WS_MOE + MOE_TE); const int* tr = (const int*)(C.ws + WS_MOE + MOE_TR); const float* tp = (const float*)(C.ws + WS_MOE + MOE_TP);
            const bf16_t* YS = (const bf16_t*)(C.ws + WS_YS);
#pragma unroll
            for (int k = 0; k < 2; ++k) {
                const int e = te[m * 2 + k], r = tr[m * 2 + k]; const float p = tp[m * 2 + k];
                int base = 0;
#pragma unroll
                for (int q = 0; q < 8; ++q) base = (q == e) ? pst[q] : base;
                const int srow = base + r;
                if (srow >= row0t) { const float* y0 = (const float*)(C.ws + WS_YSF) + (size_t)(srow - row0t) * DM;
#pragma unroll
                    for (int j = 0; j < 4; ++j) { f32x4 ysum = ld4(y0 + C.lane * 4 + 256 * j);
                        for (int kq = 1; kq < kparts; ++kq) ysum += ld4(y0 + (size_t)kq * part_elems + C.lane * 4 + 256 * j);
                        const unsigned w0 = pk2(ysum.x, ysum.y), w1 = pk2(ysum.z, ysum.w);
                        v[j] += gtp[j] * p * (f32x4){bflo(w0), bfhi(w0), bflo(w1), bfhi(w1)}; } }
                else { const bf16_t* yr = YS + (size_t)srow * DM;
#pragma unroll
                    for (int j = 0; j < 4; ++j) { const u32x2 w = *(const u32x2*)(yr + C.lane * 4 + 256 * j);
                        v[j] += gtp[j] * p * (f32x4){bflo(w.x), bfhi(w.x), bflo(w.y), bfhi(w.y)}; } }
            }
#pragma unroll
            for (int j = 0; j < 4; ++j) *(f32x4*)(xout + (size_t)m * DM + C.lane * 4 + 256 * j) = v[j];
        }
        if (which_norm == 2) continue;
        float s = 0.f;
#pragma unroll
        for (int j = 0; j < 4; ++j) s += v[j].x * v[j].x + v[j].y * v[j].y + v[j].z * v[j].z + v[j].w * v[j].w;
        const float rs = rsqrtf(wave_sum(s) * (1.f / DM) + 1e-6f);
        f32x4 hn[4];
#pragma unroll
        for (int j = 0; j < 4; ++j) { hn[j] = v[j] * rs * scl[j] + sft[j];
            if (route) *(LAS unsigned*)(C.lds + 65536 + (C.wave * 8 + (m - m0)) * 1024 + C.lane * 4 + 256 * j) = pk4_fp8(hn[j].x, hn[j].y, hn[j].z, hn[j].w);
            else { u32x2 w; w.x = pk2(hn[j].x, hn[j].y); w.y = pk2(hn[j].z, hn[j].w); *(u32x2*)(H + (size_t)m * DM + C.lane * 4 + 256 * j) = w; } }
        if (route) {
            float lg[8];
#pragma unroll
            for (int e = 0; e < 8; ++e) { float a = 0.f;
#pragma unroll
                for (int j = 0; j < 4; ++j) { const f32x4 rr = *(const LAS f32x4*)(rt + e * DM + C.lane * 4 + 256 * j); a += hn[j].x * rr.x + hn[j].y * rr.y + hn[j].z * rr.z + hn[j].w * rr.w; }
                lg[e] = wave_sum(a); }
            float mx = lg[0];
#pragma unroll
            for (int e = 1; e < 8; ++e) mx = fmaxf(mx, lg[e]);
            float pe[8];
#pragma unroll
            for (int e = 0; e < 8; ++e) pe[e] = __expf(lg[e] - mx);
            int e0 = 0; float p0 = pe[0];
#pragma unroll
            for (int e = 1; e < 8; ++e) if (pe[e] > p0) { p0 = pe[e]; e0 = e; }
            int e1 = -1; float p1 = -1.f;
#pragma unroll
            for (int e = 0; e < 8; ++e) if (e != e0 && pe[e] > p1) { p1 = pe[e]; e1 = e; }
            const float inv = 1.f / (p0 + p1);
            if (C.lane == 0) { const int si = C.wave * 64 + (m - m0); sel_e[si * 2] = e0; sel_e[si * 2 + 1] = e1; sel_p[si * 2] = p0 * inv; sel_p[si * 2 + 1] = p1 * inv; }
        }
    }
    if (route) {
        __syncthreads();
        const int w = C.tid >> 6, i = C.tid & 63; const int wm0 = (blockIdx.x * NWAVES + w) * rpw, wm1 = (wm0 + rpw < M) ? wm0 + rpw : M; const bool act = (wm0 + i) < wm1 && i < 64;
        int e0 = 0, e1 = 0, r0 = 0, r1 = 0;
        if (act) { e0 = sel_e[C.tid * 2]; e1 = sel_e[C.tid * 2 + 1]; r0 = __hip_atomic_fetch_add(&lcnt[e0], 1, __ATOMIC_RELAXED, __HIP_MEMORY_SCOPE_WORKGROUP); r1 = __hip_atomic_fetch_add(&lcnt[e1], 1, __ATOMIC_RELAXED, __HIP_MEMORY_SCOPE_WORKGROUP); }
        __syncthreads();
        if (C.tid < 8) lcnt[8 + C.tid] = (int)atomicAdd(ctl + CW_CNT + 16 * mi + C.tid, (unsigned)lcnt[C.tid]);
        __syncthreads();
        if (act) { const int m = wm0 + i; const int s0 = lcnt[8 + e0] + r0, s1 = lcnt[8 + e1] + r1;
            int* ltok = (int*)(C.ws + WS_MOE + MOE_LTOK); int* te = (int*)(C.ws + WS_MOE + MOE_TE); int* tr = (int*)(C.ws + WS_MOE + MOE_TR); float* tp = (float*)(C.ws + WS_MOE + MOE_TP);
            ltok[e0 * 16384 + s0] = m; ltok[e1 * 16384 + s1] = m;
            te[m * 2] = e0; te[m * 2 + 1] = e1; tr[m * 2] = s0; tr[m * 2 + 1] = s1; tp[m * 2] = sel_p[C.tid * 2]; tp[m * 2 + 1] = sel_p[C.tid * 2 + 1];
            sel_e[C.tid * 2] = e0 * 16384 + s0; sel_e[C.tid * 2 + 1] = e1 * 16384 + s1; }
        __syncthreads();
        { unsigned char* XS = C.ws + WS_XS8;
          for (int q = C.tid; q < 64 * 2 * 64; q += NTHREADS) { const int row = q >> 7, kk = (q >> 6) & 1, pc = q & 63; const int ww = row >> 3, ii = row & 7;
              if ((blockIdx.x * NWAVES + ww) * rpw + ii < M && ii < rpw) { const int dst = sel_e[(ww * 64 + ii) * 2 + kk];
                  *(u32x4*)(XS + (size_t)dst * 1024 + pc * 16) = *(const LAS u32x4*)(C.lds + 65536 + row * 1024 + pc * 16); } } }
        __syncthreads();
    }
}

namespace g8 {
constexpr int BM = 256, BK = 64, HALF = 128, HTB = HALF * BK * 2, STAGE_BYTES = 8 * HTB;
DI int lds_byte(int r, int c) { const int st = (r >> 4) * 2 + (c >> 5), rr = r & 15, cc = c & 31, ob = rr * 64 + cc * 2; return st * 1024 + (ob ^ (((ob >> 9) & 1) << 5)); }
DI void stage_rc(int b, int& R, int& C) { const int st = b / 1024, sb = b % 1024, swz = sb ^ (((sb >> 9) & 1) << 5); R = (st >> 1) * 16 + swz / 64; C = (st & 1) * 32 + (swz % 64) / 2; }
DI int perm32(int rho) { const int n = rho >> 4, i = rho & 15; return 8 * (i >> 2) + 4 * n + (i & 3); }
struct Unit { int pm, pn, orow, e, kh; };

struct EpiStore {
    static constexpr bool PERM = true;
    bf16_t* O; int ldc;
    DI void operator()(const f32x4 (&acc)[2][2][4][2], const Unit& u, int wr, int wc, int fr, int fq) const {
        bf16_t* base = O + (size_t)(u.orow + wr * 64 + fr) * ldc + u.pn * BM + wc * 32 + 8 * fq;
#pragma unroll
        for (int ai = 0; ai < 2; ++ai)
#pragma unroll
            for (int m = 0; m < 4; ++m) { bf16_t* rowp = base + (size_t)(ai * HALF + m * 16) * ldc;
#pragma unroll
                for (int bj = 0; bj < 2; ++bj) { const f32x4 v0 = acc[ai][bj][m][0], v1 = acc[ai][bj][m][1];
                    u32x4 w; w.x = pk2(v0[0], v0[1]); w.y = pk2(v0[2], v0[3]); w.z = pk2(v1[0], v1[1]); w.w = pk2(v1[2], v1[3]);
                    *(u32x4*)(rowp + bj * HALF) = w; } }
    }
};
struct EpiGlu {
    static constexpr bool PERM = true;
    bf16_t* O; int ldc;
    DI void operator()(const f32x4 (&acc)[2][2][4][2], const Unit& u, int wr, int wc, int fr, int fq) const {
        bf16_t* base = O + (size_t)(u.orow + wr * 64 + fr) * ldc + u.pn * HALF + wc * 32 + 8 * fq;
#pragma unroll
        for (int ai = 0; ai < 2; ++ai)
#pragma unroll
            for (int m = 0; m < 4; ++m) { float o[8];
#pragma unroll
                for (int n = 0; n < 2; ++n)
#pragma unroll
                    for (int q = 0; q < 4; q += 2) { const f32x2 g = {acc[ai][0][m][n][q], acc[ai][0][m][n][q + 1]}, uu = {acc[ai][1][m][n][q], acc[ai][1][m][n][q + 1]};
                        f32x2 e; e.x = __builtin_amdgcn_exp2f(g.x); e.y = __builtin_amdgcn_exp2f(g.y); const f32x2 d = e + 1.f; f32x2 r; r.x = __builtin_amdgcn_rcpf(d.x); r.y = __builtin_amdgcn_rcpf(d.y);
                        const f32x2 ov = (g * uu) * r; o[n * 4 + q] = ov.x; o[n * 4 + q + 1] = ov.y; }
                u32x4 w; w.x = pk2(o[0], o[1]); w.y = pk2(o[2], o[3]); w.z = pk2(o[4], o[5]); w.w = pk2(o[6], o[7]);
                *(u32x4*)(base + (size_t)(ai * HALF + m * 16) * ldc) = w; }
    }
};
struct EpiGlu8 {
    static constexpr bool PERM = true;
    unsigned char* O; int ldc;
    DI void operator()(const f32x4 (&acc)[2][2][4][2], const Unit& u, int wr, int wc, int fr, int fq) const {
        const __amdgpu_buffer_rsrc_t rs = __builtin_amdgcn_make_buffer_rsrc((void*)O, (short)0, -1, 0x00020000);
        const int voff = (wr * 64 + fr) * ldc + wc * 32 + 8 * fq, sbase = u.orow * ldc + u.pn * HALF;
#pragma unroll
        for (int ai = 0; ai < 2; ++ai)
#pragma unroll
            for (int m = 0; m < 4; ++m) { float o[8];
#pragma unroll
                for (int n = 0; n < 2; ++n)
#pragma unroll
                    for (int q = 0; q < 4; q += 2) { const f32x2 g = {acc[ai][0][m][n][q], acc[ai][0][m][n][q + 1]}, uu = {acc[ai][1][m][n][q], acc[ai][1][m][n][q + 1]};
                        f32x2 e; e.x = __builtin_amdgcn_exp2f(g.x); e.y = __builtin_amdgcn_exp2f(g.y); const f32x2 d = e + 1.f; f32x2 r; r.x = __builtin_amdgcn_rcpf(d.x); r.y = __builtin_amdgcn_rcpf(d.y);
                        const f32x2 ov = (g * uu) * r; o[n * 4 + q] = ov.x; o[n * 4 + q + 1] = ov.y; }
                u32x2 w; w.x = pk4_fp8(o[0], o[1], o[2], o[3]); w.y = pk4_fp8(o[4], o[5], o[6], o[7]);
                __builtin_amdgcn_raw_buffer_store_b64(w, rs, voff, sbase + (ai * HALF + m * 16) * ldc, 0); }
    }
};
struct EpiStoreB {
    static constexpr bool PERM = true;
    bf16_t* O; int ldc;
    DI void operator()(const f32x4 (&acc)[2][2][4][2], const Unit& u, int wr, int wc, int fr, int fq) const {
        const __amdgpu_buffer_rsrc_t rs = __builtin_amdgcn_make_buffer_rsrc((void*)O, (short)0, -1, 0x00020000);
        const int voff = ((wr * 64 + fr) * ldc + wc * 32 + 8 * fq) * 2, sbase = (u.orow * ldc + u.pn * BM) * 2;
#pragma unroll
        for (int ai = 0; ai < 2; ++ai)
#pragma unroll
            for (int m = 0; m < 4; ++m)
#pragma unroll
                for (int bj = 0; bj < 2; ++bj) { const f32x4 v0 = acc[ai][bj][m][0], v1 = acc[ai][bj][m][1];
                    u32x4 w; w.x = pk2(v0[0], v0[1]); w.y = pk2(v0[2], v0[3]); w.z = pk2(v1[0], v1[1]); w.w = pk2(v1[2], v1[3]);
                    __builtin_amdgcn_raw_buffer_store_b128(w, rs, voff, sbase + ((ai * HALF + m * 16) * ldc + bj * HALF) * 2, 0); }
    }
};
struct EpiResid {
    static constexpr bool PERM = false;
    const float* xin; float* xout; const float* gc; const float* gl;
    DI void operator()(const f32x4 (&acc)[2][2][4][2], const Unit& u, int wr, int wc, int fr, int fq) const {
        const int b = u.orow / SEQ; const int col0 = u.pn * BM + wc * 32 + 4 * fq;
        f32x4 gt[2][2];
#pragma unroll
        for (int bj = 0; bj < 2; ++bj)
#pragma unroll
            for (int n = 0; n < 2; ++n) { const int c = col0 + bj * HALF + n * 16; gt[bj][n] = *(const f32x4*)(gc + b * 6144 + c) + *(const f32x4*)(gl + c); }
#pragma unroll
        for (int ai = 0; ai < 2; ++ai)
#pragma unroll
            for (int m = 0; m < 4; ++m) { const size_t off = (size_t)(u.orow + ai * HALF + wr * 64 + m * 16 + fr) * DM + col0;
#pragma unroll
                for (int bj = 0; bj < 2; ++bj)
#pragma unroll
                    for (int n = 0; n < 2; ++n) { const f32x4 x = *(const f32x4*)(xin + off + bj * HALF + n * 16); *(f32x4*)(xout + off + bj * HALF + n * 16) = x + gt[bj][n] * acc[ai][bj][m][n]; } }
    }
};

template <class Epi, class Sched, bool GATHER, unsigned F8W = 0u  >
DI void gemm_phase(int tid, LAS unsigned char* lds, const bf16_t* A, int lda, int K, const Sched& S, const Epi& E, int ldb = 0) {
    if (ldb == 0) ldb = K;
    const int wid = __builtin_amdgcn_readfirstlane(tid >> 6), lane = tid & 63, wr = wid >> 2, wc = wid & 3, fr = lane & 15, fq = lane >> 4;
    const int nt = K / BK;
    unsigned voffA, voffB;
    { int R, C; stage_rc(tid * 16, R, C); const int Rb = Epi::PERM ? ((R & ~31) + perm32(R & 31)) : R; voffA = (unsigned)(R * lda + C) * 2u; voffB = (unsigned)(Rb * ldb + C) * 2u; }
    const unsigned p1A = 64u * (unsigned)lda * 2u, p1B = 64u * (unsigned)ldb * 2u;
    const unsigned kstep = (unsigned)(BK * 2);
    const unsigned hstepA = (unsigned)HALF * (unsigned)lda * 2u, hstepB = (unsigned)HALF * (unsigned)ldb * 2u;
    const __amdgpu_buffer_rsrc_t rsA = __builtin_amdgcn_make_buffer_rsrc((void*)A, (short)0, -1, 0x00020000);
    const __amdgpu_buffer_rsrc_t rsB = __builtin_amdgcn_make_buffer_rsrc((void*)S.bmat(), (short)0, -1, 0x00020000);
    const unsigned ldsw = (unsigned)wid * 1024u;
    const int aoff = lds_byte(wr * 64 + fr, fq * 8), boff = lds_byte(wc * 32 + fr, fq * 8) + 4 * HTB;
#define G8_SA(b, h) (((b) * 2 + (h)) * HTB)
#define G8_SB(b, h) ((4 + (b) * 2 + (h)) * HTB)
#define G8_SBR(b, h) (((b) * 2 + (h)) * HTB)
#define G8_STAGE(bufoff, rs, soff, voff) do { __builtin_amdgcn_raw_ptr_buffer_load_lds(rs, (LAS unsigned*)(lds + (bufoff) + ldsw), 16, (int)(voff), (int)(soff), 0, 0); \
        __builtin_amdgcn_raw_ptr_buffer_load_lds(rs, (LAS unsigned*)(lds + (bufoff) + ldsw + 8192), 16, (int)(voff), (int)((soff) + p1##voff), 0, 0); } while (0)
#define p1voffA p1A
#define p1voffB p1B
#define G8_LDA(dst, b, h) do { if constexpr (F8W != 0u) { _Pragma("unroll") for (int m = 0; m < 4; ++m) dst##8[m] = __builtin_shufflevector(*(const LAS v4i_t*)(lds + G8_SA(b, h) + aoff + m * 2048), *(const LAS v4i_t*)(lds + G8_SA(b, h) + aoff + m * 2048 + 1024), 0, 1, 2, 3, 4, 5, 6, 7); } \
        else { _Pragma("unroll") for (int m = 0; m < 4; ++m) _Pragma("unroll") for (int k = 0; k < 2; ++k) dst[m][k] = *(const LAS bf16x8*)(lds + G8_SA(b, h) + aoff + m * 2048 + k * 1024); } } while (0)
#define G8_LDB(dst, b, h) do { if constexpr (F8W != 0u) { _Pragma("unroll") for (int n = 0; n < 2; ++n) dst##8[n] = __builtin_shufflevector(*(const LAS v4i_t*)(lds + G8_SBR(b, h) + boff + n * 2048), *(const LAS v4i_t*)(lds + G8_SBR(b, h) + boff + n * 2048 + 1024), 0, 1, 2, 3, 4, 5, 6, 7); } \
        else { _Pragma("unroll") for (int n = 0; n < 2; ++n) _Pragma("unroll") for (int k = 0; k < 2; ++k) dst[n][k] = *(const LAS bf16x8*)(lds + G8_SBR(b, h) + boff + n * 2048 + k * 1024); } } while (0)
#define G8_MMA(ai, bj, At, Bt) do { __builtin_amdgcn_s_setprio(1); if constexpr (F8W != 0u) { _Pragma("unroll") for (int m = 0; m < 4; ++m) _Pragma("unroll") for (int n = 0; n < 2; ++n) \
        acc[ai][bj][m][n] = __builtin_amdgcn_mfma_scale_f32_16x16x128_f8f6f4(Bt##8[n], At##8[m], acc[ai][bj][m][n], 0, 0, 0, (int)F8W, 0, (int)F8W); } else { \
        _Pragma("unroll") for (int m = 0; m < 4; ++m) _Pragma("unroll") for (int n = 0; n < 2; ++n) _Pragma("unroll") for (int k = 0; k < 2; ++k) \
        acc[ai][bj][m][n] = __builtin_amdgcn_mfma_f32_16x16x32_bf16(Bt[n][k], At[m][k], acc[ai][bj][m][n], 0, 0, 0); } __builtin_amdgcn_s_setprio(0); } while (0)
#define G8_LDA_H(b, h, mh) do { _Pragma("unroll") for (int m = 0; m < 2; ++m) At8[m] = __builtin_shufflevector(*(const LAS v4i_t*)(lds + G8_SA(b, h) + aoff + ((mh) * 2 + m) * 2048), *(const LAS v4i_t*)(lds + G8_SA(b, h) + aoff + ((mh) * 2 + m) * 2048 + 1024), 0, 1, 2, 3, 4, 5, 6, 7); } while (0)
#define G8_MMA_H(ai, bj, Bt, mh) do { __builtin_amdgcn_s_setprio(1); _Pragma("unroll") for (int m = 0; m < 2; ++m) _Pragma("unroll") for (int n = 0; n < 2; ++n) \
        acc[ai][bj][(mh) * 2 + m][n] = __builtin_amdgcn_mfma_scale_f32_16x16x128_f8f6f4(Bt##8[n], At8[m], acc[ai][bj][(mh) * 2 + m][n], 0, 0, 0, (int)F8W, 0, (int)F8W); __builtin_amdgcn_s_setprio(0); } while (0)
#define G8_WAIT_V(n) asm volatile("s_waitcnt vmcnt(" #n ")" ::: "memory")
#define G8_WAIT_L(n) asm volatile("s_waitcnt lgkmcnt(" #n ")" ::: "memory")
#define G8_BAR __builtin_amdgcn_s_barrier()
#define G8_SCHED __builtin_amdgcn_sched_barrier(0)
    Unit cur, nxt; int ui = 0;
    if (!S.next(0, cur)) return;
    f32x4 acc[2][2][4][2]; const float z0 = ozero();
#pragma unroll
    for (int a = 0; a < 2; ++a)
#pragma unroll
        for (int b = 0; b < 2; ++b)
#pragma unroll
            for (int m = 0; m < 4; ++m)
#pragma unroll
                for (int n = 0; n < 2; ++n) acc[a][b][m][n] = (f32x4){z0, z0, z0, z0};
    bf16x8 At[4][2], B0[2][2], B1[2][2]; v8i_t At8[4], B08[2], B18[2];
    unsigned cA = 0u;
    LAS unsigned* gtab = (LAS unsigned*)(lds + STAGE_BYTES + 4096) + tid * 4;
#define G8_GOFF(p, unit) do { u32x4 o_; { int R_, C_; stage_rc(tid * 16, R_, C_); o_.x = S.arow(unit, R_) + (unsigned)C_ * 2u; o_.z = S.arow(unit, HALF + R_) + (unsigned)C_ * 2u; } \
        { int R_, C_; stage_rc(tid * 16 + 8192, R_, C_); o_.y = S.arow(unit, R_) + (unsigned)C_ * 2u; o_.w = S.arow(unit, HALF + R_) + (unsigned)C_ * 2u; } *(LAS u32x4*)(gtab + (p) * 2048) = o_; } while (0)
#define G8_STAGE_G(bufoff, soff, p, h) do { const u32x2 v_ = *(const LAS u32x2*)(gtab + (p) * 2048 + (h) * 2); \
        __builtin_amdgcn_raw_ptr_buffer_load_lds(rsA, (LAS unsigned*)(lds + (bufoff) + ldsw), 16, (int)v_.x, (int)(soff), 0, 0); \
        __builtin_amdgcn_raw_ptr_buffer_load_lds(rsA, (LAS unsigned*)(lds + (bufoff) + ldsw + 8192), 16, (int)v_.y, (int)(soff), 0, 0); } while (0)
    if constexpr (GATHER) { G8_GOFF(0, cur); cA = 0u; } else { cA = S.aoffs(cur); }
    unsigned cB = S.boffs(cur);
#define G8_STA_C(bufoff, h, kb) do { if constexpr (GATHER) { G8_STAGE_G(bufoff, cA + (kb), ui & 1, h); } else { G8_STAGE(bufoff, rsA, cA + (h) * hstepA + (kb), voffA); } } while (0)
    G8_STAGE(G8_SB(0, 0), rsB, cB, voffB); G8_STAGE(G8_SB(0, 1), rsB, cB + hstepB, voffB); G8_STA_C(G8_SA(0, 0), 0, 0); G8_STA_C(G8_SA(0, 1), 1, 0);
    if (wr == 1) G8_BAR;
    G8_WAIT_V(2); G8_BAR;
    G8_STAGE(G8_SB(1, 0), rsB, cB + kstep, voffB); G8_STA_C(G8_SA(1, 0), 0, kstep); G8_STAGE(G8_SB(1, 1), rsB, cB + hstepB + kstep, voffB);
    G8_WAIT_V(6); G8_BAR;
    for (;;) {
        const bool has_next = S.next(ui + 1, nxt);
        unsigned nA = cA; const unsigned nB = has_next ? S.boffs(nxt) : cB;
        if constexpr (GATHER) { if (has_next) { G8_GOFF((ui + 1) & 1, nxt); } else { G8_GOFF((ui + 1) & 1, cur); } } else { nA = has_next ? S.aoffs(nxt) : cA; }
#pragma nounroll
        for (int t = 0; t < nt; t += 2) {
            const bool last = (t == nt - 2);
            const unsigned k1 = (unsigned)(t + 1) * kstep;
            const unsigned b2 = last ? nB : cB + (unsigned)(t + 2) * kstep; const unsigned b3 = b2 + kstep;
            unsigned a2 = 0u;
            if constexpr (GATHER) { a2 = last ? cA : cA + (unsigned)(t + 2) * kstep; } else { a2 = last ? nA : cA + (unsigned)(t + 2) * kstep; }
            const unsigned a3 = a2 + kstep;
#define G8_STA_2(bufoff, h, base) do { if constexpr (GATHER) { G8_STAGE_G(bufoff, base, (ui + (last ? 1 : 0)) & 1, h); } else { G8_STAGE(bufoff, rsA, (base) + (h) * hstepA, voffA); } } while (0)
            G8_LDB(B0, 0, 0); G8_LDB(B1, 0, 1); G8_SCHED; G8_LDA(At, 0, 0); G8_STA_C(G8_SA(1, 1), 1, k1);
            G8_WAIT_V(8); G8_WAIT_L(0); G8_BAR; G8_MMA(0, 0, At, B0); G8_MMA(0, 1, At, B1); G8_BAR; G8_SCHED;
            G8_LDA(At, 0, 1); G8_STAGE(G8_SB(0, 0), rsB, b2, voffB); G8_STAGE(G8_SB(0, 1), rsB, b2 + hstepB, voffB); G8_STA_2(G8_SA(0, 0), 0, a2);
            G8_WAIT_V(8); G8_WAIT_L(0); G8_BAR; G8_MMA(1, 0, At, B0); G8_MMA(1, 1, At, B1); G8_BAR; G8_SCHED;
            G8_LDB(B0, 1, 0); G8_LDB(B1, 1, 1); G8_SCHED; G8_LDA(At, 1, 0); G8_STA_2(G8_SA(0, 1), 1, a2);
            G8_WAIT_V(8); G8_WAIT_L(0); G8_BAR; G8_MMA(0, 0, At, B0); G8_MMA(0, 1, At, B1); G8_BAR; G8_SCHED;
            G8_LDA(At, 1, 1); G8_STAGE(G8_SB(1, 0), rsB, b3, voffB); G8_STAGE(G8_SB(1, 1), rsB, b3 + hstepB, voffB); G8_STA_2(G8_SA(1, 0), 0, a3);
            G8_WAIT_V(8); G8_WAIT_L(0); G8_BAR; G8_MMA(1, 0, At, B0); G8_MMA(1, 1, At, B1); G8_BAR; G8_SCHED;
#undef G8_STA_2
        }
        if (wr == 0) G8_BAR;
        { int te = tid; asm volatile("" : "+v"(te)); const int fre = te & 15, fqe = (te & 63) >> 4;
          E(acc, cur, wr, wc, fre, fqe); }
        if (!has_next) break;
#pragma unroll
        for (int a = 0; a < 2; ++a)
#pragma unroll
            for (int b = 0; b < 2; ++b)
#pragma unroll
                for (int m = 0; m < 4; ++m)
#pragma unroll
                    for (int n = 0; n < 2; ++n) acc[a][b][m][n] = (f32x4){z0, z0, z0, z0};
        cur = nxt; cB = nB; ++ui;
        if constexpr (!GATHER) { cA = nA; }
        if (wr == 1) G8_BAR;
    }
    G8_WAIT_V(0);
    G8_BAR;
#undef G8_STA_C
#undef G8_GOFF
#undef G8_STAGE_G
#undef G8_SA
#undef G8_SB
#undef G8_SBR
#undef G8_STAGE
#undef p1voffA
#undef p1voffB
#undef G8_LDA
#undef G8_LDB
#undef G8_MMA
#undef G8_MMA_H
#undef G8_LDA_H
#undef G8_WAIT_V
#undef G8_WAIT_L
#undef G8_BAR
#undef G8_SCHED
}

struct DenseOrder {
    const char* A; const char* Bt; int lda, K, nM, nN, nwg, G, c;
    DI void init(const bf16_t* A_, int lda_, const bf16_t* Bt_, int K_, int M_, int N_, int G_, int c_) { A = (const char*)A_; Bt = (const char*)Bt_; lda = lda_; K = K_; nM = M_ / BM; nN = N_ / BM; nwg = nM * nN; G = G_; c = c_; }
    DI bool next(int i, Unit& u) const {
        const long L = (long)i * G + c; if (L >= nwg) return false;
        int wgid = (int)L; { const int q = nwg / 8, r = nwg % 8, xcd = wgid % 8, off = wgid / 8; wgid = (xcd < r ? xcd * (q + 1) : r * (q + 1) + (xcd - r) * q) + off; }
        const int nig = 8 * nN, gid = wgid / nig, fm = gid * 8, gsz = (nM - fm) < 8 ? (nM - fm) : 8;
        u.pm = fm + ((wgid % nig) % gsz); u.pn = (wgid % nig) / gsz; u.orow = u.pm * BM; u.e = 0; u.kh = 0; return true;
    }
    DI unsigned aoffs(const Unit& u) const { return (unsigned)u.pm * (unsigned)(BM * 2) * (unsigned)lda; }
    DI unsigned boffs(const Unit& u) const { return (unsigned)u.pn * (unsigned)(BM * 2) * (unsigned)K; }
    DI const char* bmat() const { return Bt; }
    DI unsigned arow(const Unit&, int) const { return 0u; }
};
}

constexpr int TAB_OFF = 131072 + 1024;
DI void moe_tables(const Ctx& C, const unsigned* cnt, int gran) {
    __syncthreads();
    if (C.tid == 0) { LAS int* tst = (LAS int*)(C.lds + TAB_OFF); LAS int* pst = tst + 16; int a1 = 0, a2 = 0;
        for (int e = 0; e < 8; ++e) { const int c = (int)cnt[e]; tst[e] = a1; pst[e] = a2; a1 += (c + gran - 1) / gran; a2 += (c + 255) / 256 * 256; }
        tst[8] = a1; }
    __syncthreads();
}

namespace g8 {
struct MoeOrder {
    const int* ltok; const unsigned* cnt; const LAS int* tst; const LAS int* pst; const char* A; const char* Bt; size_t bstride; int lda, K, nN, nU, G, c; bool xs;
    int L0, nL, kparts, kbytes;
    DI void init(const Ctx& C, const unsigned* cnt_, const char* A_, int lda_, const char* Bt_, size_t bstride_, int K_, int N_) {
        ltok = (const int*)(C.ws + WS_MOE + MOE_LTOK); cnt = cnt_; tst = (const LAS int*)(C.lds + TAB_OFF); pst = tst + 16; A = A_; Bt = Bt_; bstride = bstride_; lda = lda_; K = K_; nN = N_ / BM; xs = false;
        nU = tst[8] * nN; G = gridDim.x; c = blockIdx.x; L0 = 0; nL = nU; kparts = 1; kbytes = 0; }
    DI bool next(int i, Unit& u) const {
        const int j = i * G + c; if (j >= nL * kparts) return false;
        const int L = L0 + j / kparts; u.kh = j % kparts;
        const int tile = L / nN; int e = 0;
#pragma unroll
        for (int q = 1; q < 8; ++q) if (tile >= tst[q]) e = q;
        e = __builtin_amdgcn_readfirstlane(e);
        u.e = e; u.pm = tile - tst[e]; u.pn = L % nN; u.orow = pst[e] + u.pm * BM; return true;
    }
    DI unsigned arow(const Unit& u, int lr) const { const int r = u.pm * BM + lr; const int tok = (r < (int)cnt[u.e]) ? ltok[u.e * 16384 + r] : 0; return (unsigned)tok * (unsigned)lda * 2u; }
    DI unsigned aoffs(const Unit& u) const { return (xs ? (unsigned)(u.e * 16384 + u.pm * BM) : (unsigned)u.orow) * (unsigned)lda * 2u + (unsigned)(u.kh * kbytes); }
    DI unsigned boffs(const Unit& u) const { return (unsigned)u.e * (unsigned)bstride + (unsigned)u.pn * (unsigned)(BM * 2) * (unsigned)K + (unsigned)(u.kh * kbytes); }
    DI const char* bmat() const { return Bt; }
};
struct EpiPartialF32 {
    static constexpr bool PERM = false;
    float* O; int row0; unsigned part_bytes;
    DI void operator()(const f32x4 (&acc)[2][2][4][2], const Unit& u, int wr, int wc, int fr, int fq) const {
        const __amdgpu_buffer_rsrc_t rs = __builtin_amdgcn_make_buffer_rsrc((void*)O, (short)0, -1, 0x00020000);
        const int voff = ((wr * 64 + fr) * DM + wc * 32 + 4 * fq) * 4; const unsigned sbase = (unsigned)u.kh * part_bytes + (unsigned)((u.orow - row0) * DM + u.pn * BM) * 4u;
#pragma unroll
        for (int ai = 0; ai < 2; ++ai)
#pragma unroll
            for (int m = 0; m < 4; ++m)
#pragma unroll
                for (int bj = 0; bj < 2; ++bj)
#pragma unroll
                    for (int n = 0; n < 2; ++n) { const f32x4 v = acc[ai][bj][m][n]; u32x4 w; w.x = __float_as_uint(v[0]); w.y = __float_as_uint(v[1]); w.z = __float_as_uint(v[2]); w.w = __float_as_uint(v[3]);
                        __builtin_amdgcn_raw_buffer_store_b128(w, rs, voff, (int)(sbase + (unsigned)(((ai * HALF + m * 16) * DM + bj * HALF + n * 16) * 4)), 0); }
    }
};
}

DI void phase_conv(Ctx C, int layer) {
    const bf16_t* U = (const bf16_t*)(C.ws + WS_U); bf16_t* MX = (bf16_t*)(C.ws + WS_MIXED);
    LAS float* z = (LAS float*)C.lds;
    const int ch = C.tid & 255, half = C.tid >> 8;
    float w[CONVK];
#pragma unroll
    for (int i = 0; i < CONVK; ++i) w[i] = INF(I_CONVW)[(size_t)layer * CONVK * CONVC + i * CONVC + ch];
    const float bias = INF(I_CONVB)[layer * CONVC + ch];
    for (int it = blockIdx.x; it < M / 64; it += gridDim.x) {
        const int b = it / (SEQ / 64), t0 = (it % (SEQ / 64)) * 64;
        __syncthreads();
        { u32x4 ra[6], rg[6];
#pragma unroll
          for (int q = 0; q < 6; ++q) { const int p = C.tid + q * NTHREADS; const int i = p >> 5, c8 = (p & 31) * 8, t = t0 - 30 + i;
              if (p < 94 * 32 && t >= 0) { const size_t m = (size_t)b * SEQ + t; ra[q] = *(const u32x4*)(U + m * INCP + c8); rg[q] = *(const u32x4*)(U + m * INCP + 256 + c8); }
              else { ra[q] = (u32x4){0u, 0u, 0u, 0u}; rg[q] = (u32x4){0u, 0u, 0u, 0u}; } }
#pragma unroll
          for (int q = 0; q < 6; ++q) { const int p = C.tid + q * NTHREADS; const int i = p >> 5, c8 = (p & 31) * 8;
              if (p < 94 * 32) { float a[8], g[8], zz[8]; unpack8(ra[q], a); unpack8(rg[q], g);
#pragma unroll
                  for (int e = 0; e < 8; ++e) zz[e] = a[e] * fsigmoid(g[e]);
                  *(LAS f32x4*)(z + i * 256 + c8) = (f32x4){zz[0], zz[1], zz[2], zz[3]}; *(LAS f32x4*)(z + i * 256 + c8 + 4) = (f32x4){zz[4], zz[5], zz[6], zz[7]}; } } }
        __syncthreads();
        float o[32];
        { float zr[62];
#pragma unroll
          for (int i = 0; i < 62; ++i) zr[i] = z[(half * 32 + i) * 256 + ch];
#pragma unroll
          for (int tt = 0; tt < 32; ++tt) { float acc = bias;
#pragma unroll
              for (int i = 0; i < CONVK; ++i) acc += zr[tt + i] * w[i];
              o[tt] = acc; } }
        __syncthreads();
#pragma unroll
        for (int tt = 0; tt < 32; ++tt) z[(half * 32 + tt) * 256 + ch] = o[tt];
        __syncthreads();
        for (int tt = C.wave * 8; tt < C.wave * 8 + 8; ++tt) {
            const f32x4 v = *(const LAS f32x4*)(z + tt * 256 + C.lane * 4);
            const float mean = wave_sum(v.x + v.y + v.z + v.w) * (1.f / 256.f);
            const f32x4 d = v - mean;
            const float var = wave_sum(d.x * d.x + d.y * d.y + d.z * d.z + d.w * d.w) * (1.f / 256.f);
            const float rs = rsqrtf(var + 1e-5f);
            const f32x4 lg = *(const f32x4*)(INF(I_CONVLG) + layer * 256 + C.lane * 4), lb = *(const f32x4*)(INF(I_CONVLB) + layer * 256 + C.lane * 4);
            f32x4 y = d * rs * lg + lb;
            u32x2 o2; o2.x = pk2(siluf_(y.x), siluf_(y.y)); o2.y = pk2(siluf_(y.z), siluf_(y.w));
            *(u32x2*)(MX + ((size_t)b * SEQ + t0 + tt) * DM + C.lane * 4) = o2;
        }
    }
    __syncthreads();
}

DI void phase_prep1(Ctx C, int layer) {
    bf16_t* U = (bf16_t*)(C.ws + WS_U);
    bf16_t* RR = (bf16_t*)(C.ws + WS_RR); bf16_t* RK = (bf16_t*)(C.ws + WS_RK); bf16_t* RV = (bf16_t*)(C.ws + WS_RV); bf16_t* RKK = (bf16_t*)(C.ws + WS_RKK); bf16_t* LIN = (bf16_t*)(C.ws + WS_LIN);
    const int l = C.lane;
    float mu[16], kkw[16];
    { const float* mup = INF(I_RMU) + layer * 1024 + l * 16;
#pragma unroll
      for (int i = 0; i < 16; i += 4) { const f32x4 t4 = ld4(mup + i); mu[i] = t4.x; mu[i + 1] = t4.y; mu[i + 2] = t4.z; mu[i + 3] = t4.w; }
      const float* kp = INF(I_RKK) + layer * RC + ((l >= 16 && l < 32) ? (l - 16) * 16 : 0);
#pragma unroll
      for (int i = 0; i < 16; i += 4) { const f32x4 t4 = ld4(kp + i); kkw[i] = t4.x; kkw[i + 1] = t4.y; kkw[i + 2] = t4.z; kkw[i + 3] = t4.w; } }
    const f32x4 gq = ld4(INF(I_QNG) + layer * 256 + l * 4); const f32x2 gkv = *(const f32x2*)(INF(I_KVNG) + layer * 128 + l * 2);
    const int rpw = (M + C.NGW - 1) / C.NGW, m0 = C.gw * rpw, m1 = (m0 + rpw < M) ? m0 + rpw : M;
    bf16_t* dst0 = (l < 16) ? RR + l * 16 : (l < 32) ? RK + (l - 16) * 16 : (l < 48) ? RV + (l - 32) * 16 : LIN + (l - 48) * 16; const int dpitch = RC;
    const bool actraw = (l >= 52 && l < 56); const float acta = (l < 52) ? 2.f : 1.f, actb = (l < 52) ? 2.f : 1.f, actc = (l < 52) ? -1.f : 0.f;
    float prv[16];
    u32x4 nr0, nr1; u32x2 nq; unsigned nkv;
    if (m0 < m1) { const bf16_t* rw = U + (size_t)m0 * INCP; nr0 = *(const u32x4*)(rw + U_RW + l * 16); nr1 = *(const u32x4*)(rw + U_RW + l * 16 + 8); nq = *(const u32x2*)(rw + U_CQ + l * 4); nkv = *(const unsigned*)(rw + U_CKV + l * 2); }
    for (int m = m0; m < m1; ++m) {
        bf16_t* row = U + (size_t)m * INCP;
        float cur[16]; unpack8(nr0, cur); unpack8(nr1, cur + 8);
        const u32x2 w = nq; const unsigned w2 = nkv;
        if (m + 1 < m1) { const bf16_t* rw = row + INCP; nr0 = *(const u32x4*)(rw + U_RW + l * 16); nr1 = *(const u32x4*)(rw + U_RW + l * 16 + 8); nq = *(const u32x2*)(rw + U_CQ + l * 4); nkv = *(const unsigned*)(rw + U_CKV + l * 2); }
        if (m == m0) { if (m % SEQ != 0) { unpack8(*(const u32x4*)(row - INCP + U_RW + l * 16), prv); unpack8(*(const u32x4*)(row - INCP + U_RW + l * 16 + 8), prv + 8); } }
        if (m % SEQ == 0) {
#pragma unroll
            for (int i = 0; i < 16; ++i) prv[i] = 0.f; }
        { const float v0 = bflo(w.x), v1 = bfhi(w.x), v2 = bflo(w.y), v3 = bfhi(w.y);
          const float c0 = bflo(w2), c1 = bfhi(w2);
          float sq = v0 * v0 + v1 * v1 + v2 * v2 + v3 * v3, sk = c0 * c0 + c1 * c1;
#pragma unroll
          for (int o = 1; o < 32; o <<= 1) { sq += shx(sq, o); sk += shx(sk, o); }
          sq = shx32_sum(sq); sk = shx32_sum(sk);
          const float rq = rsqrtf(sq * (1.f / 256.f) + 1e-6f), rk = rsqrtf(sk * (1.f / 128.f) + 1e-6f);
          u32x2 o; o.x = pk2(v0 * rq * gq.x, v1 * rq * gq.y); o.y = pk2(v2 * rq * gq.z, v3 * rq * gq.w); *(u32x2*)(row + U_CQ + l * 4) = o;
          *(unsigned*)(row + U_CKV + l * 2) = pk2(c0 * rk * gkv.x, c1 * rk * gkv.y); }
        float uf[16];
#pragma unroll
        for (int i = 0; i < 16; ++i) { uf[i] = cur[i] + (prv[i] - cur[i]) * mu[i]; prv[i] = cur[i]; }
        float kk[16]; float ss = 0.f;
#pragma unroll
        for (int i = 0; i < 16; ++i) { kk[i] = uf[i] * kkw[i]; ss += kk[i] * kk[i]; }
        ss += shx(ss, 1); ss += shx(ss, 2);
        const float inrm = 1.f / fmaxf(sqrtf(ss), 1e-12f);
        if (l >= 48) {
#pragma unroll
            for (int i = 0; i < 16; ++i) { const float sg = __builtin_amdgcn_rcpf(1.f + __expf(-actb * uf[i])); uf[i] = actraw ? uf[i] : acta * sg + actc; } }
        *(u32x4*)(dst0 + (size_t)m * dpitch) = pack8(uf); *(u32x4*)(dst0 + (size_t)m * dpitch + 8) = pack8(uf + 8);
        if (l >= 16 && l < 32) {
#pragma unroll
            for (int i = 0; i < 16; ++i) kk[i] *= inrm;
            *(u32x4*)(RKK + (size_t)m * RC + (l - 16) * 16) = pack8(kk); *(u32x4*)(RKK + (size_t)m * RC + (l - 16) * 16 + 8) = pack8(kk + 8); }
    }
}

namespace g8 {
struct UpOrder {
    int layer, G, c;
    DI bool next(int i, Unit& u) const {
        const int L = i * G + c; if (L >= 640) return false;
        if (L < 256) { u.e = 1; u.pm = L & 63; u.pn = L >> 6; }
        else if (L < 448) { const int q = L - 256; u.e = 0; u.pm = q & 63; u.pn = q >> 6; }
        else { const int q = L - 448; u.e = 2; u.pm = q & 63; u.pn = q >> 6; }
        u.orow = u.pm * BM; u.kh = 0; return true;
    }
    DI unsigned arow(const Unit& u, int lr) const {
        const unsigned r = (unsigned)(u.pm * BM + lr);
        return (u.e == 2) ? (unsigned)WS_LIN + r * 512u : (unsigned)WS_U + r * (unsigned)(INCP * 2) + (unsigned)((u.e == 0 ? U_CQ : U_CKV) * 2);
    }
    DI unsigned aoffs(const Unit&) const { return 0u; }
    DI size_t boff(const Unit& u) const {
        return (u.e == 0 ? WS_WUQ + (size_t)layer * 768 * 256 * 2 : u.e == 1 ? WS_WUKV + (size_t)layer * 1024 * 256 * 2 : WS_LORA + (size_t)layer * 768 * 256 * 2) + (size_t)u.pn * BM * 256 * 2;
    }
    const char* ws;
    DI unsigned boffs(const Unit& u) const { return (unsigned)boff(u); }
    DI const char* bmat() const { return ws; }
};
struct EpiStore3 {
    static constexpr bool PERM = true;
    unsigned char* ws;
    DI void operator()(const f32x4 (&acc)[2][2][4][2], const Unit& u, int wr, int wc, int fr, int fq) const {
        const int ldc = (u.e == 1) ? 1024 : 768;
        bf16_t* O = (bf16_t*)(ws + (u.e == 0 ? WS_QRAW : u.e == 1 ? WS_KVRAW : WS_LOUT));
        EpiStore E{O, ldc}; E(acc, u, wr, wc, fr, fq);
    }
};
}
DI void phase_upgemms(Ctx C, int layer) {
    g8::UpOrder S; S.layer = layer; S.G = gridDim.x; S.c = blockIdx.x; S.ws = (const char*)C.ws;
    g8::EpiStore3 E{C.ws};
    g8::gemm_phase<g8::EpiStore3, g8::UpOrder, true>(C.tid, C.lds, (const bf16_t*)C.ws, 0, 256, S, E);
}

DI void phase_prep2(Ctx C, int layer) {
    const bf16_t* U = (const bf16_t*)(C.ws + WS_U); const bf16_t* QR = (const bf16_t*)(C.ws + WS_QRAW); const bf16_t* KVR = (const bf16_t*)(C.ws + WS_KVRAW);
    bf16_t* Q = (bf16_t*)(C.ws + WS_Q); bf16_t* K = (bf16_t*)(C.ws + WS_K); bf16_t* V = (bf16_t*)(C.ws + WS_VT);
    const float* cs = (const float*)(C.ws + WS_COS); const float* sn = (const float*)(C.ws + WS_SIN);
    const float qscale = 0.10206207261596575f * 1.4426950408889634f;
    const int l = C.lane, hd = l >> 3, sub = l & 7;
    float gqn[8], gkn[8], gqr[4], gkr[4];
#pragma unroll
    for (int i = 0; i < 8; ++i) { gqn[i] = INF(I_QKQ)[layer * 96 + sub * 8 + i]; gkn[i] = INF(I_QKK)[layer * 96 + sub * 8 + i]; }
#pragma unroll
    for (int i = 0; i < 4; ++i) { gqr[i] = INF(I_QKQ)[layer * 96 + 64 + sub * 4 + i]; gkr[i] = INF(I_QKK)[layer * 96 + 64 + sub * 4 + i]; }
    const int rpw = (M + C.NGW - 1) / C.NGW, m0 = C.gw * rpw, m1 = (m0 + rpw < M) ? m0 + rpw : M;
    const bool vt_lds = (rpw == 8) && (M % (8 * rpw) == 0);
    LAS bf16_t* vst = (LAS bf16_t*)C.lds;
    u32x4 nqn, nkn, nv; u32x2 nqr, nkr;
#define P2_LOAD(mm) do { nqn = *(const u32x4*)(QR + (size_t)(mm) * 768 + hd * 96 + sub * 8); nqr = *(const u32x2*)(QR + (size_t)(mm) * 768 + hd * 96 + 64 + sub * 4); \
        nkn = *(const u32x4*)(KVR + (size_t)(mm) * 1024 + hd * 128 + sub * 8); nkr = *(const u32x2*)(U + (size_t)(mm) * INCP + U_KR + sub * 4); \
        nv = *(const u32x4*)(KVR + (size_t)(mm) * 1024 + hd * 128 + 64 + sub * 8); } while (0)
    if (m0 < m1) P2_LOAD(m0);
    for (int m = m0; m < m1; ++m) {
        const int b = m / SEQ, t = m % SEQ, bh = b * NH + hd;
        float qn[8], kn[8]; unpack8(nqn, qn); unpack8(nkn, kn);
        float qr[4] = {bflo(nqr.x), bfhi(nqr.x), bflo(nqr.y), bfhi(nqr.y)}, kr[4] = {bflo(nkr.x), bfhi(nkr.x), bflo(nkr.y), bfhi(nkr.y)};
        const u32x4 vraw = nv;
        if (m + 1 < m1) P2_LOAD(m + 1);
        const f32x4 c4 = ld4(cs + m * 16 + (sub & 3) * 4), s4 = ld4(sn + m * 16 + (sub & 3) * 4);
        float sq = 0.f, sk = 0.f;
#pragma unroll
        for (int i = 0; i < 8; ++i) { sq += qn[i] * qn[i]; sk += kn[i] * kn[i]; }
#pragma unroll
        for (int i = 0; i < 4; ++i) { sq += qr[i] * qr[i]; sk += kr[i] * kr[i]; }
#pragma unroll
        for (int o = 1; o < 8; o <<= 1) { sq += shx(sq, o); sk += shx(sk, o); }
        const float rq = rsqrtf(sq * (1.f / 96.f) + 1e-6f), rk = rsqrtf(sk * (1.f / 96.f) + 1e-6f);
#pragma unroll
        for (int i = 0; i < 8; ++i) { qn[i] *= rq * gqn[i] * qscale; kn[i] *= rk * gkn[i]; }
        float qo4[4], ko4[4];
#pragma unroll
        for (int i = 0; i < 4; ++i) { const float qv = qr[i] * rq * gqr[i], kv = kr[i] * rk * gkr[i]; const float qp = shx(qv, 4), kp = shx(kv, 4);
            const float cc = c4[i], ss = s4[i];
            qo4[i] = ((sub < 4) ? (qv * cc - qp * ss) : (qp * ss + qv * cc)) * qscale;
            ko4[i] = (sub < 4) ? (kv * cc - kp * ss) : (kp * ss + kv * cc); }
        bf16_t* qo = Q + ((size_t)bh * SEQ + t) * DQK; bf16_t* ko = K + ((size_t)bh * SEQ + t) * DQK;
        *(u32x4*)(qo + sub * 8) = pack8(qn); *(u32x4*)(ko + sub * 8) = pack8(kn);
        u32x2 w2; w2.x = pk2(qo4[0], qo4[1]); w2.y = pk2(qo4[2], qo4[3]); *(u32x2*)(qo + 64 + sub * 4) = w2;
        w2.x = pk2(ko4[0], ko4[1]); w2.y = pk2(ko4[2], ko4[3]); *(u32x2*)(ko + 64 + sub * 4) = w2;
        if (vt_lds) *(LAS u32x4*)(vst + ((C.wave * 8 + (m - m0)) * 512 + hd * 64 + sub * 8)) = vraw;
        else {
#pragma unroll
            for (int e = 0; e < 8; ++e) V[((size_t)bh * DV + sub * 8 + e) * SEQ + t] = (bf16_t)(((e & 1) ? (vraw[e >> 1] >> 16) : (vraw[e >> 1] & 0xffffu))); }
    }
#undef P2_LOAD
    if (vt_lds) {
        __syncthreads();
        const int hd2 = C.tid >> 6, d2 = C.tid & 63, mb0 = blockIdx.x * 64, b2 = mb0 / SEQ, t0 = mb0 % SEQ;
        unsigned w[32];
#pragma unroll
        for (int i = 0; i < 32; ++i) w[i] = (unsigned)vst[(2 * i) * 512 + hd2 * 64 + d2] | ((unsigned)vst[(2 * i + 1) * 512 + hd2 * 64 + d2] << 16);
        bf16_t* dst = V + ((size_t)(b2 * NH + hd2) * DV + d2) * SEQ + t0;
#pragma unroll
        for (int i = 0; i < 8; ++i) *(u32x4*)(dst + 8 * i) = (u32x4){w[4 * i], w[4 * i + 1], w[4 * i + 2], w[4 * i + 3]};
        __syncthreads();
    }
}

DI void phase_attn2(Ctx C, unsigned* qhead, int layer) {
    constexpr int KP = 104, VP = 68, KBYTES = 64 * KP * 2, SLOT = KBYTES + 64 * VP * 2 + 64;
    LAS unsigned char* lds = C.lds;
    const bf16_t* Q = (const bf16_t*)(C.ws + WS_Q); const bf16_t* K = (const bf16_t*)(C.ws + WS_K); const bf16_t* V = (const bf16_t*)(C.ws + WS_VT); bf16_t* MX = (bf16_t*)(C.ws + WS_MIXED);
    const int tid = C.tid, lane = C.lane, wid = C.wave, r = lane & 31, h = lane >> 5;
    const int kp0 = tid, kp1 = tid + 512;
    const int kr0 = kp0 / 12, kc0 = (kp0 % 12) * 8, kr1 = kp1 / 12, kc1 = (kp1 % 12) * 8;
    const int vr = tid >> 3, vc = (tid & 7) * 8;
    volatile LAS int* qslot = (volatile LAS int*)(lds + 131072 + 2048);
    float gqm = 0.f, gkm = 0.f;
    for (int i = lane; i < 96; i += 64) { gqm = fmaxf(gqm, fabsf(INF(I_QKQ)[layer * 96 + i])); gkm = fmaxf(gkm, fabsf(INF(I_QKK)[layer * 96 + i])); }
    gqm = wave_max(gqm); gkm = wave_max(gkm);
    const float shift = 9.797958971132712f * 1.4426950408889634f * gqm * gkm * 1.02f + 0.5f;
    f32x16 negc;
#pragma unroll
    for (int q = 0; q < 16; ++q) negc[q] = -shift;
    for (;;) {
        __syncthreads();
        if (tid == 0) qslot[0] = (int)__hip_atomic_fetch_add(qhead, 1u, __ATOMIC_RELAXED, __HIP_MEMORY_SCOPE_AGENT);
        __syncthreads();
        const int item = __builtin_amdgcn_readfirstlane(qslot[0]);
        if (item >= 512) break;
        {
        const int bh = item & 31, b = bh >> 3, hh = bh & 7;
        const bf16_t* Kg = K + (size_t)bh * SEQ * DQK; const bf16_t* Vg = V + (size_t)bh * DV * SEQ;
        {
            const int qb = 15 - (item >> 5), NT = 4 * qb + 4, qmin = 256 * qb + 32 * wid;
            bf16x8 qf[6];
            { const bf16_t* qp = Q + ((size_t)bh * SEQ + qmin + r) * DQK + 8 * h;
#pragma unroll
              for (int sx = 0; sx < 6; ++sx) qf[sx] = *(const bf16x8*)(qp + 16 * sx); }
            u32x4 kg0, kg1, vg;
            kg0 = *(const u32x4*)(Kg + (size_t)kr0 * DQK + kc0); if (tid < 256) kg1 = *(const u32x4*)(Kg + (size_t)kr1 * DQK + kc1); vg = *(const u32x4*)(Vg + (size_t)vr * SEQ + vc);
#define ATT_WRITE(slot) do { LAS unsigned char* sb_ = lds + (slot) * SLOT; *(LAS u32x4*)(sb_ + (kr0 * KP + kc0) * 2) = kg0; if (tid < 256) *(LAS u32x4*)(sb_ + (kr1 * KP + kc1) * 2) = kg1; \
                LAS bf16_t* vt_ = (LAS bf16_t*)(sb_ + KBYTES); *(LAS u32x2*)(vt_ + vr * VP + vc) = (u32x2){vg.x, vg.y}; *(LAS u32x2*)(vt_ + vr * VP + vc + 4) = (u32x2){vg.z, vg.w}; } while (0)
            ATT_WRITE(0);
            { const size_t ko = 64; kg0 = *(const u32x4*)(Kg + (ko + kr0) * DQK + kc0); if (tid < 256) kg1 = *(const u32x4*)(Kg + (ko + kr1) * DQK + kc1); vg = *(const u32x4*)(Vg + (size_t)vr * SEQ + ko + vc); }
            __syncthreads();
            f32x16 o[2]; float lrun = 0.f;
            { const float z0 = ozero();
#pragma unroll
            for (int q = 0; q < 16; ++q) { o[0][q] = z0; o[1][q] = z0; } }
#pragma unroll 2
            for (int t = 0; t < NT; ++t) {
                u32x4 ng0 = kg0, ng1 = kg0, nvg = kg0;
                if (t + 2 < NT) { const size_t ko = (size_t)(t + 2) * 64;
                    ng0 = *(const u32x4*)(Kg + (ko + kr0) * DQK + kc0); if (tid < 256) ng1 = *(const u32x4*)(Kg + (ko + kr1) * DQK + kc1); nvg = *(const u32x4*)(Vg + (size_t)vr * SEQ + ko + vc); }
                const int key0 = 64 * t;
                if (key0 <= qmin + 31) {
                    const LAS unsigned char* sb = lds + (t & 1) * SLOT;
                    const LAS bf16_t* kl = (const LAS bf16_t*)sb + r * KP + 8 * h; const LAS bf16_t* vl = (const LAS bf16_t*)(sb + KBYTES) + r * VP + 4 * h;
                    f32x16 p0 = negc, p1 = negc;
                    bf16x8 ka[6], kb[6];
#pragma unroll
                    for (int sx = 0; sx < 6; ++sx) { ka[sx] = *(const LAS bf16x8*)(kl + 16 * sx); kb[sx] = *(const LAS bf16x8*)(kl + 32 * KP + 16 * sx); }
                    __builtin_amdgcn_sched_barrier(0);
#pragma unroll
                    for (int sx = 0; sx < 6; ++sx) { p0 = __builtin_amdgcn_mfma_f32_32x32x16_bf16(ka[sx], qf[sx], p0, 0, 0, 0); p1 = __builtin_amdgcn_mfma_f32_32x32x16_bf16(kb[sx], qf[sx], p1, 0, 0, 0); }
                    u32x2 vlo[2][4], vhi[2][4];
#pragma unroll
                    for (int sx = 0; sx < 4; ++sx)
#pragma unroll
                        for (int db = 0; db < 2; ++db) { vlo[db][sx] = *(const LAS u32x2*)(vl + db * 32 * VP + 16 * sx); vhi[db][sx] = *(const LAS u32x2*)(vl + db * 32 * VP + 16 * sx + 8); }
                    __builtin_amdgcn_sched_barrier(0);
                    if (key0 + 63 > qmin) { const int qa = qmin + r;
#pragma unroll
                        for (int q = 0; q < 16; ++q) { const int ky = key0 + crow(q, h); if (ky > qa) p0[q] = -INFINITY; if (ky + 32 > qa) p1[q] = -INFINITY; } }
                    float ps = 0.f;
#pragma unroll
                    for (int q = 0; q < 16; ++q) { p0[q] = __builtin_amdgcn_exp2f(p0[q]); p1[q] = __builtin_amdgcn_exp2f(p1[q]); ps += p0[q] + p1[q]; }
                    lrun += ps;
#pragma unroll
                    for (int sx = 0; sx < 4; ++sx) {
                        u32x4 pw;
                        if (sx < 2) { pw.x = pk2(p0[8 * sx + 0], p0[8 * sx + 1]); pw.y = pk2(p0[8 * sx + 2], p0[8 * sx + 3]); pw.z = pk2(p0[8 * sx + 4], p0[8 * sx + 5]); pw.w = pk2(p0[8 * sx + 6], p0[8 * sx + 7]); }
                        else { const int s2 = sx - 2; pw.x = pk2(p1[8 * s2 + 0], p1[8 * s2 + 1]); pw.y = pk2(p1[8 * s2 + 2], p1[8 * s2 + 3]); pw.z = pk2(p1[8 * s2 + 4], p1[8 * s2 + 5]); pw.w = pk2(p1[8 * s2 + 6], p1[8 * s2 + 7]); }
                        const bf16x8 pf = __builtin_bit_cast(bf16x8, pw);
#pragma unroll
                        for (int db = 0; db < 2; ++db) { u32x4 vw4; vw4.x = vlo[db][sx].x; vw4.y = vlo[db][sx].y; vw4.z = vhi[db][sx].x; vw4.w = vhi[db][sx].y;
                            o[db] = __builtin_amdgcn_mfma_f32_32x32x16_bf16(__builtin_bit_cast(bf16x8, vw4), pf, o[db], 0, 0, 0); }
                    }
                }
                if (t + 1 < NT) ATT_WRITE((t + 1) & 1);
                kg0 = ng0; kg1 = ng1; vg = nvg;
                asm volatile("s_waitcnt lgkmcnt(0)" ::: "memory"); __builtin_amdgcn_s_barrier(); asm volatile("" ::: "memory");
            }
#undef ATT_WRITE
            lrun = shx32_sum(lrun);
            const float il = 1.f / lrun;
            bf16_t* orow = MX + ((size_t)b * SEQ + qmin + r) * DM + 256 + hh * 64;
#pragma unroll
            for (int db = 0; db < 2; ++db)
#pragma unroll
                for (int g = 0; g < 4; ++g) { u32x2 w2; w2.x = pk2(o[db][4 * g] * il, o[db][4 * g + 1] * il); w2.y = pk2(o[db][4 * g + 2] * il, o[db][4 * g + 3] * il); *(u32x2*)(orow + db * 32 + 8 * g + 4 * h) = w2; }
        }
        }
    }
}

namespace rk {
constexpr int PITCH = 72, BUFB = 64 * PITCH * 2;
enum { B_RT = 0, B_ATT, B_BHT, B_KHT, B_VT, B_NBRT, B_MAK, B_PA, B_PB, B_PC, B_PD, B_PE, NBUF };
constexpr int OFF_MFD = NBUF * BUFB, OFF_TOT = OFF_MFD + 4096, OFF_ECUM = OFF_TOT + 2048;
static_assert(OFF_ECUM + 256 <= 131072, "rk lds");
constexpr int REC = 32768;
#define RKBUF(id) ((LAS bf16_t*)(lds + (id) * BUFB))
DI f32x16 mm_block(const LAS bf16_t* A, int mb, const LAS bf16_t* Bt, int nb, f32x16 acc, int lane) {
    const int r = lane & 31, h = lane >> 5;
    const LAS bf16_t* ap = A + (mb * 32 + r) * PITCH + 8 * h; const LAS bf16_t* bp = Bt + (nb * 32 + r) * PITCH + 8 * h;
#pragma unroll
    for (int ks = 0; ks < 4; ++ks) acc = __builtin_amdgcn_mfma_f32_32x32x16_bf16(*(const LAS bf16x8*)(ap + 16 * ks), *(const LAS bf16x8*)(bp + 16 * ks), acc, 0, 0, 0);
    return acc;
}
DI void store_T(LAS bf16_t* dst, int mb, int nb, const f32x16& acc, int lane) {
    const int r = lane & 31, h = lane >> 5;
#pragma unroll
    for (int g = 0; g < 4; ++g) { u32x2 w; w.x = pk2(acc[4 * g], acc[4 * g + 1]); w.y = pk2(acc[4 * g + 2], acc[4 * g + 3]); *(LAS u32x2*)(dst + (nb * 32 + r) * PITCH + mb * 32 + 8 * g + 4 * h) = w; }
}
DI void store_N(LAS bf16_t* dst, int mb, int nb, const f32x16& acc, int lane) {
    const int r = lane & 31, h = lane >> 5;
#pragma unroll
    for (int q = 0; q < 16; ++q) dst[(mb * 32 + crow(q, h)) * PITCH + nb * 32 + r] = f2bf(acc[q]);
}
DI f32x16 zero16() { const float z0 = ozero(); f32x16 z;
#pragma unroll
    for (int q = 0; q < 16; ++q) z[q] = z0;
    return z; }
}

DI void phase_rwkv_chunk(Ctx C, int layer) {
    using namespace rk;
    LAS unsigned char* lds = C.lds;
    const bf16_t* RR = (const bf16_t*)(C.ws + WS_RR); const bf16_t* RK = (const bf16_t*)(C.ws + WS_RK); const bf16_t* RV = (const bf16_t*)(C.ws + WS_RV);
    const bf16_t* RKK = (const bf16_t*)(C.ws + WS_RKK); const bf16_t* LO = (const bf16_t*)(C.ws + WS_LOUT);
    const int lane = C.lane, w = C.wave, r = lane & 31, h = lane >> 5;
    LAS float* tot = (LAS float*)(lds + OFF_TOT); LAS float* ecum = (LAS float*)(lds + OFF_ECUM); LAS float* mfd = (LAS float*)(lds + OFF_MFD);
    for (int job = blockIdx.x; job < NB * RH * (SEQ / 64); job += gridDim.x) {
        const int bh = job >> 6, c = job & 63, b = bh >> 2, hh = bh & 3;
        unsigned char* rec = C.ws + WS_CHK + (size_t)job * REC;
        {
            const int g = w, ch = lane; const size_t base = ((size_t)b * SEQ + c * 64 + g * 8) * RC + hh * 64 + ch;
            float lw[8], cum[8];
            float rv[8], kv[8], vv[8], kkv[8], bv[8];
            { const float w0 = INF(I_RW0)[layer * RC + hh * 64 + ch], a0 = INF(I_RA0)[layer * RC + hh * 64 + ch], ka = INF(I_RKA)[layer * RC + hh * 64 + ch];
              const size_t lbase = ((size_t)b * SEQ + c * 64 + g * 8) * 768 + hh * 64 + ch;
#pragma unroll
              for (int i = 0; i < 8; ++i) { const size_t o = base + (size_t)i * RC; rv[i] = bf2f(RR[o]); vv[i] = bf2f(RV[o]); kkv[i] = bf2f(RKK[o]);
                  const float kraw = bf2f(RK[o]), lin = bf2f(LO[lbase + (size_t)i * 768]), la = bf2f(LO[lbase + (size_t)i * 768 + 256]);
                  const float zz = -(w0 + lin); const float sp = fmaxf(zz, 0.f) + __logf(1.f + __expf(-fabsf(zz))); lw[i] = -__expf(-sp - 0.5f);
                  const float asig = fsigmoid(a0 + la); kv[i] = kraw * (1.f + (asig - 1.f) * ka); bv[i] = kkv[i] * asig; } }
            cum[0] = lw[0];
#pragma unroll
            for (int i = 1; i < 8; ++i) cum[i] = cum[i - 1] + lw[i];
            tot[g * 64 + ch] = cum[7];
            __syncthreads();
            float prefix = 0.f, total = 0.f;
#pragma unroll
            for (int q = 0; q < 8; ++q) { const float tq = tot[q * 64 + ch]; total += tq; prefix += (q < g) ? tq : 0.f; }
            if (g == 0) ecum[ch] = __expf(total);
            unsigned att[4], bht[4], kht[4], vt[4];
#pragma unroll
            for (int i = 0; i < 8; i += 2) {
                float o[2][8];
#pragma unroll
                for (int e = 0; e < 2; ++e) { const int ii = i + e; const float ci = cum[ii] + prefix, cx = ci - lw[ii];
                    const float ein = __expf(ci), eex = __expf(cx), eneg = __expf(-ci), eend = __expf(total - ci);
                    o[e][0] = -kkv[ii] * eex; o[e][1] = rv[ii] * ein; o[e][2] = bv[ii] * eneg; o[e][3] = kv[ii] * eneg; o[e][4] = bv[ii] * eend; o[e][5] = kv[ii] * eend; o[e][6] = vv[ii];
                    const int tok = g * 8 + ii;
                    RKBUF(B_PA)[tok * PITCH + ch] = f2bf(o[e][0]); RKBUF(B_RT)[tok * PITCH + ch] = f2bf(o[e][1]); RKBUF(B_PB)[tok * PITCH + ch] = f2bf(o[e][2]); RKBUF(B_PC)[tok * PITCH + ch] = f2bf(o[e][3]); }
                att[i >> 1] = pk2(o[0][0], o[1][0]); bht[i >> 1] = pk2(o[0][4], o[1][4]); kht[i >> 1] = pk2(o[0][5], o[1][5]); vt[i >> 1] = pk2(o[0][6], o[1][6]);
            }
            *(LAS u32x4*)(RKBUF(B_ATT) + ch * PITCH + g * 8) = (u32x4){att[0], att[1], att[2], att[3]};
            *(LAS u32x4*)(RKBUF(B_BHT) + ch * PITCH + g * 8) = (u32x4){bht[0], bht[1], bht[2], bht[3]};
            *(LAS u32x4*)(RKBUF(B_KHT) + ch * PITCH + g * 8) = (u32x4){kht[0], kht[1], kht[2], kht[3]};
            *(LAS u32x4*)(RKBUF(B_VT) + ch * PITCH + g * 8) = (u32x4){vt[0], vt[1], vt[2], vt[3]};
        }
        __syncthreads();
        const int blk = w & 3, mb = blk >> 1, nb = blk & 1;
        f32x16 nkr = zero16();
        {
            const LAS bf16_t* Aop = (w < 4) ? RKBUF(B_PB) : RKBUF(B_PC);
            f32x16 m1 = mm_block(Aop, mb, RKBUF(B_PA), nb, zero16(), lane);
            f32x16 m2 = mm_block(Aop, mb, RKBUF(B_RT), nb, zero16(), lane);
#pragma unroll
            for (int q = 0; q < 16; ++q) { const int sI = mb * 32 + crow(q, h), tI = nb * 32 + r; if (!(sI < tI)) m1[q] = 0.f; if (!(sI <= tI)) m2[q] = 0.f; }
            if (w < 4) {
                f32x16 moff = m1;
#pragma unroll
                for (int q = 0; q < 16; ++q) { const int sI = mb * 32 + crow(q, h), tI = nb * 32 + r; if ((sI >> 4) == (tI >> 4)) { mfd[(tI >> 4) * 256 + (tI & 15) * 16 + (sI & 15)] = m1[q]; moff[q] = 0.f; } }
                store_T(RKBUF(B_PD), mb, nb, moff, lane);
                store_T(RKBUF(B_NBRT), mb, nb, m2, lane);
            } else { store_N(RKBUF(B_MAK), mb, nb, m1, lane); nkr = m2; }
        }
        __syncthreads();
        if (w == 0) {
            const int d = lane >> 4, rr = lane & 15; float x[16];
#pragma unroll
            for (int t = 0; t < 16; ++t) { float acc = (t == rr) ? 1.f : 0.f;
#pragma unroll
                for (int sI = 0; sI < t; ++sI) acc += x[sI] * mfd[d * 256 + t * 16 + sI];
                x[t] = acc; }
            LAS bf16_t* Dn = RKBUF(B_PA); LAS bf16_t* Dt = RKBUF(B_PB); const int row = 16 * d + rr;
#pragma unroll
            for (int q = 0; q < 8; ++q) { *(LAS u32x4*)(Dn + row * PITCH + 8 * q) = (u32x4){0u, 0u, 0u, 0u}; *(LAS u32x4*)(Dt + row * PITCH + 8 * q) = (u32x4){0u, 0u, 0u, 0u}; }
            asm volatile("s_waitcnt lgkmcnt(0)" ::: "memory");
#pragma unroll
            for (int t = 0; t < 16; t += 2) *(LAS unsigned*)(Dn + row * PITCH + 16 * d + t) = pk2(x[t], x[t + 1]);
#pragma unroll
            for (int t = 0; t < 16; ++t) Dt[(16 * d + t) * PITCH + row] = f2bf(x[t]);
        }
        __syncthreads();
        f32x16 sig = zero16();
        if (w < 4) { sig = mm_block(RKBUF(B_PA), mb, RKBUF(B_PD), nb, zero16(), lane); store_N(RKBUF(B_PC), mb, nb, sig, lane); store_T(RKBUF(B_PE), mb, nb, sig, lane); }
        __syncthreads();
        if (w < 4) { const f32x16 w2 = mm_block(RKBUF(B_PC), mb, RKBUF(B_PE), nb, zero16(), lane); store_T(RKBUF(B_PD), mb, nb, w2, lane);
#pragma unroll
            for (int q = 0; q < 16; ++q) sig[q] += w2[q]; }
        __syncthreads();
        if (w < 4) { sig = mm_block(RKBUF(B_PC), mb, RKBUF(B_PD), nb, sig, lane);
#pragma unroll
            for (int q = 0; q < 16; ++q) if (mb * 32 + crow(q, h) == nb * 32 + r) sig[q] += 1.f;
            store_N(RKBUF(B_PA), mb, nb, sig, lane); }
        __syncthreads();
        if (w < 4) { const f32x16 tt = mm_block(RKBUF(B_PA), mb, RKBUF(B_PB), nb, zero16(), lane); store_T(RKBUF(B_PC), mb, nb, tt, lane); }
        __syncthreads();
        { const f32x16 x = mm_block((w < 4) ? RKBUF(B_ATT) : RKBUF(B_MAK), mb, RKBUF(B_PC), nb, zero16(), lane); store_N((w < 4) ? RKBUF(B_PA) : RKBUF(B_PB), mb, nb, x, lane); }
        __syncthreads();
        if (w < 4) {
            f32x16 qh = mm_block(RKBUF(B_PA), mb, RKBUF(B_NBRT), nb, zero16(), lane);
#pragma unroll
            for (int g = 0; g < 4; ++g) { const u32x2 rw = *(const LAS u32x2*)(RKBUF(B_RT) + (nb * 32 + r) * PITCH + mb * 32 + 8 * g + 4 * h);
                qh[4 * g] += __uint_as_float(rw.x << 16); qh[4 * g + 1] += __uint_as_float(rw.x & 0xffff0000u); qh[4 * g + 2] += __uint_as_float(rw.y << 16); qh[4 * g + 3] += __uint_as_float(rw.y & 0xffff0000u); }
            f32x16 ph = mm_block(RKBUF(B_PA), mb, RKBUF(B_BHT), nb, zero16(), lane);
#pragma unroll
            for (int q = 0; q < 16; ++q) if (mb * 32 + crow(q, h) == nb * 32 + r) ph[q] += ecum[nb * 32 + r];
#pragma unroll
            for (int sx = 0; sx < 2; ++sx) {
                u32x4 o; o.x = pk2(ph[8 * sx], ph[8 * sx + 1]); o.y = pk2(ph[8 * sx + 2], ph[8 * sx + 3]); o.z = pk2(ph[8 * sx + 4], ph[8 * sx + 5]); o.w = pk2(ph[8 * sx + 6], ph[8 * sx + 7]);
                *(u32x4*)(rec + (((nb * 2 + mb) * 2 + sx) * 64 + lane) * 16) = o;
                u32x4 p; p.x = pk2(qh[8 * sx], qh[8 * sx + 1]); p.y = pk2(qh[8 * sx + 2], qh[8 * sx + 3]); p.z = pk2(qh[8 * sx + 4], qh[8 * sx + 5]); p.w = pk2(qh[8 * sx + 6], qh[8 * sx + 7]);
                *(u32x4*)(rec + 8192 + (((nb * 2 + mb) * 2 + sx) * 64 + lane) * 16) = p; }
        } else {
            const f32x16 gg = mm_block(RKBUF(B_PB), mb, RKBUF(B_NBRT), nb, nkr, lane);
            f32x16 hm = mm_block(RKBUF(B_PB), mb, RKBUF(B_BHT), nb, zero16(), lane);
#pragma unroll
            for (int g = 0; g < 4; ++g) { const u32x2 kw = *(const LAS u32x2*)(RKBUF(B_KHT) + (nb * 32 + r) * PITCH + mb * 32 + 8 * g + 4 * h);
                hm[4 * g] += __uint_as_float(kw.x << 16); hm[4 * g + 1] += __uint_as_float(kw.x & 0xffff0000u); hm[4 * g + 2] += __uint_as_float(kw.y << 16); hm[4 * g + 3] += __uint_as_float(kw.y & 0xffff0000u); }
            store_T(RKBUF(B_PC), mb, nb, gg, lane); store_T(RKBUF(B_PD), mb, nb, hm, lane);
        }
        __syncthreads();
        { const f32x16 o = mm_block((w < 4) ? RKBUF(B_PD) : RKBUF(B_PC), mb, RKBUF(B_VT), nb, zero16(), lane);
          unsigned char* dst = rec + ((w < 4) ? 16384 : 24576) + ((nb * 2 + mb) * 64 + lane) * 32;
          u32x4 o0, o1; o0.x = pk2(o[0], o[1]); o0.y = pk2(o[2], o[3]); o0.z = pk2(o[4], o[5]); o0.w = pk2(o[6], o[7]); o1.x = pk2(o[8], o[9]); o1.y = pk2(o[10], o[11]); o1.z = pk2(o[12], o[13]); o1.w = pk2(o[14], o[15]);
          *(u32x4*)dst = o0; *(u32x4*)(dst + 16) = o1; }
        __syncthreads();
    }
}

DI void phase_rwkv_scan(Ctx C) {
    using namespace rk;
    LAS unsigned char* lds = C.lds;
    const int bh = blockIdx.x, b = bh >> 2, hh = bh & 3, w = C.wave, lane = C.lane, r = lane & 31, h = lane >> 5;
    const unsigned char* rec0 = C.ws + WS_CHK + (size_t)bh * 64 * REC;
    float* RY = (float*)(C.ws + WS_RY);
    constexpr int NCH = SEQ / 64;
#define RK_DMA(cc) do { if (w >= 4) { _Pragma("unroll") for (int p_ = 0; p_ < 8; ++p_) { const int pc_ = (w - 4) * 8 + p_; \
        __builtin_amdgcn_global_load_lds((const unsigned*)(rec0 + (size_t)(cc) * REC + pc_ * 1024 + lane * 16), (LAS unsigned*)(lds + ((cc) & 3) * REC + pc_ * 1024), 16, 0, 0); } } } while (0)
    RK_DMA(0); RK_DMA(1); RK_DMA(2);
    f32x16 st[2]; st[0] = zero16(); st[1] = zero16();
    for (int c = 0; c < NCH; ++c) {
        if (w >= 4) { if (c + 2 < NCH) asm volatile("s_waitcnt vmcnt(16)" ::: "memory"); else if (c + 1 < NCH) asm volatile("s_waitcnt vmcnt(8)" ::: "memory"); else asm volatile("s_waitcnt vmcnt(0)" ::: "memory"); }
        asm volatile("s_waitcnt lgkmcnt(0)" ::: "memory");
        __builtin_amdgcn_s_barrier();
        asm volatile("" ::: "memory");
        if (c + 3 < NCH) RK_DMA(c + 3);
        if (w < 2) {
            const LAS unsigned char* sb = lds + (c & 3) * REC; const int ib = w;
            bf16x8 bfr[2][2];
#pragma unroll
            for (int jb = 0; jb < 2; ++jb)
#pragma unroll
                for (int sx = 0; sx < 2; ++sx) { u32x4 p; p.x = pk2(st[jb][8 * sx], st[jb][8 * sx + 1]); p.y = pk2(st[jb][8 * sx + 2], st[jb][8 * sx + 3]); p.z = pk2(st[jb][8 * sx + 4], st[jb][8 * sx + 5]); p.w = pk2(st[jb][8 * sx + 6], st[jb][8 * sx + 7]); bfr[jb][sx] = __builtin_bit_cast(bf16x8, p); }
            f32x16 y[2], sn[2];
#pragma unroll
            for (int ob = 0; ob < 2; ++ob) {
                const u32x4 y0 = *(const LAS u32x4*)(sb + 24576 + ((ib * 2 + ob) * 64 + lane) * 32), y1 = *(const LAS u32x4*)(sb + 24576 + ((ib * 2 + ob) * 64 + lane) * 32 + 16);
                const u32x4 p0 = *(const LAS u32x4*)(sb + 16384 + ((ib * 2 + ob) * 64 + lane) * 32), p1 = *(const LAS u32x4*)(sb + 16384 + ((ib * 2 + ob) * 64 + lane) * 32 + 16);
#pragma unroll
                for (int q = 0; q < 4; ++q) { y[ob][2 * q] = __uint_as_float(y0[q] << 16); y[ob][2 * q + 1] = __uint_as_float(y0[q] & 0xffff0000u); y[ob][8 + 2 * q] = __uint_as_float(y1[q] << 16); y[ob][8 + 2 * q + 1] = __uint_as_float(y1[q] & 0xffff0000u);
                    sn[ob][2 * q] = __uint_as_float(p0[q] << 16); sn[ob][2 * q + 1] = __uint_as_float(p0[q] & 0xffff0000u); sn[ob][8 + 2 * q] = __uint_as_float(p1[q] << 16); sn[ob][8 + 2 * q + 1] = __uint_as_float(p1[q] & 0xffff0000u); }
#pragma unroll
                for (int jb = 0; jb < 2; ++jb)
#pragma unroll
                    for (int sx = 0; sx < 2; ++sx) {
                        const bf16x8 qa = *(const LAS bf16x8*)(sb + 8192 + (((ob * 2 + jb) * 2 + sx) * 64 + lane) * 16);
                        const bf16x8 pa = *(const LAS bf16x8*)(sb + (((ob * 2 + jb) * 2 + sx) * 64 + lane) * 16);
                        y[ob] = __builtin_amdgcn_mfma_f32_32x32x16_bf16(qa, bfr[jb][sx], y[ob], 0, 0, 0);
                        sn[ob] = __builtin_amdgcn_mfma_f32_32x32x16_bf16(pa, bfr[jb][sx], sn[ob], 0, 0, 0);
                    }
            }
#pragma unroll
            for (int ob = 0; ob < 2; ++ob)
#pragma unroll
                for (int q = 0; q < 16; ++q) RY[((size_t)b * SEQ + c * 64 + ob * 32 + crow(q, h)) * RC + hh * 64 + ib * 32 + r] = y[ob][q];
            st[0] = sn[0]; st[1] = sn[1];
        }
    }
#undef RK_DMA
    asm volatile("s_waitcnt vmcnt(0) lgkmcnt(0)" ::: "memory");
    __builtin_amdgcn_s_barrier();
}

DI void phase_rwkv_out(Ctx C, int layer) {
    const bf16_t* RR = (const bf16_t*)(C.ws + WS_RR); const bf16_t* RK = (const bf16_t*)(C.ws + WS_RK); const bf16_t* RV = (const bf16_t*)(C.ws + WS_RV); const bf16_t* LO = (const bf16_t*)(C.ws + WS_LOUT);
    const float* RY = (const float*)(C.ws + WS_RY); bf16_t* MX = (bf16_t*)(C.ws + WS_MIXED);
    const int l = C.lane;
    const f32x4 lg = ld4(INF(I_RLNG) + layer * RC + l * 4), lb = ld4(INF(I_RLNB) + layer * RC + l * 4), rk = ld4(INF(I_RRK) + layer * RC + l * 4);
    const f32x4 a0 = ld4(INF(I_RA0) + layer * RC + l * 4), ka = ld4(INF(I_RKA) + layer * RC + l * 4);
    const int rpw = (M + C.NGW - 1) / C.NGW, m0 = C.gw * rpw, m1 = (m0 + rpw < M) ? m0 + rpw : M;
    f32x4 ny; u32x2 nwr, nwk, nwv, nwg, nwa;
#define RO_LOAD(mm) do { const size_t o_ = (size_t)(mm) * RC + l * 4; ny = ld4(RY + o_); nwr = *(const u32x2*)(RR + o_); nwk = *(const u32x2*)(RK + o_); nwv = *(const u32x2*)(RV + o_); \
        nwg = *(const u32x2*)(LO + (size_t)(mm) * 768 + 512 + l * 4); nwa = *(const u32x2*)(LO + (size_t)(mm) * 768 + 256 + l * 4); } while (0)
    if (m0 < m1) RO_LOAD(m0);
    for (int m = m0; m < m1; ++m) {
        const f32x4 y = ny; const u32x2 wr = nwr, wk = nwk, wv = nwv, wg = nwg, wa = nwa;
        if (m + 1 < m1) RO_LOAD(m + 1);
        const f32x4 r = {bflo(wr.x), bfhi(wr.x), bflo(wr.y), bfhi(wr.y)}, kraw = {bflo(wk.x), bfhi(wk.x), bflo(wk.y), bfhi(wk.y)}, v = {bflo(wv.x), bfhi(wv.x), bflo(wv.y), bfhi(wv.y)}, g = {bflo(wg.x), bfhi(wg.x), bflo(wg.y), bfhi(wg.y)};
        const f32x4 la = {bflo(wa.x), bfhi(wa.x), bflo(wa.y), bfhi(wa.y)};
        f32x4 k;
#pragma unroll
        for (int i = 0; i < 4; ++i) { const float asig = sigmoidf_(a0[i] + la[i]); k[i] = kraw[i] * (1.f + (asig - 1.f) * ka[i]); }
        float sm = y.x + y.y + y.z + y.w; const f32x4 rkk = r * k * rk; float bn = rkk.x + rkk.y + rkk.z + rkk.w;
#pragma unroll
        for (int o = 1; o < 16; o <<= 1) { sm += shx(sm, o); bn += shx(bn, o); }
        const float mean = sm * (1.f / 64.f); const f32x4 d = y - mean; float vr = d.x * d.x + d.y * d.y + d.z * d.z + d.w * d.w;
#pragma unroll
        for (int o = 1; o < 16; o <<= 1) vr += shx(vr, o);
        const f32x4 yn = d * rsqrtf(vr * (1.f / 64.f) + 64e-5f) * lg + lb;
        const f32x4 res = (yn + bn * v) * g;
        u32x2 o2; o2.x = pk2(res.x, res.y); o2.y = pk2(res.z, res.w); *(u32x2*)(MX + (size_t)m * DM + 768 + l * 4) = o2;
    }
}

constexpr int LDS_BYTES = 163840;
constexpr int MISC_OFF = 131072 + 320;
constexpr int PH_PER_LAYER = 11, N_PHASES = 1 + NL * PH_PER_LAYER + 1;

__global__ void __launch_bounds__(NTHREADS, 2) __attribute__((amdgpu_waves_per_eu(2, 2))) mega(Args args) {
    extern __shared__ __attribute__((aligned(16))) unsigned char lds[];
    Ctx C; C.ka = (const CAS char*)__builtin_amdgcn_kernarg_segment_ptr(); C.ws = args.ws; C.lds = (LAS unsigned char*)lds;
    C.tid = threadIdx.x; C.lane = C.tid & 63; C.wave = __builtin_amdgcn_readfirstlane(C.tid >> 6);
    C.gw = blockIdx.x * NWAVES + C.wave; C.NGW = gridDim.x * NWAVES; C.gtid = blockIdx.x * NTHREADS + C.tid; C.NT = gridDim.x * NTHREADS;
    volatile LAS unsigned* MISC = (volatile LAS unsigned*)((LAS unsigned char*)lds + MISC_OFF);
    if (C.tid < 32) MISC[C.tid] = 0u;
    __syncthreads();
    unsigned* ctl = (unsigned*)(args.ws + WS_CTL);
    XcdBarrier bar; bar.bar = ctl + CW_BAR; bar.x = 0; bar.st = nullptr;
    const int lo = args.ph_lo, hi = args.ph_hi;
    if (hi - lo > 1) bar = xcd_barrier_post(ctl + CW_BAR, MISC + 8);
    int pid = 0;
#ifndef PHMASK
#define PHMASK 0xFFFF
#endif
#define PH_ON(k) ((PHMASK >> (k)) & 1)
#define PH_BEGIN if (pid >= lo && pid < hi) { Ctx P; P.ka = C.ka; P.lds = C.lds; P.NGW = C.NGW; P.NT = C.NT; P.wave = C.wave; unsigned mk_ = ~0u; asm volatile("" : "+s"(P.wave), "+s"(P.ka), "+s"(mk_)); \
        P.lane = (int)__builtin_amdgcn_mbcnt_hi(mk_, __builtin_amdgcn_mbcnt_lo(mk_, 0u)); P.tid = P.wave * 64 + P.lane; P.gw = blockIdx.x * NWAVES + P.wave; P.gtid = blockIdx.x * NTHREADS + P.tid; P.ws = KARG(P, 312, unsigned char*);
#define PH_END } if (pid + 1 < hi) xcd_barrier(bar, P.tid); } ++pid;

    PH_BEGIN if (PH_ON(0)) { phase_prologue(P); PH_END
    for (int layer = 0; layer < NL; ++layer) {
        const bool moe = layer & 1; const int fi = layer >> 1;
        PH_BEGIN if (PH_ON(1)) { phase_norm(P, layer, 0, layer > 0 && ((layer - 1) & 1), false); PH_END
        PH_BEGIN if (PH_ON(2)) { const bf16_t* A = (const bf16_t*)(P.ws + WS_H); g8::DenseOrder S; S.init(A, DM, (const bf16_t*)(P.ws + WS_WIN) + (size_t)layer * INCP * DM, DM, M, INCP, gridDim.x, blockIdx.x);
            g8::EpiStore E{(bf16_t*)(P.ws + WS_U), INCP}; g8::gemm_phase<g8::EpiStore, g8::DenseOrder, false>(P.tid, P.lds, A, DM, DM, S, E); PH_END
        PH_BEGIN if (PH_ON(3)) { phase_conv(P, layer); phase_prep1(P, layer); PH_END
        PH_BEGIN if (PH_ON(4)) { phase_upgemms(P, layer); PH_END
        PH_BEGIN if (PH_ON(5)) { phase_prep2(P, layer); phase_rwkv_chunk(P, layer); PH_END
        PH_BEGIN if (PH_ON(6)) { if (blockIdx.x < NB * RH) phase_rwkv_scan(P); phase_attn2(P, ctl + CW_QH + 64 * layer, layer); PH_END
        PH_BEGIN if (PH_ON(8)) { phase_rwkv_out(P, layer); PH_END
        PH_BEGIN if (PH_ON(9)) { const bf16_t* A = (const bf16_t*)(P.ws + WS_MIXED); g8::DenseOrder S; S.init(A, DM, (const bf16_t*)(P.ws + WS_WOUT) + (size_t)layer * DM * DM, DM, M, DM, gridDim.x, blockIdx.x);
            g8::EpiResid E{(layer == 0) ? KARG(P, 8 * I_X, const float*) : (const float*)OUTP(P), OUTP(P), (const float*)(P.ws + WS_COND) + 2 * 1024, KARG(P, 8 * I_ADALB, const float*) + layer * 6144 + 2 * 1024};
            g8::gemm_phase<g8::EpiResid, g8::DenseOrder, false>(P.tid, P.lds, A, DM, DM, S, E); PH_END
        PH_BEGIN if (PH_ON(10)) { phase_norm(P, layer, 1, false, moe); PH_END
        if (!moe) {
            PH_BEGIN if (PH_ON(11)) { const bf16_t* H = (const bf16_t*)(P.ws + WS_H);
                g8::DenseOrder S; S.init(H, DM, (const bf16_t*)(P.ws + WS_FGU) + (size_t)fi * 2 * FF * DM, DM, M, 2 * FF, gridDim.x, blockIdx.x);
#if DENSE_DN8
                g8::EpiGlu8 E{(unsigned char*)(P.ws + WS_ACT), FF}; g8::gemm_phase<g8::EpiGlu8, g8::DenseOrder, false>(P.tid, P.lds, H, DM, DM, S, E);
#else
                g8::EpiGlu E{(bf16_t*)(P.ws + WS_ACT), FF}; g8::gemm_phase<g8::EpiGlu, g8::DenseOrder, false>(P.tid, P.lds, H, DM, DM, S, E);
#endif
            PH_END
            PH_BEGIN if (PH_ON(12)) { const bf16_t* ACT = (const bf16_t*)(P.ws + WS_ACT);
                g8::EpiResid E{(const float*)OUTP(P), OUTP(P), (const float*)(P.ws + WS_COND) + 5 * 1024, KARG(P, 8 * I_ADALB, const float*) + layer * 6144 + 5 * 1024};
#if DENSE_DN8
                g8::DenseOrder S; S.init(ACT, FF / 2, (const bf16_t*)(P.ws + WS_FD + (size_t)fi * DM * FF), FF / 2, M, DM, gridDim.x, blockIdx.x);
                g8::gemm_phase<g8::EpiResid, g8::DenseOrder, false, 0x7C7C7C7Cu>(P.tid, P.lds, ACT, FF / 2, FF / 2, S, E);
#else
                g8::DenseOrder S; S.init(ACT, FF, (const bf16_t*)(P.ws + WS_FD) + (size_t)fi * DM * FF, FF, M, DM, gridDim.x, blockIdx.x);
                g8::gemm_phase<g8::EpiResid, g8::DenseOrder, false>(P.tid, P.lds, ACT, FF, FF, S, E);
#endif
            PH_END
        } else {
            PH_BEGIN if (PH_ON(11)) { const unsigned* cnt = ctl + CW_CNT + 16 * fi; moe_tables(P, cnt, 256);
                const bf16_t* XS = (const bf16_t*)(P.ws + WS_XS8);
                g8::MoeOrder S; S.init(P, cnt, (const char*)XS, DM / 2, (const char*)(P.ws + WS_MGU) + (size_t)fi * NE * 2 * MFF * DM, (size_t)2 * MFF * DM, DM / 2, 2 * MFF); S.xs = true;
                g8::EpiGlu8 E{(unsigned char*)(P.ws + WS_ACT), MFF}; g8::gemm_phase<g8::EpiGlu8, g8::MoeOrder, false, 0x7C7C7C7Cu>(P.tid, P.lds, XS, DM / 2, DM / 2, S, E);
            PH_END
            PH_BEGIN if (PH_ON(12)) { const unsigned* cnt = ctl + CW_CNT + 16 * fi; moe_tables(P, cnt, 256);
                const bf16_t* ACT = (const bf16_t*)(P.ws + WS_ACT);
                g8::MoeOrder S; S.init(P, cnt, (const char*)ACT, MFF / 2, (const char*)(P.ws + WS_MD) + (size_t)fi * NE * DM * MFF, (size_t)DM * MFF, MFF / 2, DM);
                int kparts = 1; const int nFull = (S.nU / S.G) * S.G, nT = S.nU - nFull;
                if (layer == NL - 1 && nT > 0) kparts = (nT * 7 <= S.G) ? 7 : (nT * 2 <= S.G) ? 2 : 1;
                if (kparts > 1) S.nL = nFull;
                g8::EpiStoreB E{(bf16_t*)(P.ws + WS_YS), DM}; g8::gemm_phase<g8::EpiStoreB, g8::MoeOrder, false, 0x7C7C7C7Cu>(P.tid, P.lds, ACT, MFF / 2, MFF / 2, S, E);
                if (kparts > 1) {
                    S.L0 = nFull; S.nL = nT; S.kparts = kparts; S.kbytes = MFF / kparts;
                    const int t0 = nFull / S.nN; int e0 = 0;
#pragma unroll
                    for (int q = 1; q < 8; ++q) if (t0 >= S.tst[q]) e0 = q;
                    const int row0 = S.pst[e0] + (t0 - S.tst[e0]) * 256;
                    g8::EpiPartialF32 E2{(float*)(P.ws + WS_YSF), row0, (unsigned)((S.tst[8] - t0) * 256 * DM * 4)};
                    unsigned mk2 = ~0u; asm volatile("" : "+s"(mk2)); const int tid2 = P.wave * 64 + (int)__builtin_amdgcn_mbcnt_hi(mk2, __builtin_amdgcn_mbcnt_lo(mk2, 0u));
                    g8::gemm_phase<g8::EpiPartialF32, g8::MoeOrder, false, 0x7C7C7C7Cu>(tid2, P.lds, ACT, MFF / 2, MFF / 2 / kparts, S, E2, MFF / 2);
                }
                if (layer == 1) late_convert(P, ctl + CW_LATE);
            PH_END
        }
    }
    PH_BEGIN if (PH_ON(13)) { phase_norm(P, NL, 2, true, false); PH_END
#undef PH_BEGIN
#undef PH_END
}

extern "C" void kernel_launch(void* const* d_in, const int* in_sizes, int n_in, void* d_out, int out_size, void* d_ws, size_t ws_size, hipStream_t stream) {
    static int grid = 0;
    if (grid == 0) {
        if (n_in != 38 || out_size != M * DM || ws_size < WS_END) { fprintf(stderr, "kernel_launch: unexpected problem (n_in %d out %d ws %zu need %zu)\n", n_in, out_size, ws_size, (size_t)WS_END); grid = -1; return; }
        int dev = 0, cus = 0, per_cu = 0;
        if (hipGetDevice(&dev) != hipSuccess || hipDeviceGetAttribute(&cus, hipDeviceAttributeMultiprocessorCount, dev) != hipSuccess) { grid = -1; return; }
        if (hipFuncSetAttribute((const void*)mega, hipFuncAttributeMaxDynamicSharedMemorySize, LDS_BYTES) != hipSuccess) { fprintf(stderr, "kernel_launch: hipFuncSetAttribute failed\n"); grid = -1; return; }
        if (hipOccupancyMaxActiveBlocksPerMultiprocessor(&per_cu, (const void*)mega, NTHREADS, LDS_BYTES) != hipSuccess || per_cu < 1) fprintf(stderr, "kernel_launch: occupancy query reports %d\n", per_cu);
        (void)hipGetLastError();
        grid = cus;
    }
    if (grid < 0) return;
    (void)hipMemsetAsync((char*)d_ws + WS_CTL, 0, CTL_BYTES, stream);
    Args a{};
    for (int i = 0; i < 38; ++i) a.in[i] = d_in[i];
    a.out = (float*)d_out; a.ws = (unsigned char*)d_ws;
#if MK_ONE_LAUNCH
    a.ph_lo = 0; a.ph_hi = N_PHASES;
    hipLaunchKernelGGL(mega, dim3(grid), dim3(NTHREADS), LDS_BYTES, stream, a);
#ifdef PROBE_PID
    { const int plist[] = {PROBE_PID}; for (int r = 0; r < PROBE_N; ++r) for (int pi = 0; pi < (int)(sizeof(plist) / sizeof(int)); ++pi) { (void)hipMemsetAsync((char*)d_ws + WS_CTL + (CW_QH + 64 * 3) * 4, 0, 4, stream); a.ph_lo = plist[pi]; a.ph_hi = plist[pi] + 1; hipLaunchKernelGGL(mega, dim3(grid), dim3(NTHREADS), LDS_BYTES, stream, a); } }
#endif
#else
    for (int p = 0; p < N_PHASES; ++p) { a.ph_lo = p; a.ph_hi = p + 1; hipLaunchKernelGGL(mega, dim3(grid), dim3(NTHREADS), LDS_BYTES, stream, a); }
#endif
}
```

```cpp
#ifndef DENSE_DN8
#define DENSE_DN8 1
#endif
#include <hip/hip_runtime.h>
#include <cstdio>
#include <cstdint>

#ifndef MK_ONE_LAUNCH
#define MK_ONE_LAUNCH 1
#endif

#define GAS __attribute__((address_space(1)))
#define LAS __attribute__((address_space(3)))
#define DI __device__ __forceinline__
typedef unsigned short bf16_t;
typedef short bf16x8 __attribute__((ext_vector_type(8)));
typedef short s16x4 __attribute__((ext_vector_type(4)));
typedef float f32x4 __attribute__((ext_vector_type(4)));
typedef float f32x2 __attribute__((ext_vector_type(2)));
typedef float f32x16 __attribute__((ext_vector_type(16)));
typedef unsigned u32x4 __attribute__((ext_vector_type(4)));
typedef unsigned u32x2 __attribute__((ext_vector_type(2)));
typedef __bf16 bf16x2_t __attribute__((ext_vector_type(2)));
typedef int v4i_t __attribute__((ext_vector_type(4)));
typedef int v8i_t __attribute__((ext_vector_type(8)));

constexpr int NB = 4, SEQ = 4096, DM = 1024, M = NB * SEQ, NL = 4;
constexpr int INC = 1952, INCP = 2048;
constexpr int U_CQ = 512, U_CKV = 768, U_KR = 896, U_RW = 928;
constexpr int NH = 8, DQK = 96, DNOPE = 64, DROPE = 32, DV = 64;
constexpr int RH = 4, RN = 64, RC = 256;
constexpr int FF = 2816, MFF = 3584, NE = 8;
constexpr int CONVK = 31, CONVC = 256;
constexpr int MOE_CAP = 34816;
constexpr int NWAVES = 8, NTHREADS = 512;

constexpr size_t MiB = 1u << 20;
constexpr size_t WS_CTL = 0, CTL_BYTES = 1 * MiB;
constexpr size_t WS_COND = 1 * MiB;
constexpr size_t WS_COS = 2 * MiB, WS_SIN = 3 * MiB;
constexpr size_t WS_WIN = 4 * MiB;
constexpr size_t WS_WOUT = 20 * MiB;
constexpr size_t WS_WUQ = 28 * MiB;
constexpr size_t WS_WUKV = 30 * MiB;
constexpr size_t WS_LORA = 32 * MiB;
constexpr size_t WS_FGU = 34 * MiB;
constexpr size_t WS_FD = 56 * MiB;
constexpr size_t WS_MGU = 68 * MiB;
constexpr size_t WS_MD = 292 * MiB;
constexpr size_t WS_H = 404 * MiB;
constexpr size_t WS_YS = 436 * MiB;
constexpr size_t WS_MOE = 504 * MiB;
constexpr size_t WS_MIX = 508 * MiB;
constexpr size_t WS_U = WS_MIX;
constexpr size_t WS_MIXED = WS_MIX + 64 * MiB;
constexpr size_t WS_QRAW = WS_MIX + 96 * MiB;
constexpr size_t WS_KVRAW = WS_MIX + 120 * MiB;
constexpr size_t WS_Q = WS_MIX + 152 * MiB;
constexpr size_t WS_K = WS_MIX + 176 * MiB;
constexpr size_t WS_VT = WS_MIX + 200 * MiB;
constexpr size_t WS_RR = WS_MIX + 216 * MiB;
constexpr size_t WS_RK = WS_MIX + 224 * MiB;
constexpr size_t WS_RV = WS_MIX + 232 * MiB;
constexpr size_t WS_RKK = WS_MIX + 240 * MiB;
constexpr size_t WS_RB = WS_MIX + 248 * MiB;
constexpr size_t WS_RG = WS_MIX + 256 * MiB;
constexpr size_t WS_RLW = WS_MIX + 264 * MiB;
constexpr size_t WS_RY = WS_MIX + 280 * MiB;
constexpr size_t WS_LIN = WS_MIX + 296 * MiB;
constexpr size_t WS_LOUT = WS_MIX + 304 * MiB;
constexpr size_t WS_XS8 = WS_MIX + 128 * MiB;
constexpr size_t WS_ACT = WS_MIX;
constexpr size_t WS_CHK = WS_MIX + 330 * MiB;
constexpr size_t WS_END = WS_MIX + 362 * MiB;
static_assert((size_t)MOE_CAP * MFF * 2 <= 330 * MiB, "act fits");
constexpr size_t MOE_LTOK = 0;
constexpr size_t MOE_TE = 512 * 1024;
constexpr size_t MOE_TR = MOE_TE + 128 * 1024;
constexpr size_t MOE_TP = MOE_TR + 128 * 1024;
constexpr int CW_CNT = 64;
constexpr int CW_LATE = 448;
constexpr int CW_QH = 512;
constexpr int CW_BAR = 4096;

DI float shx(float v, int k) {
    if (k == 32) { auto rr = __builtin_amdgcn_permlane32_swap(__float_as_uint(v), __float_as_uint(v), false, false); const float a = __uint_as_float(rr[0]), b = __uint_as_float(rr[1]);
        return (__builtin_amdgcn_mbcnt_hi(~0u, __builtin_amdgcn_mbcnt_lo(~0u, 0u)) < 32u) ? b : a; }
    switch (k) {
        case 1: return __int_as_float(__builtin_amdgcn_ds_swizzle(__float_as_int(v), (1 << 10) | 0x1f));
        case 2: return __int_as_float(__builtin_amdgcn_ds_swizzle(__float_as_int(v), (2 << 10) | 0x1f));
        case 4: return __int_as_float(__builtin_amdgcn_ds_swizzle(__float_as_int(v), (4 << 10) | 0x1f));
        case 8: return __int_as_float(__builtin_amdgcn_ds_swizzle(__float_as_int(v), (8 << 10) | 0x1f));
        default: return __int_as_float(__builtin_amdgcn_ds_swizzle(__float_as_int(v), (16 << 10) | 0x1f));
    }
}
DI float shx32_sum(float v) { auto rr = __builtin_amdgcn_permlane32_swap(__float_as_uint(v), __float_as_uint(v), false, false); return __uint_as_float(rr[0]) + __uint_as_float(rr[1]); }
DI float shx32_max(float v) { auto rr = __builtin_amdgcn_permlane32_swap(__float_as_uint(v), __float_as_uint(v), false, false); return fmaxf(__uint_as_float(rr[0]), __uint_as_float(rr[1])); }
DI float wave_sum(float v) {
#pragma unroll
    for (int o = 1; o < 32; o <<= 1) v += shx(v, o);
    v = shx32_sum(v);
    return v;
}
DI float wave_max(float v) {
#pragma unroll
    for (int o = 1; o < 32; o <<= 1) v = fmaxf(v, shx(v, o));
    v = shx32_max(v);
    return v;
}
DI unsigned pk2(float lo, float hi) { f32x2 v = {lo, hi}; bf16x2_t b = __builtin_convertvector(v, bf16x2_t); return __builtin_bit_cast(unsigned, b); }
DI bf16_t f2bf(float f) { return (bf16_t)(pk2(f, 0.f) & 0xffffu); }
DI float bf2f(bf16_t b) { return __uint_as_float((unsigned)b << 16); }
DI float sigmoidf_(float x) { return 1.f / (1.f + __expf(-x)); }
DI float siluf_(float x) { return x * __builtin_amdgcn_rcpf(1.f + __expf(-x)); }
DI float fsigmoid(float x) { return __builtin_amdgcn_rcpf(1.f + __expf(-x)); }
DI float ftanh(float x) { return 2.f * __builtin_amdgcn_rcpf(1.f + __expf(-2.f * x)) - 1.f; }
DI float ozero() { float z = 0.f; asm volatile("" : "+v"(z)); return z; }
DI int crow(int reg, int h) { return (reg & 3) + 8 * (reg >> 2) + 4 * h; }
DI float bflo(unsigned w) { return __uint_as_float(w << 16); }
DI float bfhi(unsigned w) { return __uint_as_float(w & 0xffff0000u); }
DI void unpack8(const u32x4& w, float* f) { f[0] = bflo(w.x); f[1] = bfhi(w.x); f[2] = bflo(w.y); f[3] = bfhi(w.y); f[4] = bflo(w.z); f[5] = bfhi(w.z); f[6] = bflo(w.w); f[7] = bfhi(w.w); }
DI u32x4 pack8(const float* f) { u32x4 w; w.x = pk2(f[0], f[1]); w.y = pk2(f[2], f[3]); w.z = pk2(f[4], f[5]); w.w = pk2(f[6], f[7]); return w; }
DI f32x4 ld4(const float* p) { return *(const f32x4*)p; }
DI unsigned pk4_fp8(float a, float b, float c, float d) { int w; asm volatile("" : "=v"(w));   w = __builtin_amdgcn_cvt_pk_fp8_f32(a, b, w, false); w = __builtin_amdgcn_cvt_pk_fp8_f32(c, d, w, true); return (unsigned)w; }

#define XB_TMO      128
#define XB_XCNT(j)  (256  + 64 * (j))
#define XB_XSUB(j)  (1280 + 64 * (j))
#define XB_XGEN(j)  (2304 + 64 * (j))
#define XB_TOP      3328
#define XB_TOPGEN   3392
#define XCD_BAR_WORDS 3456
#define XB_SPIN_CAP (1u << 18)
__device__ __forceinline__ unsigned xb_ld(unsigned* p)              { asm volatile("" : "+v"(p));   return __hip_atomic_load(p, __ATOMIC_RELAXED, __HIP_MEMORY_SCOPE_AGENT); }
__device__ __forceinline__ unsigned xb_add(unsigned* p, unsigned v) { return __hip_atomic_fetch_add(p, v, __ATOMIC_RELAXED, __HIP_MEMORY_SCOPE_AGENT); }
__device__ __forceinline__ unsigned xb_xcc_id() { return (unsigned)__builtin_amdgcn_s_getreg((3 << 11) | 20) & 0xFu; }
#define XB_SPIN(cond, bar) do { unsigned _sp = 0; while (cond) { __builtin_amdgcn_s_sleep(1); \
    if ((++_sp & 255u) == 0u) { if (xb_ld(&(bar)[XB_TMO])) break; if (_sp > XB_SPIN_CAP) { atomicAdd(&(bar)[XB_TMO], 1u); break; } } } } while (0)
struct XcdBarrier { unsigned* bar; unsigned x; volatile LAS unsigned* st; };
__device__ __forceinline__ XcdBarrier xcd_barrier_post(unsigned* bar, volatile LAS unsigned* st) {
    XcdBarrier b; b.bar = bar; b.x = xb_xcc_id(); b.st = st;
    if (threadIdx.x == 0) (void)xb_add(&bar[XB_XCNT(b.x)], 1u);
    return b;
}
__device__ __forceinline__ void xcd_barrier_complete(unsigned* bar, unsigned x, unsigned& nloc, unsigned& nx) {
    const unsigned G = gridDim.x * gridDim.y * gridDim.z;
    unsigned sum, cnt, mine, sp = 0u;
    for (;;) {
        sum = 0u; cnt = 0u; mine = 0u;
#pragma unroll
        for (unsigned j = 0; j < 16; ++j) { const unsigned c = xb_ld(&bar[XB_XCNT(j)]); sum += c; cnt += (c > 0u) ? 1u : 0u; mine = (j == x) ? c : mine; }
        if (sum == G) break;
        __builtin_amdgcn_s_sleep(1);
        if ((++sp & 255u) == 0u) { if (xb_ld(&bar[XB_TMO])) break; if (sp > XB_SPIN_CAP) { atomicAdd(&bar[XB_TMO], 1u); break; } }
    }
    nloc = mine > 0u ? mine : 1u; nx = cnt > 0u ? cnt : 1u;
}
__device__ __forceinline__ void xcd_barrier(const XcdBarrier& b, int tid_) {
    asm volatile("s_waitcnt vmcnt(0)" ::: "memory");
    __syncthreads();
    if (tid_ == 0) {
        unsigned* bar = b.bar;
        __builtin_amdgcn_s_waitcnt(0);
        unsigned nloc = b.st[0], nx = b.st[1];
        if (nloc == 0u) { xcd_barrier_complete(bar, b.x, nloc, nx); b.st[0] = nloc; b.st[1] = nx; }
        const unsigned old = xb_add(&bar[XB_XSUB(b.x)], 1u);
        const unsigned gen = old / nloc;
        if (old + 1u == (gen + 1u) * nloc) {
            __builtin_amdgcn_fence(__ATOMIC_RELEASE, "agent");
            asm volatile("s_waitcnt vmcnt(0)" ::: "memory");
            const unsigned og = xb_add(&bar[XB_TOP], 1u);
            const unsigned tg = og / nx;
            if (og + 1u == (tg + 1u) * nx) xb_add(&bar[XB_TOPGEN], 1u);
            else XB_SPIN(xb_ld(&bar[XB_TOPGEN]) == tg, bar);
            __builtin_amdgcn_fence(__ATOMIC_ACQUIRE, "agent");
            xb_add(&bar[XB_XGEN(b.x)], 1u);
            asm volatile("s_waitcnt vmcnt(0)" ::: "memory");
        } else {
            XB_SPIN(xb_ld(&bar[XB_XGEN(b.x)]) == gen, bar);
            __builtin_amdgcn_fence(__ATOMIC_ACQUIRE, "agent");
            asm volatile("s_waitcnt vmcnt(0)" ::: "memory");
        }
    }
    __syncthreads();
}

struct Args { const void* in[38]; float* out; unsigned char* ws; int ph_lo, ph_hi; };
enum { I_X = 0, I_C, I_POS, I_ADAW, I_ADAB, I_ADALB, I_N1G, I_N2G, I_WIN, I_WOUT, I_CONVW, I_CONVB, I_CONVLG, I_CONVLB, I_QNG, I_WUQ, I_KVNG, I_WUKV, I_QKQ, I_QKK,
       I_RMU, I_RW0, I_RWUP, I_RA0, I_RAUP, I_RGUP, I_RKK, I_RKA, I_RRK, I_RLNG, I_RLNB, I_FG, I_FU, I_FD, I_ROUTER, I_MG, I_MU, I_MD };

#define CAS __attribute__((address_space(4)))
struct Ctx {
    const CAS char* ka; unsigned char* ws; LAS unsigned char* lds;
    int tid, lane, wave, gw, NGW, gtid, NT;
};
#define KARG(C_, off, T) (*(T const CAS*)((C_).ka + (off)))
#define INF(i) KARG(C, 8 * (i), const float*)
#define OUTP(C_) KARG(C_, 304, float*)

constexpr float GLU_GS = -1.4426950408889634f, GLU_US = -0.6931471805599453f;
DI void tr_load(const float* W, int K, int N, int item, int lane, f32x4 (&t)[16]) {
    const int nblk = (N + 63) / 64, kb = item / nblk, nb = item % nblk, k0 = 64 * kb, n0 = 64 * nb;
    const int lr = lane >> 4, lc = (lane & 15) * 4;
    const bool cvalid = (n0 + lc) < N;
#pragma unroll
    for (int i = 0; i < 16; ++i) t[i] = cvalid ? *(const f32x4*)(W + (size_t)(k0 + 4 * i + lr) * N + n0 + lc) : (f32x4){0.f, 0.f, 0.f, 0.f};
}
DI void tr_emit(const f32x4 (&t)[16], int K, int N, bf16_t* WT, int ldk, int mode, LAS float* scr, int item, int lane, float f8scale, float wmul) {
    const int nblk = (N + 63) / 64, kb = item / nblk, nb = item % nblk, k0 = 64 * kb, n0 = 64 * nb;
    const int lr = lane >> 4, lc = (lane & 15) * 4;
#pragma unroll
    for (int i = 0; i < 16; ++i) *(LAS f32x4*)(scr + (4 * i + lr) * 68 + lc) = t[i];
    asm volatile("s_waitcnt lgkmcnt(0)" ::: "memory");
    const int c = lane & 7;
    const int r0 = (mode == 0) ? n0 : ((n0 / 128) * 256 + (n0 % 128) + (mode == 2 ? 128 : 0));
#pragma unroll
    for (int j = 0; j < 8; ++j) { const int n = (lane >> 3) + 8 * j; const LAS float* sp = scr + (8 * c) * 68 + n;
        if (f8scale != 0.f) { u32x2 o8; o8.x = pk4_fp8(sp[0 * 68] * f8scale, sp[1 * 68] * f8scale, sp[2 * 68] * f8scale, sp[3 * 68] * f8scale); o8.y = pk4_fp8(sp[4 * 68] * f8scale, sp[5 * 68] * f8scale, sp[6 * 68] * f8scale, sp[7 * 68] * f8scale);
            if (n0 + n < N) *(u32x2*)((unsigned char*)WT + (size_t)(r0 + n) * ldk + k0 + 8 * c) = o8; }
        else { u32x4 o; o.x = pk2(sp[0 * 68] * wmul, sp[1 * 68] * wmul); o.y = pk2(sp[2 * 68] * wmul, sp[3 * 68] * wmul); o.z = pk2(sp[4 * 68] * wmul, sp[5 * 68] * wmul); o.w = pk2(sp[6 * 68] * wmul, sp[7 * 68] * wmul);
            if (n0 + n < N) *(u32x4*)(WT + (size_t)(r0 + n) * ldk + k0 + 8 * c) = o; } }
    asm volatile("s_waitcnt lgkmcnt(0)" ::: "memory");
}
DI void tr_load8(const float* W, int K, int N, int item, int lane, f32x4 (&t)[16]) {
    const int nblk = N / 32, kb = item / nblk, nb = item % nblk, k0 = 128 * kb, n0 = 32 * nb;
    const int lr = lane >> 3, lc = (lane & 7) * 4;
#pragma unroll
    for (int i = 0; i < 16; ++i) t[i] = *(const f32x4*)(W + (size_t)(k0 + 8 * i + lr) * N + n0 + lc);
}
DI void tr_emit8(const f32x4 (&t)[16], int K, int N, unsigned char* WT, int ldk, int mode, LAS float* scr, int item, int lane, float f8scale) {
    const int nblk = N / 32, kb = item / nblk, nb = item % nblk, k0 = 128 * kb, n0 = 32 * nb;
    const int lr = lane >> 3, lc = (lane & 7) * 4;
#pragma unroll
    for (int i = 0; i < 16; ++i) *(LAS f32x4*)(scr + (8 * i + lr) * 36 + lc) = t[i];
    asm volatile("s_waitcnt lgkmcnt(0)" ::: "memory");
    const int n = lane & 31, h = lane >> 5;
    const int r0 = (mode == 0) ? n0 : ((n0 / 128) * 256 + (n0 % 128) + (mode == 2 ? 128 : 0));
    unsigned char* rowp = WT + (size_t)(r0 + n) * ldk + k0;
#pragma unroll
    for (int j = 0; j < 4; ++j) { const int pc = 2 * j + h; const LAS float* sp = scr + (16 * pc) * 36 + n; u32x4 o;
        o.x = pk4_fp8(sp[0 * 36] * f8scale, sp[1 * 36] * f8scale, sp[2 * 36] * f8scale, sp[3 * 36] * f8scale); o.y = pk4_fp8(sp[4 * 36] * f8scale, sp[5 * 36] * f8scale, sp[6 * 36] * f8scale, sp[7 * 36] * f8scale);
        o.z = pk4_fp8(sp[8 * 36] * f8scale, sp[9 * 36] * f8scale, sp[10 * 36] * f8scale, sp[11 * 36] * f8scale); o.w = pk4_fp8(sp[12 * 36] * f8scale, sp[13 * 36] * f8scale, sp[14 * 36] * f8scale, sp[15 * 36] * f8scale);
        *(u32x4*)(rowp + 16 * pc) = o; }
    asm volatile("s_waitcnt lgkmcnt(0)" ::: "memory");
}
DI void transpose_item(const float* W, int K, int N, bf16_t* WT, int ldk, int mode, LAS float* scr, int item, int lane, float f8scale = 0.f, float wmul = 1.f) {
    f32x4 t[16];
    if (f8scale != 0.f) { tr_load8(W, K, N, item, lane, t); tr_emit8(t, K, N, (unsigned char*)WT, ldk, mode, scr, item, lane, f8scale); }
    else { tr_load(W, K, N, item, lane, t); tr_emit(t, K, N, WT, ldk, mode, scr, item, lane, f8scale, wmul); }
}

struct TrItem { const float* W; int K, N; bf16_t* WT; int ldk, mode; float f8, wm; int item; bool ok; };
DI TrItem tr_decode(const Ctx& C, int g) {
    TrItem r; r.ok = false; r.W = nullptr; r.K = 64; r.N = 64; r.WT = nullptr; r.ldk = 0; r.mode = 0; r.f8 = 0.f; r.wm = 1.f; r.item = 0;
    bool done = false;
#define TJ(in_, K_, N_, dst_, ldk_, mode_, nmat_, ss_, dsb_, f8_, wm_) if (!done) { const int per = ((K_) / 64) * (((N_) + 63) / 64), tot = per * (nmat_); \
        if (g < tot) { const int mi = g / per; r.item = g - mi * per; r.W = INF(in_) + (size_t)mi * (ss_); r.K = (K_); r.N = (N_); r.WT = (bf16_t*)(C.ws + (dst_) + (size_t)mi * (dsb_)); r.ldk = (ldk_); r.mode = (mode_); r.f8 = (f8_); r.wm = (wm_); r.ok = true; done = true; } else g -= tot; }
    TJ(I_MG, 1024, MFF, WS_MGU, 1024, 1, 16, (size_t)1024 * MFF, (size_t)2 * MFF * 1024, 64.f * GLU_GS, 1.f)
    TJ(I_MU, 1024, MFF, WS_MGU, 1024, 2, 16, (size_t)1024 * MFF, (size_t)2 * MFF * 1024, 64.f * GLU_US, 1.f)
    TJ(I_MD, MFF, 1024, WS_MD, MFF, 0, 8, (size_t)MFF * 1024, (size_t)1024 * MFF, 64.f, 1.f)
    TJ(I_WIN, 1024, INC, WS_WIN, 1024, 0, NL, (size_t)1024 * INC, (size_t)INCP * 1024 * 2, 0.f, 1.f)
    TJ(I_WOUT, 1024, 1024, WS_WOUT, 1024, 0, NL, (size_t)1024 * 1024, (size_t)1024 * 1024 * 2, 0.f, 1.f)
    TJ(I_WUQ, 256, 768, WS_WUQ, 256, 0, NL, (size_t)256 * 768, (size_t)768 * 256 * 2, 0.f, 1.f)
    TJ(I_FG, 1024, FF, WS_FGU, 1024, 1, 2, (size_t)1024 * FF, (size_t)2 * FF * 1024 * 2, 0.f, GLU_GS)
    TJ(I_FU, 1024, FF, WS_FGU, 1024, 2, 2, (size_t)1024 * FF, (size_t)2 * FF * 1024 * 2, 0.f, GLU_US)
    TJ(I_WUKV, 128, 1024, WS_WUKV, 256, 0, NL, (size_t)128 * 1024, (size_t)1024 * 256 * 2, 0.f, 1.f)
    TJ(I_RWUP, 64, 256, WS_LORA, 256, 0, NL, (size_t)64 * 256, (size_t)768 * 256 * 2, 0.f, 1.f)
    TJ(I_RAUP, 64, 256, WS_LORA + (size_t)(256 * 256 + 64) * 2, 256, 0, NL, (size_t)64 * 256, (size_t)768 * 256 * 2, 0.f, 1.f)
    TJ(I_RGUP, 128, 256, WS_LORA + (size_t)(512 * 256 + 128) * 2, 256, 0, NL, (size_t)128 * 256, (size_t)768 * 256 * 2, 0.f, 1.f)
#if DENSE_DN8
    TJ(I_FD, FF, 1024, WS_FD, FF, 0, 2, (size_t)FF * 1024, (size_t)1024 * FF, 64.f, 1.f)
#else
    TJ(I_FD, FF, 1024, WS_FD, FF, 0, 2, (size_t)FF * 1024, (size_t)1024 * FF * 2, 0.f, 1.f)
#endif
#undef TJ
    return r;
}

DI void phase_prologue(Ctx C) {
    LAS float* scr = (LAS float*)(C.lds + (C.wave < 7 ? C.wave * 18432 : 131072 + 4096));
    {
        TrItem cur = tr_decode(C, C.gw); f32x4 t[16];
        if (cur.ok) { if (cur.f8 != 0.f) tr_load8(cur.W, cur.K, cur.N, cur.item, C.lane, t); else tr_load(cur.W, cur.K, cur.N, cur.item, C.lane, t); }
        for (int g = C.gw; cur.ok; g += C.NGW) {
            const TrItem nxt = tr_decode(C, g + C.NGW); f32x4 tn[16];
            if (nxt.ok) { if (nxt.f8 != 0.f) tr_load8(nxt.W, nxt.K, nxt.N, nxt.item, C.lane, tn); else tr_load(nxt.W, nxt.K, nxt.N, nxt.item, C.lane, tn); }
            if (cur.f8 != 0.f) tr_emit8(t, cur.K, cur.N, (unsigned char*)cur.WT, cur.ldk, cur.mode, scr, cur.item, C.lane, cur.f8);
            else tr_emit(t, cur.K, cur.N, cur.WT, cur.ldk, cur.mode, scr, cur.item, C.lane, cur.f8, cur.wm);
#pragma unroll
            for (int i = 0; i < 16; ++i) t[i] = tn[i];
            cur = nxt;
        }
    }
    {
        for (int i = C.gtid; i < NL * 96 * 1024; i += C.NT) { const int l = i / (96 * 1024), r = i % (96 * 1024); ((bf16_t*)(C.ws + WS_WIN))[(size_t)l * INCP * 1024 + (size_t)INC * 1024 + r] = 0; }
        for (int i = C.gtid; i < NL * 1024 * 16; i += C.NT) { const int row = i >> 4, c = i & 15; *(u32x4*)((bf16_t*)(C.ws + WS_WUKV) + (size_t)row * 256 + 128 + c * 8) = (u32x4){0u, 0u, 0u, 0u}; }
        for (int i = C.gtid; i < NL * 768 * 32; i += C.NT) { const int row = i >> 5, c8 = (i & 31) * 8, n = row % 768;
            const bool z = (n < 256) ? (c8 >= 64) : (n < 512) ? (c8 < 64 || c8 >= 128) : (c8 < 128);
            if (z) *(u32x4*)((bf16_t*)(C.ws + WS_LORA) + (size_t)row * 256 + c8) = (u32x4){0u, 0u, 0u, 0u}; }
        const int* pos = KARG(C, 8 * I_POS, const int*);
        for (int i = C.gtid; i < M * 16; i += C.NT) { const int m = i >> 4, f = i & 15; const float inv = powf(10000.0f, -(float)(2 * f) / 32.0f); const float ang = (float)pos[m] * inv;
            ((float*)(C.ws + WS_COS))[i] = cosf(ang); ((float*)(C.ws + WS_SIN))[i] = sinf(ang); }
    }
    {
        LAS float* red = (LAS float*)(C.lds);
        LAS float* sc = (LAS float*)(C.lds + 8192);
        __syncthreads();
        if (blockIdx.x < 6144 / 64) { for (int i = C.tid; i < 4096; i += NTHREADS) sc[(i & 1023) * 4 + (i >> 10)] = siluf_(INF(I_C)[i]); }
        for (int it = blockIdx.x; it < 6144 / 64; it += gridDim.x) {
            __syncthreads();
            const int n = it * 64 + C.lane; float acc[4] = {0.f, 0.f, 0.f, 0.f};
#pragma unroll 8
            for (int k = C.wave * 128; k < C.wave * 128 + 128; ++k) { const float w = INF(I_ADAW)[(size_t)k * 6144 + n]; const f32x4 s4 = *(const LAS f32x4*)(sc + k * 4);
#pragma unroll
                for (int b = 0; b < 4; ++b) acc[b] += s4[b] * w; }
#pragma unroll
            for (int b = 0; b < 4; ++b) red[(C.wave * 4 + b) * 64 + C.lane] = acc[b];
            __syncthreads();
            if (C.tid < 256) { const int b = C.tid >> 6, l = C.tid & 63; float s = INF(I_ADAB)[it * 64 + l];
                for (int w = 0; w < 8; ++w) s += red[(w * 4 + b) * 64 + l];
                ((float*)(C.ws + WS_COND))[b * 6144 + it * 64 + l] = s; }
        }
        __syncthreads();
    }
}


DI void late_convert(Ctx C, unsigned* qctr) {
    LAS float* scr = (LAS float*)(C.lds + (C.wave < 7 ? C.wave * 18432 : 131072 + 4096));
    constexpr int P_M = 16 * 56, NTOT = 8 * P_M;
    for (;;) {
        unsigned base = 0; if (C.lane == 0) base = __hip_atomic_fetch_add(qctr, 8u, __ATOMIC_RELAXED, __HIP_MEMORY_SCOPE_AGENT);
        base = __builtin_amdgcn_readfirstlane(base);
        if (base >= (unsigned)NTOT) break;
        for (int q = 0; q < 8; ++q) { const int it = (int)base + q; if (it >= NTOT) break; const int mi = 8 + it / P_M;
            transpose_item(INF(I_MD) + (size_t)mi * MFF * 1024, MFF, 1024, (bf16_t*)(C.ws + WS_MD + (size_t)mi * 1024 * MFF), MFF, 0, scr, it % P_M, C.lane, 64.f); }
    }
}

DI void phase_norm(Ctx C, int layer, int which_norm, bool combine_prev, bool route) {
    const float* xin = (layer == 0 && which_norm == 0) ? INF(I_X) : OUTP(C);
    float* xout = OUTP(C);
    bf16_t* H = (bf16_t*)(C.ws + WS_H);
    const int prev = layer - 1, mi_prev = prev >> 1;
    unsigned* ctl = (unsigned*)(C.ws + WS_CTL);
    const float* cond = (const float*)(C.ws + WS_COND); const float* lbias = INF(I_ADALB);
    LAS float* rt = (LAS float*)C.lds;
    const int mi = layer >> 1;
    LAS int* sel_e = (LAS int*)(C.lds + 40960); LAS float* sel_p = (LAS float*)(C.lds + 40960 + 4096); LAS int* lcnt = (LAS int*)(C.lds + 40960 + 8192);
    if (route) { const float* R = INF(I_ROUTER) + (size_t)mi * DM * NE;
        for (int i = C.tid; i < DM * NE; i += NTHREADS) rt[(i & 7) * DM + (i >> 3)] = R[i];
        if (C.tid < 16) lcnt[C.tid] = 0;
        __syncthreads(); }
    int pst[8];
    if (combine_prev) { const unsigned* cnt = ctl + CW_CNT + 16 * mi_prev; int acc = 0;
#pragma unroll
        for (int e = 0; e < 8; ++e) { pst[e] = acc; acc += ((int)cnt[e] + 255) / 256 * 256; } }
    const int rpw = (M + C.NGW - 1) / C.NGW, m0 = C.gw * rpw, m1 = (m0 + rpw < M) ? m0 + rpw : M;
    int bcur = -1; f32x4 scl[4], sft[4], gtp[4];
    const int wsh = which_norm == 0 ? 0 : 3, wsc = wsh + 1;
    f32x4 vn[4];
    if (m0 < m1) {
#pragma unroll
        for (int j = 0; j < 4; ++j) vn[j] = *(const f32x4*)(xin + (size_t)m0 * DM + C.lane * 4 + 256 * j); }
    for (int m = m0; m < m1; ++m) {
        const int b = m / SEQ;
        if (b != bcur) { bcur = b;
#pragma unroll
            for (int j = 0; j < 4; ++j) { const int c = C.lane * 4 + 256 * j;
                if (which_norm != 2) { const f32x4 g = ld4(INF(which_norm == 0 ? I_N1G : I_N2G) + layer * DM + c);
                    scl[j] = g * (1.f + ld4(cond + b * 6144 + wsc * 1024 + c) + ld4(lbias + layer * 6144 + wsc * 1024 + c)); sft[j] = ld4(cond + b * 6144 + wsh * 1024 + c) + ld4(lbias + layer * 6144 + wsh * 1024 + c); }
                if (combine_prev) gtp[j] = ld4(cond + b * 6144 + 5 * 1024 + c) + ld4(lbias + prev * 6144 + 5 * 1024 + c); } }
        f32x4 v[4];
#pragma unroll
        for (int j = 0; j < 4; ++j) v[j] = vn[j];
        if (m + 1 < m1) {
#pragma unroll
            for (int j = 0; j < 4; ++j) vn[j] = *(const f32x4*)(xin + (size_t)(m + 1) * DM + C.lane * 4 + 256 * j); }
        if (combine_prev) {
            const int* te = (const int*)(C.ws + WS_MOE + MOE_TE); const int* tr = (const int*)(C.ws + WS_MOE + MOE_TR); const float* tp = (const float*)(C.ws + WS_MOE + MOE_TP);
            const bf16_t* YS = (const bf16_t*)(C.ws + WS_YS);
#pragma unroll
            for (int k = 0; k < 2; ++k) {
                const int e = te[m * 2 + k], r = tr[m * 2 + k]; const float p = tp[m * 2 + k];
                int base = 0;
#pragma unroll
                for (int q = 0; q < 8; ++q) base = (q == e) ? pst[q] : base;
                const bf16_t* yr = YS + (size_t)(base + r) * DM;
#pragma unroll
                for (int j = 0; j < 4; ++j) { const u32x2 w = *(const u32x2*)(yr + C.lane * 4 + 256 * j);
                    v[j] += gtp[j] * p * (f32x4){bflo(w.x), bfhi(w.x), bflo(w.y), bfhi(w.y)}; }
            }
#pragma unroll
            for (int j = 0; j < 4; ++j) *(f32x4*)(xout + (size_t)m * DM + C.lane * 4 + 256 * j) = v[j];
        }
        if (which_norm == 2) continue;
        float s = 0.f;
#pragma unroll
        for (int j = 0; j < 4; ++j) s += v[j].x * v[j].x + v[j].y * v[j].y + v[j].z * v[j].z + v[j].w * v[j].w;
        const float rs = rsqrtf(wave_sum(s) * (1.f / DM) + 1e-6f);
        f32x4 hn[4];
#pragma unroll
        for (int j = 0; j < 4; ++j) { hn[j] = v[j] * rs * scl[j] + sft[j];
            if (route) *(LAS unsigned*)(C.lds + 65536 + (C.wave * 8 + (m - m0)) * 1024 + C.lane * 4 + 256 * j) = pk4_fp8(hn[j].x, hn[j].y, hn[j].z, hn[j].w);
            else { u32x2 w; w.x = pk2(hn[j].x, hn[j].y); w.y = pk2(hn[j].z, hn[j].w); *(u32x2*)(H + (size_t)m * DM + C.lane * 4 + 256 * j) = w; } }
        if (route) {
            float lg[8];
#pragma unroll
            for (int e = 0; e < 8; ++e) { float a = 0.f;
#pragma unroll
                for (int j = 0; j < 4; ++j) { const f32x4 rr = *(const LAS f32x4*)(rt + e * DM + C.lane * 4 + 256 * j); a += hn[j].x * rr.x + hn[j].y * rr.y + hn[j].z * rr.z + hn[j].w * rr.w; }
                lg[e] = wave_sum(a); }
            float mx = lg[0];
#pragma unroll
            for (int e = 1; e < 8; ++e) mx = fmaxf(mx, lg[e]);
            float pe[8];
#pragma unroll
            for (int e = 0; e < 8; ++e) pe[e] = __expf(lg[e] - mx);
            int e0 = 0; float p0 = pe[0];
#pragma unroll
            for (int e = 1; e < 8; ++e) if (pe[e] > p0) { p0 = pe[e]; e0 = e; }
            int e1 = -1; float p1 = -1.f;
#pragma unroll
            for (int e = 0; e < 8; ++e) if (e != e0 && pe[e] > p1) { p1 = pe[e]; e1 = e; }
            const float inv = 1.f / (p0 + p1);
            if (C.lane == 0) { const int si = C.wave * 64 + (m - m0); sel_e[si * 2] = e0; sel_e[si * 2 + 1] = e1; sel_p[si * 2] = p0 * inv; sel_p[si * 2 + 1] = p1 * inv; }
        }
    }
    if (route) {
        __syncthreads();
        const int w = C.tid >> 6, i = C.tid & 63; const int wm0 = (blockIdx.x * NWAVES + w) * rpw, wm1 = (wm0 + rpw < M) ? wm0 + rpw : M; const bool act = (wm0 + i) < wm1 && i < 64;
        int e0 = 0, e1 = 0, r0 = 0, r1 = 0;
        if (act) { e0 = sel_e[C.tid * 2]; e1 = sel_e[C.tid * 2 + 1]; r0 = __hip_atomic_fetch_add(&lcnt[e0], 1, __ATOMIC_RELAXED, __HIP_MEMORY_SCOPE_WORKGROUP); r1 = __hip_atomic_fetch_add(&lcnt[e1], 1, __ATOMIC_RELAXED, __HIP_MEMORY_SCOPE_WORKGROUP); }
        __syncthreads();
        if (C.tid < 8) lcnt[8 + C.tid] = (int)atomicAdd(ctl + CW_CNT + 16 * mi + C.tid, (unsigned)lcnt[C.tid]);
        __syncthreads();
        if (act) { const int m = wm0 + i; const int s0 = lcnt[8 + e0] + r0, s1 = lcnt[8 + e1] + r1;
            int* ltok = (int*)(C.ws + WS_MOE + MOE_LTOK); int* te = (int*)(C.ws + WS_MOE + MOE_TE); int* tr = (int*)(C.ws + WS_MOE + MOE_TR); float* tp = (float*)(C.ws + WS_MOE + MOE_TP);
            ltok[e0 * 16384 + s0] = m; ltok[e1 * 16384 + s1] = m;
            te[m * 2] = e0; te[m * 2 + 1] = e1; tr[m * 2] = s0; tr[m * 2 + 1] = s1; tp[m * 2] = sel_p[C.tid * 2]; tp[m * 2 + 1] = sel_p[C.tid * 2 + 1];
            sel_e[C.tid * 2] = e0 * 16384 + s0; sel_e[C.tid * 2 + 1] = e1 * 16384 + s1; }
        __syncthreads();
        { unsigned char* XS = C.ws + WS_XS8;
          for (int q = C.tid; q < 64 * 2 * 64; q += NTHREADS) { const int row = q >> 7, kk = (q >> 6) & 1, pc = q & 63; const int ww = row >> 3, ii = row & 7;
              if ((blockIdx.x * NWAVES + ww) * rpw + ii < M && ii < rpw) { const int dst = sel_e[(ww * 64 + ii) * 2 + kk];
                  *(u32x4*)(XS + (size_t)dst * 1024 + pc * 16) = *(const LAS u32x4*)(C.lds + 65536 + row * 1024 + pc * 16); } } }
        __syncthreads();
    }
}

namespace g8 {
constexpr int BM = 256, BK = 64, HALF = 128, HTB = HALF * BK * 2, STAGE_BYTES = 8 * HTB;
DI int lds_byte(int r, int c) { const int st = (r >> 4) * 2 + (c >> 5), rr = r & 15, cc = c & 31, ob = rr * 64 + cc * 2; return st * 1024 + (ob ^ (((ob >> 9) & 1) << 5)); }
DI void stage_rc(int b, int& R, int& C) { const int st = b / 1024, sb = b % 1024, swz = sb ^ (((sb >> 9) & 1) << 5); R = (st >> 1) * 16 + swz / 64; C = (st & 1) * 32 + (swz % 64) / 2; }
DI int perm32(int rho) { const int n = rho >> 4, i = rho & 15; return 8 * (i >> 2) + 4 * n + (i & 3); }
struct Unit { int pm, pn, orow, e; };

struct EpiStore {
    static constexpr bool PERM = true;
    bf16_t* O; int ldc;
    DI void operator()(const f32x4 (&acc)[2][2][4][2], const Unit& u, int wr, int wc, int fr, int fq) const {
        bf16_t* base = O + (size_t)(u.orow + wr * 64 + fr) * ldc + u.pn * BM + wc * 32 + 8 * fq;
#pragma unroll
        for (int ai = 0; ai < 2; ++ai)
#pragma unroll
            for (int m = 0; m < 4; ++m) { bf16_t* rowp = base + (size_t)(ai * HALF + m * 16) * ldc;
#pragma unroll
                for (int bj = 0; bj < 2; ++bj) { const f32x4 v0 = acc[ai][bj][m][0], v1 = acc[ai][bj][m][1];
                    u32x4 w; w.x = pk2(v0[0], v0[1]); w.y = pk2(v0[2], v0[3]); w.z = pk2(v1[0], v1[1]); w.w = pk2(v1[2], v1[3]);
                    *(u32x4*)(rowp + bj * HALF) = w; } }
    }
};
struct EpiGlu {
    static constexpr bool PERM = true;
    bf16_t* O; int ldc;
    DI void operator()(const f32x4 (&acc)[2][2][4][2], const Unit& u, int wr, int wc, int fr, int fq) const {
        bf16_t* base = O + (size_t)(u.orow + wr * 64 + fr) * ldc + u.pn * HALF + wc * 32 + 8 * fq;
#pragma unroll
        for (int ai = 0; ai < 2; ++ai)
#pragma unroll
            for (int m = 0; m < 4; ++m) { float o[8];
#pragma unroll
                for (int n = 0; n < 2; ++n)
#pragma unroll
                    for (int q = 0; q < 4; q += 2) { const f32x2 g = {acc[ai][0][m][n][q], acc[ai][0][m][n][q + 1]}, uu = {acc[ai][1][m][n][q], acc[ai][1][m][n][q + 1]};
                        f32x2 e; e.x = __builtin_amdgcn_exp2f(g.x); e.y = __builtin_amdgcn_exp2f(g.y); const f32x2 d = e + 1.f; f32x2 r; r.x = __builtin_amdgcn_rcpf(d.x); r.y = __builtin_amdgcn_rcpf(d.y);
                        const f32x2 ov = (g * uu) * r; o[n * 4 + q] = ov.x; o[n * 4 + q + 1] = ov.y; }
                u32x4 w; w.x = pk2(o[0], o[1]); w.y = pk2(o[2], o[3]); w.z = pk2(o[4], o[5]); w.w = pk2(o[6], o[7]);
                *(u32x4*)(base + (size_t)(ai * HALF + m * 16) * ldc) = w; }
    }
};
struct EpiGlu8 {
    static constexpr bool PERM = true;
    unsigned char* O; int ldc;
    DI void operator()(const f32x4 (&acc)[2][2][4][2], const Unit& u, int wr, int wc, int fr, int fq) const {
        const __amdgpu_buffer_rsrc_t rs = __builtin_amdgcn_make_buffer_rsrc((void*)O, (short)0, -1, 0x00020000);
        const int voff = (wr * 64 + fr) * ldc + wc * 32 + 8 * fq, sbase = u.orow * ldc + u.pn * HALF;
#pragma unroll
        for (int ai = 0; ai < 2; ++ai)
#pragma unroll
            for (int m = 0; m < 4; ++m) { float o[8];
#pragma unroll
                for (int n = 0; n < 2; ++n)
#pragma unroll
                    for (int q = 0; q < 4; q += 2) { const f32x2 g = {acc[ai][0][m][n][q], acc[ai][0][m][n][q + 1]}, uu = {acc[ai][1][m][n][q], acc[ai][1][m][n][q + 1]};
                        f32x2 e; e.x = __builtin_amdgcn_exp2f(g.x); e.y = __builtin_amdgcn_exp2f(g.y); const f32x2 d = e + 1.f; f32x2 r; r.x = __builtin_amdgcn_rcpf(d.x); r.y = __builtin_amdgcn_rcpf(d.y);
                        const f32x2 ov = (g * uu) * r; o[n * 4 + q] = ov.x; o[n * 4 + q + 1] = ov.y; }
                u32x2 w; w.x = pk4_fp8(o[0], o[1], o[2], o[3]); w.y = pk4_fp8(o[4], o[5], o[6], o[7]);
                __builtin_amdgcn_raw_buffer_store_b64(w, rs, voff, sbase + (ai * HALF + m * 16) * ldc, 0); }
    }
};
struct EpiStoreB {
    static constexpr bool PERM = true;
    bf16_t* O; int ldc;
    DI void operator()(const f32x4 (&acc)[2][2][4][2], const Unit& u, int wr, int wc, int fr, int fq) const {
        const __amdgpu_buffer_rsrc_t rs = __builtin_amdgcn_make_buffer_rsrc((void*)O, (short)0, -1, 0x00020000);
        const int voff = ((wr * 64 + fr) * ldc + wc * 32 + 8 * fq) * 2, sbase = (u.orow * ldc + u.pn * BM) * 2;
#pragma unroll
        for (int ai = 0; ai < 2; ++ai)
#pragma unroll
            for (int m = 0; m < 4; ++m)
#pragma unroll
                for (int bj = 0; bj < 2; ++bj) { const f32x4 v0 = acc[ai][bj][m][0], v1 = acc[ai][bj][m][1];
                    u32x4 w; w.x = pk2(v0[0], v0[1]); w.y = pk2(v0[2], v0[3]); w.z = pk2(v1[0], v1[1]); w.w = pk2(v1[2], v1[3]);
                    __builtin_amdgcn_raw_buffer_store_b128(w, rs, voff, sbase + ((ai * HALF + m * 16) * ldc + bj * HALF) * 2, 0); }
    }
};
struct EpiResid {
    static constexpr bool PERM = false;
    const float* xin; float* xout; const float* gc; const float* gl;
    DI void operator()(const f32x4 (&acc)[2][2][4][2], const Unit& u, int wr, int wc, int fr, int fq) const {
        const int b = u.orow / SEQ; const int col0 = u.pn * BM + wc * 32 + 4 * fq;
        f32x4 gt[2][2];
#pragma unroll
        for (int bj = 0; bj < 2; ++bj)
#pragma unroll
            for (int n = 0; n < 2; ++n) { const int c = col0 + bj * HALF + n * 16; gt[bj][n] = *(const f32x4*)(gc + b * 6144 + c) + *(const f32x4*)(gl + c); }
#pragma unroll
        for (int ai = 0; ai < 2; ++ai)
#pragma unroll
            for (int m = 0; m < 4; ++m) { const size_t off = (size_t)(u.orow + ai * HALF + wr * 64 + m * 16 + fr) * DM + col0;
#pragma unroll
                for (int bj = 0; bj < 2; ++bj)
#pragma unroll
                    for (int n = 0; n < 2; ++n) { const f32x4 x = *(const f32x4*)(xin + off + bj * HALF + n * 16); *(f32x4*)(xout + off + bj * HALF + n * 16) = x + gt[bj][n] * acc[ai][bj][m][n]; } }
    }
};

template <class Epi, class Sched, bool GATHER, unsigned F8W = 0u  >
DI void gemm_phase(int tid, LAS unsigned char* lds, const bf16_t* A, int lda, int K, const Sched& S, const Epi& E) {
    const int wid = __builtin_amdgcn_readfirstlane(tid >> 6), lane = tid & 63, wr = wid >> 2, wc = wid & 3, fr = lane & 15, fq = lane >> 4;
    const int nt = K / BK;
    unsigned voffA, voffB;
    { int R, C; stage_rc(tid * 16, R, C); const int Rb = Epi::PERM ? ((R & ~31) + perm32(R & 31)) : R; voffA = (unsigned)(R * lda + C) * 2u; voffB = (unsigned)(Rb * K + C) * 2u; }
    const unsigned p1A = 64u * (unsigned)lda * 2u, p1B = 64u * (unsigned)K * 2u;
    const unsigned kstep = (unsigned)(BK * 2);
    const unsigned hstepA = (unsigned)HALF * (unsigned)lda * 2u, hstepB = (unsigned)HALF * (unsigned)K * 2u;
    const __amdgpu_buffer_rsrc_t rsA = __builtin_amdgcn_make_buffer_rsrc((void*)A, (short)0, -1, 0x00020000);
    const __amdgpu_buffer_rsrc_t rsB = __builtin_amdgcn_make_buffer_rsrc((void*)S.bmat(), (short)0, -1, 0x00020000);
    const unsigned ldsw = (unsigned)wid * 1024u;
    const int aoff = lds_byte(wr * 64 + fr, fq * 8), boff = lds_byte(wc * 32 + fr, fq * 8) + 4 * HTB;
#define G8_SA(b, h) (((b) * 2 + (h)) * HTB)
#define G8_SB(b, h) ((4 + (b) * 2 + (h)) * HTB)
#define G8_SBR(b, h) (((b) * 2 + (h)) * HTB)
#define G8_STAGE(bufoff, rs, soff, voff) do { __builtin_amdgcn_raw_ptr_buffer_load_lds(rs, (LAS unsigned*)(lds + (bufoff) + ldsw), 16, (int)(voff), (int)(soff), 0, 0); \
        __builtin_amdgcn_raw_ptr_buffer_load_lds(rs, (LAS unsigned*)(lds + (bufoff) + ldsw + 8192), 16, (int)(voff), (int)((soff) + p1##voff), 0, 0); } while (0)
#define p1voffA p1A
#define p1voffB p1B
#define G8_LDA(dst, b, h) do { if constexpr (F8W != 0u) { _Pragma("unroll") for (int m = 0; m < 4; ++m) dst##8[m] = __builtin_shufflevector(*(const LAS v4i_t*)(lds + G8_SA(b, h) + aoff + m * 2048), *(const LAS v4i_t*)(lds + G8_SA(b, h) + aoff + m * 2048 + 1024), 0, 1, 2, 3, 4, 5, 6, 7); } \
        else { _Pragma("unroll") for (int m = 0; m < 4; ++m) _Pragma("unroll") for (int k = 0; k < 2; ++k) dst[m][k] = *(const LAS bf16x8*)(lds + G8_SA(b, h) + aoff + m * 2048 + k * 1024); } } while (0)
#define G8_LDB(dst, b, h) do { if constexpr (F8W != 0u) { _Pragma("unroll") for (int n = 0; n < 2; ++n) dst##8[n] = __builtin_shufflevector(*(const LAS v4i_t*)(lds + G8_SBR(b, h) + boff + n * 2048), *(const LAS v4i_t*)(lds + G8_SBR(b, h) + boff + n * 2048 + 1024), 0, 1, 2, 3, 4, 5, 6, 7); } \
        else { _Pragma("unroll") for (int n = 0; n < 2; ++n) _Pragma("unroll") for (int k = 0; k < 2; ++k) dst[n][k] = *(const LAS bf16x8*)(lds + G8_SBR(b, h) + boff + n * 2048 + k * 1024); } } while (0)
#define G8_MMA(ai, bj, At, Bt) do { __builtin_amdgcn_s_setprio(1); if constexpr (F8W != 0u) { _Pragma("unroll") for (int m = 0; m < 4; ++m) _Pragma("unroll") for (int n = 0; n < 2; ++n) \
        acc[ai][bj][m][n] = __builtin_amdgcn_mfma_scale_f32_16x16x128_f8f6f4(Bt##8[n], At##8[m], acc[ai][bj][m][n], 0, 0, 0, (int)F8W, 0, (int)F8W); } else { \
        _Pragma("unroll") for (int m = 0; m < 4; ++m) _Pragma("unroll") for (int n = 0; n < 2; ++n) _Pragma("unroll") for (int k = 0; k < 2; ++k) \
        acc[ai][bj][m][n] = __builtin_amdgcn_mfma_f32_16x16x32_bf16(Bt[n][k], At[m][k], acc[ai][bj][m][n], 0, 0, 0); } __builtin_amdgcn_s_setprio(0); } while (0)
#define G8_LDA_H(b, h, mh) do { _Pragma("unroll") for (int m = 0; m < 2; ++m) At8[m] = __builtin_shufflevector(*(const LAS v4i_t*)(lds + G8_SA(b, h) + aoff + ((mh) * 2 + m) * 2048), *(const LAS v4i_t*)(lds + G8_SA(b, h) + aoff + ((mh) * 2 + m) * 2048 + 1024), 0, 1, 2, 3, 4, 5, 6, 7); } while (0)
#define G8_MMA_H(ai, bj, Bt, mh) do { __builtin_amdgcn_s_setprio(1); _Pragma("unroll") for (int m = 0; m < 2; ++m) _Pragma("unroll") for (int n = 0; n < 2; ++n) \
        acc[ai][bj][(mh) * 2 + m][n] = __builtin_amdgcn_mfma_scale_f32_16x16x128_f8f6f4(Bt##8[n], At8[m], acc[ai][bj][(mh) * 2 + m][n], 0, 0, 0, (int)F8W, 0, (int)F8W); __builtin_amdgcn_s_setprio(0); } while (0)
#define G8_WAIT_V(n) asm volatile("s_waitcnt vmcnt(" #n ")" ::: "memory")
#define G8_WAIT_L(n) asm volatile("s_waitcnt lgkmcnt(" #n ")" ::: "memory")
#define G8_BAR __builtin_amdgcn_s_barrier()
#define G8_SCHED __builtin_amdgcn_sched_barrier(0)
    Unit cur, nxt; int ui = 0;
    if (!S.next(0, cur)) return;
    f32x4 acc[2][2][4][2]; const float z0 = ozero();
#pragma unroll
    for (int a = 0; a < 2; ++a)
#pragma unroll
        for (int b = 0; b < 2; ++b)
#pragma unroll
            for (int m = 0; m < 4; ++m)
#pragma unroll
                for (int n = 0; n < 2; ++n) acc[a][b][m][n] = (f32x4){z0, z0, z0, z0};
    bf16x8 At[4][2], B0[2][2], B1[2][2]; v8i_t At8[4], B08[2], B18[2];
    unsigned cA = 0u;
    LAS unsigned* gtab = (LAS unsigned*)(lds + STAGE_BYTES + 4096) + tid * 4;
#define G8_GOFF(p, unit) do { u32x4 o_; { int R_, C_; stage_rc(tid * 16, R_, C_); o_.x = S.arow(unit, R_) + (unsigned)C_ * 2u; o_.z = S.arow(unit, HALF + R_) + (unsigned)C_ * 2u; } \
        { int R_, C_; stage_rc(tid * 16 + 8192, R_, C_); o_.y = S.arow(unit, R_) + (unsigned)C_ * 2u; o_.w = S.arow(unit, HALF + R_) + (unsigned)C_ * 2u; } *(LAS u32x4*)(gtab + (p) * 2048) = o_; } while (0)
#define G8_STAGE_G(bufoff, soff, p, h) do { const u32x2 v_ = *(const LAS u32x2*)(gtab + (p) * 2048 + (h) * 2); \
        __builtin_amdgcn_raw_ptr_buffer_load_lds(rsA, (LAS unsigned*)(lds + (bufoff) + ldsw), 16, (int)v_.x, (int)(soff), 0, 0); \
        __builtin_amdgcn_raw_ptr_buffer_load_lds(rsA, (LAS unsigned*)(lds + (bufoff) + ldsw + 8192), 16, (int)v_.y, (int)(soff), 0, 0); } while (0)
    if constexpr (GATHER) { G8_GOFF(0, cur); cA = 0u; } else { cA = S.aoffs(cur); }
    unsigned cB = S.boffs(cur);
#define G8_STA_C(bufoff, h, kb) do { if constexpr (GATHER) { G8_STAGE_G(bufoff, cA + (kb), ui & 1, h); } else { G8_STAGE(bufoff, rsA, cA + (h) * hstepA + (kb), voffA); } } while (0)
    G8_STAGE(G8_SB(0, 0), rsB, cB, voffB); G8_STAGE(G8_SB(0, 1), rsB, cB + hstepB, voffB); G8_STA_C(G8_SA(0, 0), 0, 0); G8_STA_C(G8_SA(0, 1), 1, 0);
    if (wr == 1) G8_BAR;
    G8_WAIT_V(2); G8_BAR;
    G8_STAGE(G8_SB(1, 0), rsB, cB + kstep, voffB); G8_STA_C(G8_SA(1, 0), 0, kstep); G8_STAGE(G8_SB(1, 1), rsB, cB + hstepB + kstep, voffB);
    G8_WAIT_V(6); G8_BAR;
    for (;;) {
        const bool has_next = S.next(ui + 1, nxt);
        unsigned nA = cA; const unsigned nB = has_next ? S.boffs(nxt) : cB;
        if constexpr (GATHER) { if (has_next) { G8_GOFF((ui + 1) & 1, nxt); } else { G8_GOFF((ui + 1) & 1, cur); } } else { nA = has_next ? S.aoffs(nxt) : cA; }
#pragma nounroll
        for (int t = 0; t < nt; t += 2) {
            const bool last = (t == nt - 2);
            const unsigned k1 = (unsigned)(t + 1) * kstep;
            const unsigned b2 = last ? nB : cB + (unsigned)(t + 2) * kstep; const unsigned b3 = b2 + kstep;
            unsigned a2 = 0u;
            if constexpr (GATHER) { a2 = last ? cA : cA + (unsigned)(t + 2) * kstep; } else { a2 = last ? nA : cA + (unsigned)(t + 2) * kstep; }
            const unsigned a3 = a2 + kstep;
#define G8_STA_2(bufoff, h, base) do { if constexpr (GATHER) { G8_STAGE_G(bufoff, base, (ui + (last ? 1 : 0)) & 1, h); } else { G8_STAGE(bufoff, rsA, (base) + (h) * hstepA, voffA); } } while (0)
            G8_LDB(B0, 0, 0); G8_LDB(B1, 0, 1); G8_SCHED; G8_LDA(At, 0, 0); G8_STA_C(G8_SA(1, 1), 1, k1);
            G8_WAIT_V(8); G8_WAIT_L(0); G8_BAR; G8_MMA(0, 0, At, B0); G8_MMA(0, 1, At, B1); G8_BAR; G8_SCHED;
            G8_LDA(At, 0, 1); G8_STAGE(G8_SB(0, 0), rsB, b2, voffB); G8_STAGE(G8_SB(0, 1), rsB, b2 + hstepB, voffB); G8_STA_2(G8_SA(0, 0), 0, a2);
            G8_WAIT_V(8); G8_WAIT_L(0); G8_BAR; G8_MMA(1, 0, At, B0); G8_MMA(1, 1, At, B1); G8_BAR; G8_SCHED;
            G8_LDB(B0, 1, 0); G8_LDB(B1, 1, 1); G8_SCHED; G8_LDA(At, 1, 0); G8_STA_2(G8_SA(0, 1), 1, a2);
            G8_WAIT_V(8); G8_WAIT_L(0); G8_BAR; G8_MMA(0, 0, At, B0); G8_MMA(0, 1, At, B1); G8_BAR; G8_SCHED;
            G8_LDA(At, 1, 1); G8_STAGE(G8_SB(1, 0), rsB, b3, voffB); G8_STAGE(G8_SB(1, 1), rsB, b3 + hstepB, voffB); G8_STA_2(G8_SA(1, 0), 0, a3);
            G8_WAIT_V(8); G8_WAIT_L(0); G8_BAR; G8_MMA(1, 0, At, B0); G8_MMA(1, 1, At, B1); G8_BAR; G8_SCHED;
#undef G8_STA_2
        }
        if (wr == 0) G8_BAR;
        { int te = tid; asm volatile("" : "+v"(te)); const int fre = te & 15, fqe = (te & 63) >> 4;
          E(acc, cur, wr, wc, fre, fqe); }
        if (!has_next) break;
#pragma unroll
        for (int a = 0; a < 2; ++a)
#pragma unroll
            for (int b = 0; b < 2; ++b)
#pragma unroll
                for (int m = 0; m < 4; ++m)
#pragma unroll
                    for (int n = 0; n < 2; ++n) acc[a][b][m][n] = (f32x4){z0, z0, z0, z0};
        cur = nxt; cB = nB; ++ui;
        if constexpr (!GATHER) { cA = nA; }
        if (wr == 1) G8_BAR;
    }
    G8_WAIT_V(0);
    G8_BAR;
#undef G8_STA_C
#undef G8_GOFF
#undef G8_STAGE_G
#undef G8_SA
#undef G8_SB
#undef G8_SBR
#undef G8_STAGE
#undef p1voffA
#undef p1voffB
#undef G8_LDA
#undef G8_LDB
#undef G8_MMA
#undef G8_MMA_H
#undef G8_LDA_H
#undef G8_WAIT_V
#undef G8_WAIT_L
#undef G8_BAR
#undef G8_SCHED
}

struct DenseOrder {
    const char* A; const char* Bt; int lda, K, nM, nN, nwg, G, c;
    DI void init(const bf16_t* A_, int lda_, const bf16_t* Bt_, int K_, int M_, int N_, int G_, int c_) { A = (const char*)A_; Bt = (const char*)Bt_; lda = lda_; K = K_; nM = M_ / BM; nN = N_ / BM; nwg = nM * nN; G = G_; c = c_; }
    DI bool next(int i, Unit& u) const {
        const long L = (long)i * G + c; if (L >= nwg) return false;
        int wgid = (int)L; { const int q = nwg / 8, r = nwg % 8, xcd = wgid % 8, off = wgid / 8; wgid = (xcd < r ? xcd * (q + 1) : r * (q + 1) + (xcd - r) * q) + off; }
        const int nig = 8 * nN, gid = wgid / nig, fm = gid * 8, gsz = (nM - fm) < 8 ? (nM - fm) : 8;
        u.pm = fm + ((wgid % nig) % gsz); u.pn = (wgid % nig) / gsz; u.orow = u.pm * BM; u.e = 0; return true;
    }
    DI unsigned aoffs(const Unit& u) const { return (unsigned)u.pm * (unsigned)(BM * 2) * (unsigned)lda; }
    DI unsigned boffs(const Unit& u) const { return (unsigned)u.pn * (unsigned)(BM * 2) * (unsigned)K; }
    DI const char* bmat() const { return Bt; }
    DI unsigned arow(const Unit&, int) const { return 0u; }
};
}

constexpr int TAB_OFF = 131072 + 1024;
DI void moe_tables(const Ctx& C, const unsigned* cnt, int gran) {
    __syncthreads();
    if (C.tid == 0) { LAS int* tst = (LAS int*)(C.lds + TAB_OFF); LAS int* pst = tst + 16; int a1 = 0, a2 = 0;
        for (int e = 0; e < 8; ++e) { const int c = (int)cnt[e]; tst[e] = a1; pst[e] = a2; a1 += (c + gran - 1) / gran; a2 += (c + 255) / 256 * 256; }
        tst[8] = a1; }
    __syncthreads();
}

namespace g8 {
struct MoeOrder {
    const int* ltok; const unsigned* cnt; const LAS int* tst; const LAS int* pst; const char* A; const char* Bt; size_t bstride; int lda, K, nN, nU, G, c; bool xs;
    DI void init(const Ctx& C, const unsigned* cnt_, const char* A_, int lda_, const char* Bt_, size_t bstride_, int K_, int N_) {
        ltok = (const int*)(C.ws + WS_MOE + MOE_LTOK); cnt = cnt_; tst = (const LAS int*)(C.lds + TAB_OFF); pst = tst + 16; A = A_; Bt = Bt_; bstride = bstride_; lda = lda_; K = K_; nN = N_ / BM; xs = false;
        nU = tst[8] * nN; G = gridDim.x; c = blockIdx.x; }
    DI bool next(int i, Unit& u) const {
        const int L = i * G + c; if (L >= nU) return false;
        const int tile = L / nN; int e = 0;
#pragma unroll
        for (int q = 1; q < 8; ++q) if (tile >= tst[q]) e = q;
        e = __builtin_amdgcn_readfirstlane(e);
        u.e = e; u.pm = tile - tst[e]; u.pn = L % nN; u.orow = pst[e] + u.pm * BM; return true;
    }
    DI unsigned arow(const Unit& u, int lr) const { const int r = u.pm * BM + lr; const int tok = (r < (int)cnt[u.e]) ? ltok[u.e * 16384 + r] : 0; return (unsigned)tok * (unsigned)lda * 2u; }
    DI unsigned aoffs(const Unit& u) const { return (xs ? (unsigned)(u.e * 16384 + u.pm * BM) : (unsigned)u.orow) * (unsigned)lda * 2u; }
    DI unsigned boffs(const Unit& u) const { return (unsigned)u.e * (unsigned)bstride + (unsigned)u.pn * (unsigned)(BM * 2) * (unsigned)K; }
    DI const char* bmat() const { return Bt; }
};
}

DI void phase_conv(Ctx C, int layer) {
    const bf16_t* U = (const bf16_t*)(C.ws + WS_U); bf16_t* MX = (bf16_t*)(C.ws + WS_MIXED);
    LAS float* z = (LAS float*)C.lds;
    const int ch = C.tid & 255, half = C.tid >> 8;
    float w[CONVK];
#pragma unroll
    for (int i = 0; i < CONVK; ++i) w[i] = INF(I_CONVW)[(size_t)layer * CONVK * CONVC + i * CONVC + ch];
    const float bias = INF(I_CONVB)[layer * CONVC + ch];
    for (int it = blockIdx.x; it < M / 64; it += gridDim.x) {
        const int b = it / (SEQ / 64), t0 = (it % (SEQ / 64)) * 64;
        __syncthreads();
        { u32x4 ra[6], rg[6];
#pragma unroll
          for (int q = 0; q < 6; ++q) { const int p = C.tid + q * NTHREADS; const int i = p >> 5, c8 = (p & 31) * 8, t = t0 - 30 + i;
              if (p < 94 * 32 && t >= 0) { const size_t m = (size_t)b * SEQ + t; ra[q] = *(const u32x4*)(U + m * INCP + c8); rg[q] = *(const u32x4*)(U + m * INCP + 256 + c8); }
              else { ra[q] = (u32x4){0u, 0u, 0u, 0u}; rg[q] = (u32x4){0u, 0u, 0u, 0u}; } }
#pragma unroll
          for (int q = 0; q < 6; ++q) { const int p = C.tid + q * NTHREADS; const int i = p >> 5, c8 = (p & 31) * 8;
              if (p < 94 * 32) { float a[8], g[8], zz[8]; unpack8(ra[q], a); unpack8(rg[q], g);
#pragma unroll
                  for (int e = 0; e < 8; ++e) zz[e] = a[e] * fsigmoid(g[e]);
                  *(LAS f32x4*)(z + i * 256 + c8) = (f32x4){zz[0], zz[1], zz[2], zz[3]}; *(LAS f32x4*)(z + i * 256 + c8 + 4) = (f32x4){zz[4], zz[5], zz[6], zz[7]}; } } }
        __syncthreads();
        float o[32];
        { float zr[62];
#pragma unroll
          for (int i = 0; i < 62; ++i) zr[i] = z[(half * 32 + i) * 256 + ch];
#pragma unroll
          for (int tt = 0; tt < 32; ++tt) { float acc = bias;
#pragma unroll
              for (int i = 0; i < CONVK; ++i) acc += zr[tt + i] * w[i];
              o[tt] = acc; } }
        __syncthreads();
#pragma unroll
        for (int tt = 0; tt < 32; ++tt) z[(half * 32 + tt) * 256 + ch] = o[tt];
        __syncthreads();
        for (int tt = C.wave * 8; tt < C.wave * 8 + 8; ++tt) {
            const f32x4 v = *(const LAS f32x4*)(z + tt * 256 + C.lane * 4);
            const float mean = wave_sum(v.x + v.y + v.z + v.w) * (1.f / 256.f);
            const f32x4 d = v - mean;
            const float var = wave_sum(d.x * d.x + d.y * d.y + d.z * d.z + d.w * d.w) * (1.f / 256.f);
            const float rs = rsqrtf(var + 1e-5f);
            const f32x4 lg = *(const f32x4*)(INF(I_CONVLG) + layer * 256 + C.lane * 4), lb = *(const f32x4*)(INF(I_CONVLB) + layer * 256 + C.lane * 4);
            f32x4 y = d * rs * lg + lb;
            u32x2 o2; o2.x = pk2(siluf_(y.x), siluf_(y.y)); o2.y = pk2(siluf_(y.z), siluf_(y.w));
            *(u32x2*)(MX + ((size_t)b * SEQ + t0 + tt) * DM + C.lane * 4) = o2;
        }
    }
    __syncthreads();
}

DI void phase_prep1(Ctx C, int layer) {
    bf16_t* U = (bf16_t*)(C.ws + WS_U);
    bf16_t* RR = (bf16_t*)(C.ws + WS_RR); bf16_t* RK = (bf16_t*)(C.ws + WS_RK); bf16_t* RV = (bf16_t*)(C.ws + WS_RV); bf16_t* RKK = (bf16_t*)(C.ws + WS_RKK); bf16_t* LIN = (bf16_t*)(C.ws + WS_LIN);
    const int l = C.lane;
    float mu[16], kkw[16];
    { const float* mup = INF(I_RMU) + layer * 1024 + l * 16;
#pragma unroll
      for (int i = 0; i < 16; i += 4) { const f32x4 t4 = ld4(mup + i); mu[i] = t4.x; mu[i + 1] = t4.y; mu[i + 2] = t4.z; mu[i + 3] = t4.w; }
      const float* kp = INF(I_RKK) + layer * RC + ((l >= 16 && l < 32) ? (l - 16) * 16 : 0);
#pragma unroll
      for (int i = 0; i < 16; i += 4) { const f32x4 t4 = ld4(kp + i); kkw[i] = t4.x; kkw[i + 1] = t4.y; kkw[i + 2] = t4.z; kkw[i + 3] = t4.w; } }
    const f32x4 gq = ld4(INF(I_QNG) + layer * 256 + l * 4); const f32x2 gkv = *(const f32x2*)(INF(I_KVNG) + layer * 128 + l * 2);
    const int rpw = (M + C.NGW - 1) / C.NGW, m0 = C.gw * rpw, m1 = (m0 + rpw < M) ? m0 + rpw : M;
    bf16_t* dst0 = (l < 16) ? RR + l * 16 : (l < 32) ? RK + (l - 16) * 16 : (l < 48) ? RV + (l - 32) * 16 : LIN + (l - 48) * 16; const int dpitch = RC;
    const bool actraw = (l >= 52 && l < 56); const float acta = (l < 52) ? 2.f : 1.f, actb = (l < 52) ? 2.f : 1.f, actc = (l < 52) ? -1.f : 0.f;
    float prv[16];
    u32x4 nr0, nr1; u32x2 nq; unsigned nkv;
    if (m0 < m1) { const bf16_t* rw = U + (size_t)m0 * INCP; nr0 = *(const u32x4*)(rw + U_RW + l * 16); nr1 = *(const u32x4*)(rw + U_RW + l * 16 + 8); nq = *(const u32x2*)(rw + U_CQ + l * 4); nkv = *(const unsigned*)(rw + U_CKV + l * 2); }
    for (int m = m0; m < m1; ++m) {
        bf16_t* row = U + (size_t)m * INCP;
        float cur[16]; unpack8(nr0, cur); unpack8(nr1, cur + 8);
        const u32x2 w = nq; const unsigned w2 = nkv;
        if (m + 1 < m1) { const bf16_t* rw = row + INCP; nr0 = *(const u32x4*)(rw + U_RW + l * 16); nr1 = *(const u32x4*)(rw + U_RW + l * 16 + 8); nq = *(const u32x2*)(rw + U_CQ + l * 4); nkv = *(const unsigned*)(rw + U_CKV + l * 2); }
        if (m == m0) { if (m % SEQ != 0) { unpack8(*(const u32x4*)(row - INCP + U_RW + l * 16), prv); unpack8(*(const u32x4*)(row - INCP + U_RW + l * 16 + 8), prv + 8); } }
        if (m % SEQ == 0) {
#pragma unroll
            for (int i = 0; i < 16; ++i) prv[i] = 0.f; }
        { const float v0 = bflo(w.x), v1 = bfhi(w.x), v2 = bflo(w.y), v3 = bfhi(w.y);
          const float c0 = bflo(w2), c1 = bfhi(w2);
          float sq = v0 * v0 + v1 * v1 + v2 * v2 + v3 * v3, sk = c0 * c0 + c1 * c1;
#pragma unroll
          for (int o = 1; o < 32; o <<= 1) { sq += shx(sq, o); sk += shx(sk, o); }
          sq = shx32_sum(sq); sk = shx32_sum(sk);
          const float rq = rsqrtf(sq * (1.f / 256.f) + 1e-6f), rk = rsqrtf(sk * (1.f / 128.f) + 1e-6f);
          u32x2 o; o.x = pk2(v0 * rq * gq.x, v1 * rq * gq.y); o.y = pk2(v2 * rq * gq.z, v3 * rq * gq.w); *(u32x2*)(row + U_CQ + l * 4) = o;
          *(unsigned*)(row + U_CKV + l * 2) = pk2(c0 * rk * gkv.x, c1 * rk * gkv.y); }
        float uf[16];
#pragma unroll
        for (int i = 0; i < 16; ++i) { uf[i] = cur[i] + (prv[i] - cur[i]) * mu[i]; prv[i] = cur[i]; }
        float kk[16]; float ss = 0.f;
#pragma unroll
        for (int i = 0; i < 16; ++i) { kk[i] = uf[i] * kkw[i]; ss += kk[i] * kk[i]; }
        ss += shx(ss, 1); ss += shx(ss, 2);
        const float inrm = 1.f / fmaxf(sqrtf(ss), 1e-12f);
        if (l >= 48) {
#pragma unroll
            for (int i = 0; i < 16; ++i) { const float sg = __builtin_amdgcn_rcpf(1.f + __expf(-actb * uf[i])); uf[i] = actraw ? uf[i] : acta * sg + actc; } }
        *(u32x4*)(dst0 + (size_t)m * dpitch) = pack8(uf); *(u32x4*)(dst0 + (size_t)m * dpitch + 8) = pack8(uf + 8);
        if (l >= 16 && l < 32) {
#pragma unroll
            for (int i = 0; i < 16; ++i) kk[i] *= inrm;
            *(u32x4*)(RKK + (size_t)m * RC + (l - 16) * 16) = pack8(kk); *(u32x4*)(RKK + (size_t)m * RC + (l - 16) * 16 + 8) = pack8(kk + 8); }
    }
}

namespace g8 {
struct UpOrder {
    int layer, G, c;
    DI bool next(int i, Unit& u) const {
        const int L = i * G + c; if (L >= 640) return false;
        if (L < 256) { u.e = 1; u.pm = L & 63; u.pn = L >> 6; }
        else if (L < 448) { const int q = L - 256; u.e = 0; u.pm = q & 63; u.pn = q >> 6; }
        else { const int q = L - 448; u.e = 2; u.pm = q & 63; u.pn = q >> 6; }
        u.orow = u.pm * BM; return true;
    }
    DI unsigned arow(const Unit& u, int lr) const {
        const unsigned r = (unsigned)(u.pm * BM + lr);
        return (u.e == 2) ? (unsigned)WS_LIN + r * 512u : (unsigned)WS_U + r * (unsigned)(INCP * 2) + (unsigned)((u.e == 0 ? U_CQ : U_CKV) * 2);
    }
    DI unsigned aoffs(const Unit&) const { return 0u; }
    DI size_t boff(const Unit& u) const {
        return (u.e == 0 ? WS_WUQ + (size_t)layer * 768 * 256 * 2 : u.e == 1 ? WS_WUKV + (size_t)layer * 1024 * 256 * 2 : WS_LORA + (size_t)layer * 768 * 256 * 2) + (size_t)u.pn * BM * 256 * 2;
    }
    const char* ws;
    DI unsigned boffs(const Unit& u) const { return (unsigned)boff(u); }
    DI const char* bmat() const { return ws; }
};
struct EpiStore3 {
    static constexpr bool PERM = true;
    unsigned char* ws;
    DI void operator()(const f32x4 (&acc)[2][2][4][2], const Unit& u, int wr, int wc, int fr, int fq) const {
        const int ldc = (u.e == 1) ? 1024 : 768;
        bf16_t* O = (bf16_t*)(ws + (u.e == 0 ? WS_QRAW : u.e == 1 ? WS_KVRAW : WS_LOUT));
        EpiStore E{O, ldc}; E(acc, u, wr, wc, fr, fq);
    }
};
}
DI void phase_upgemms(Ctx C, int layer) {
    g8::UpOrder S; S.layer = layer; S.G = gridDim.x; S.c = blockIdx.x; S.ws = (const char*)C.ws;
    g8::EpiStore3 E{C.ws};
    g8::gemm_phase<g8::EpiStore3, g8::UpOrder, true>(C.tid, C.lds, (const bf16_t*)C.ws, 0, 256, S, E);
}

DI void phase_prep2(Ctx C, int layer) {
    const bf16_t* U = (const bf16_t*)(C.ws + WS_U); const bf16_t* QR = (const bf16_t*)(C.ws + WS_QRAW); const bf16_t* KVR = (const bf16_t*)(C.ws + WS_KVRAW);
    bf16_t* Q = (bf16_t*)(C.ws + WS_Q); bf16_t* K = (bf16_t*)(C.ws + WS_K); bf16_t* V = (bf16_t*)(C.ws + WS_VT);
    const float* cs = (const float*)(C.ws + WS_COS); const float* sn = (const float*)(C.ws + WS_SIN);
    const float qscale = 0.10206207261596575f * 1.4426950408889634f;
    const int l = C.lane, hd = l >> 3, sub = l & 7;
    float gqn[8], gkn[8], gqr[4], gkr[4];
#pragma unroll
    for (int i = 0; i < 8; ++i) { gqn[i] = INF(I_QKQ)[layer * 96 + sub * 8 + i]; gkn[i] = INF(I_QKK)[layer * 96 + sub * 8 + i]; }
#pragma unroll
    for (int i = 0; i < 4; ++i) { gqr[i] = INF(I_QKQ)[layer * 96 + 64 + sub * 4 + i]; gkr[i] = INF(I_QKK)[layer * 96 + 64 + sub * 4 + i]; }
    const int rpw = (M + C.NGW - 1) / C.NGW, m0 = C.gw * rpw, m1 = (m0 + rpw < M) ? m0 + rpw : M;
    const bool vt_lds = (rpw == 8) && (M % (8 * rpw) == 0);
    LAS bf16_t* vst = (LAS bf16_t*)C.lds;
    u32x4 nqn, nkn, nv; u32x2 nqr, nkr;
#define P2_LOAD(mm) do { nqn = *(const u32x4*)(QR + (size_t)(mm) * 768 + hd * 96 + sub * 8); nqr = *(const u32x2*)(QR + (size_t)(mm) * 768 + hd * 96 + 64 + sub * 4); \
        nkn = *(const u32x4*)(KVR + (size_t)(mm) * 1024 + hd * 128 + sub * 8); nkr = *(const u32x2*)(U + (size_t)(mm) * INCP + U_KR + sub * 4); \
        nv = *(const u32x4*)(KVR + (size_t)(mm) * 1024 + hd * 128 + 64 + sub * 8); } while (0)
    if (m0 < m1) P2_LOAD(m0);
    for (int m = m0; m < m1; ++m) {
        const int b = m / SEQ, t = m % SEQ, bh = b * NH + hd;
        float qn[8], kn[8]; unpack8(nqn, qn); unpack8(nkn, kn);
        float qr[4] = {bflo(nqr.x), bfhi(nqr.x), bflo(nqr.y), bfhi(nqr.y)}, kr[4] = {bflo(nkr.x), bfhi(nkr.x), bflo(nkr.y), bfhi(nkr.y)};
        const u32x4 vraw = nv;
        if (m + 1 < m1) P2_LOAD(m + 1);
        const f32x4 c4 = ld4(cs + m * 16 + (sub & 3) * 4), s4 = ld4(sn + m * 16 + (sub & 3) * 4);
        float sq = 0.f, sk = 0.f;
#pragma unroll
        for (int i = 0; i < 8; ++i) { sq += qn[i] * qn[i]; sk += kn[i] * kn[i]; }
#pragma unroll
        for (int i = 0; i < 4; ++i) { sq += qr[i] * qr[i]; sk += kr[i] * kr[i]; }
#pragma unroll
        for (int o = 1; o < 8; o <<= 1) { sq += shx(sq, o); sk += shx(sk, o); }
        const float rq = rsqrtf(sq * (1.f / 96.f) + 1e-6f), rk = rsqrtf(sk * (1.f / 96.f) + 1e-6f);
#pragma unroll
        for (int i = 0; i < 8; ++i) { qn[i] *= rq * gqn[i] * qscale; kn[i] *= rk * gkn[i]; }
        float qo4[4], ko4[4];
#pragma unroll
        for (int i = 0; i < 4; ++i) { const float qv = qr[i] * rq * gqr[i], kv = kr[i] * rk * gkr[i]; const float qp = shx(qv, 4), kp = shx(kv, 4);
            const float cc = c4[i], ss = s4[i];
            qo4[i] = ((sub < 4) ? (qv * cc - qp * ss) : (qp * ss + qv * cc)) * qscale;
            ko4[i] = (sub < 4) ? (kv * cc - kp * ss) : (kp * ss + kv * cc); }
        bf16_t* qo = Q + ((size_t)bh * SEQ + t) * DQK; bf16_t* ko = K + ((size_t)bh * SEQ + t) * DQK;
        *(u32x4*)(qo + sub * 8) = pack8(qn); *(u32x4*)(ko + sub * 8) = pack8(kn);
        u32x2 w2; w2.x = pk2(qo4[0], qo4[1]); w2.y = pk2(qo4[2], qo4[3]); *(u32x2*)(qo + 64 + sub * 4) = w2;
        w2.x = pk2(ko4[0], ko4[1]); w2.y = pk2(ko4[2], ko4[3]); *(u32x2*)(ko + 64 + sub * 4) = w2;
        if (vt_lds) *(LAS u32x4*)(vst + ((C.wave * 8 + (m - m0)) * 512 + hd * 64 + sub * 8)) = vraw;
        else {
#pragma unroll
            for (int e = 0; e < 8; ++e) V[((size_t)bh * DV + sub * 8 + e) * SEQ + t] = (bf16_t)(((e & 1) ? (vraw[e >> 1] >> 16) : (vraw[e >> 1] & 0xffffu))); }
    }
#undef P2_LOAD
    if (vt_lds) {
        __syncthreads();
        const int hd2 = C.tid >> 6, d2 = C.tid & 63, mb0 = blockIdx.x * 64, b2 = mb0 / SEQ, t0 = mb0 % SEQ;
        unsigned w[32];
#pragma unroll
        for (int i = 0; i < 32; ++i) w[i] = (unsigned)vst[(2 * i) * 512 + hd2 * 64 + d2] | ((unsigned)vst[(2 * i + 1) * 512 + hd2 * 64 + d2] << 16);
        bf16_t* dst = V + ((size_t)(b2 * NH + hd2) * DV + d2) * SEQ + t0;
#pragma unroll
        for (int i = 0; i < 8; ++i) *(u32x4*)(dst + 8 * i) = (u32x4){w[4 * i], w[4 * i + 1], w[4 * i + 2], w[4 * i + 3]};
        __syncthreads();
    }
}

DI void phase_attn2(Ctx C, unsigned* qhead, int layer) {
    constexpr int KP = 104, VP = 68, KBYTES = 64 * KP * 2, SLOT = KBYTES + 64 * VP * 2 + 64;
    LAS unsigned char* lds = C.lds;
    const bf16_t* Q = (const bf16_t*)(C.ws + WS_Q); const bf16_t* K = (const bf16_t*)(C.ws + WS_K); const bf16_t* V = (const bf16_t*)(C.ws + WS_VT); bf16_t* MX = (bf16_t*)(C.ws + WS_MIXED);
    const int tid = C.tid, lane = C.lane, wid = C.wave, r = lane & 31, h = lane >> 5;
    const int kp0 = tid, kp1 = tid + 512;
    const int kr0 = kp0 / 12, kc0 = (kp0 % 12) * 8, kr1 = kp1 / 12, kc1 = (kp1 % 12) * 8;
    const int vr = tid >> 3, vc = (tid & 7) * 8;
    volatile LAS int* qslot = (volatile LAS int*)(lds + 131072 + 2048);
    float gqm = 0.f, gkm = 0.f;
    for (int i = lane; i < 96; i += 64) { gqm = fmaxf(gqm, fabsf(INF(I_QKQ)[layer * 96 + i])); gkm = fmaxf(gkm, fabsf(INF(I_QKK)[layer * 96 + i])); }
    gqm = wave_max(gqm); gkm = wave_max(gkm);
    const float shift = 9.797958971132712f * 1.4426950408889634f * gqm * gkm * 1.02f + 0.5f;
    f32x16 negc;
#pragma unroll
    for (int q = 0; q < 16; ++q) negc[q] = -shift;
    for (;;) {
        __syncthreads();
        if (tid == 0) qslot[0] = (int)__hip_atomic_fetch_add(qhead, 1u, __ATOMIC_RELAXED, __HIP_MEMORY_SCOPE_AGENT);
        __syncthreads();
        const int item = __builtin_amdgcn_readfirstlane(qslot[0]);
        if (item >= 512) break;
        {
        const int bh = item & 31, b = bh >> 3, hh = bh & 7;
        const bf16_t* Kg = K + (size_t)bh * SEQ * DQK; const bf16_t* Vg = V + (size_t)bh * DV * SEQ;
        {
            const int qb = 15 - (item >> 5), NT = 4 * qb + 4, qmin = 256 * qb + 32 * wid;
            bf16x8 qf[6];
            { const bf16_t* qp = Q + ((size_t)bh * SEQ + qmin + r) * DQK + 8 * h;
#pragma unroll
              for (int sx = 0; sx < 6; ++sx) qf[sx] = *(const bf16x8*)(qp + 16 * sx); }
            u32x4 kg0, kg1, vg;
            kg0 = *(const u32x4*)(Kg + (size_t)kr0 * DQK + kc0); if (tid < 256) kg1 = *(const u32x4*)(Kg + (size_t)kr1 * DQK + kc1); vg = *(const u32x4*)(Vg + (size_t)vr * SEQ + vc);
#define ATT_WRITE(slot) do { LAS unsigned char* sb_ = lds + (slot) * SLOT; *(LAS u32x4*)(sb_ + (kr0 * KP + kc0) * 2) = kg0; if (tid < 256) *(LAS u32x4*)(sb_ + (kr1 * KP + kc1) * 2) = kg1; \
                LAS bf16_t* vt_ = (LAS bf16_t*)(sb_ + KBYTES); *(LAS u32x2*)(vt_ + vr * VP + vc) = (u32x2){vg.x, vg.y}; *(LAS u32x2*)(vt_ + vr * VP + vc + 4) = (u32x2){vg.z, vg.w}; } while (0)
            { u32x4 kh0, kh1 = kg0, vh;
              { const size_t ko = 64; kh0 = *(const u32x4*)(Kg + (ko + kr0) * DQK + kc0); if (tid < 256) kh1 = *(const u32x4*)(Kg + (ko + kr1) * DQK + kc1); vh = *(const u32x4*)(Vg + (size_t)vr * SEQ + ko + vc); }
              ATT_WRITE(0);
              kg0 = kh0; kg1 = kh1; vg = vh; }
            ATT_WRITE(1);
            { const size_t ko = 128; kg0 = *(const u32x4*)(Kg + (ko + kr0) * DQK + kc0); if (tid < 256) kg1 = *(const u32x4*)(Kg + (ko + kr1) * DQK + kc1); vg = *(const u32x4*)(Vg + (size_t)vr * SEQ + ko + vc); }
            __syncthreads();
            f32x16 o[2]; float lrun = 0.f;
            { const float z0 = ozero();
#pragma unroll
            for (int q = 0; q < 16; ++q) { o[0][q] = z0; o[1][q] = z0; } }
#pragma unroll 2
            for (int t = 0; t < NT; ++t) {
                u32x4 ng0 = kg0, ng1 = kg0, nvg = kg0;
                if (t + 3 < NT) { const size_t ko = (size_t)(t + 3) * 64;
                    ng0 = *(const u32x4*)(Kg + (ko + kr0) * DQK + kc0); if (tid < 256) ng1 = *(const u32x4*)(Kg + (ko + kr1) * DQK + kc1); nvg = *(const u32x4*)(Vg + (size_t)vr * SEQ + ko + vc); }
                const int key0 = 64 * t;
                if (key0 <= qmin + 31) {
                    const LAS unsigned char* sb = lds + (t & 3) * SLOT;
                    const LAS bf16_t* kl = (const LAS bf16_t*)sb + r * KP + 8 * h; const LAS bf16_t* vl = (const LAS bf16_t*)(sb + KBYTES) + r * VP + 4 * h;
                    f32x16 p0 = negc, p1 = negc;
                    bf16x8 ka[6], kb[6];
#pragma unroll
                    for (int sx = 0; sx < 6; ++sx) { ka[sx] = *(const LAS bf16x8*)(kl + 16 * sx); kb[sx] = *(const LAS bf16x8*)(kl + 32 * KP + 16 * sx); }
                    __builtin_amdgcn_sched_barrier(0);
#pragma unroll
                    for (int sx = 0; sx < 6; ++sx) { p0 = __builtin_amdgcn_mfma_f32_32x32x16_bf16(ka[sx], qf[sx], p0, 0, 0, 0); p1 = __builtin_amdgcn_mfma_f32_32x32x16_bf16(kb[sx], qf[sx], p1, 0, 0, 0); }
                    u32x2 vlo[2][4], vhi[2][4];
#pragma unroll
                    for (int sx = 0; sx < 4; ++sx)
#pragma unroll
                        for (int db = 0; db < 2; ++db) { vlo[db][sx] = *(const LAS u32x2*)(vl + db * 32 * VP + 16 * sx); vhi[db][sx] = *(const LAS u32x2*)(vl + db * 32 * VP + 16 * sx + 8); }
                    __builtin_amdgcn_sched_barrier(0);
                    if (key0 + 63 > qmin) { const int qa = qmin + r;
#pragma unroll
                        for (int q = 0; q < 16; ++q) { const int ky = key0 + crow(q, h); if (ky > qa) p0[q] = -INFINITY; if (ky + 32 > qa) p1[q] = -INFINITY; } }
                    float ps = 0.f;
#pragma unroll
                    for (int q = 0; q < 16; ++q) { p0[q] = __builtin_amdgcn_exp2f(p0[q]); p1[q] = __builtin_amdgcn_exp2f(p1[q]); ps += p0[q] + p1[q]; }
                    lrun += ps;
#pragma unroll
                    for (int sx = 0; sx < 4; ++sx) {
                        u32x4 pw;
                        if (sx < 2) { pw.x = pk2(p0[8 * sx + 0], p0[8 * sx + 1]); pw.y = pk2(p0[8 * sx + 2], p0[8 * sx + 3]); pw.z = pk2(p0[8 * sx + 4], p0[8 * sx + 5]); pw.w = pk2(p0[8 * sx + 6], p0[8 * sx + 7]); }
                        else { const int s2 = sx - 2; pw.x = pk2(p1[8 * s2 + 0], p1[8 * s2 + 1]); pw.y = pk2(p1[8 * s2 + 2], p1[8 * s2 + 3]); pw.z = pk2(p1[8 * s2 + 4], p1[8 * s2 + 5]); pw.w = pk2(p1[8 * s2 + 6], p1[8 * s2 + 7]); }
                        const bf16x8 pf = __builtin_bit_cast(bf16x8, pw);
#pragma unroll
                        for (int db = 0; db < 2; ++db) { u32x4 vw4; vw4.x = vlo[db][sx].x; vw4.y = vlo[db][sx].y; vw4.z = vhi[db][sx].x; vw4.w = vhi[db][sx].y;
                            o[db] = __builtin_amdgcn_mfma_f32_32x32x16_bf16(__builtin_bit_cast(bf16x8, vw4), pf, o[db], 0, 0, 0); }
                    }
                }
                if (t + 2 < NT) ATT_WRITE((t + 2) & 3);
                kg0 = ng0; kg1 = ng1; vg = nvg;
                if ((t & 1) == 0) { asm volatile("s_waitcnt lgkmcnt(0)" ::: "memory"); __builtin_amdgcn_s_barrier(); asm volatile("" ::: "memory"); }
            }
#undef ATT_WRITE
            lrun = shx32_sum(lrun);
            const float il = 1.f / lrun;
            bf16_t* orow = MX + ((size_t)b * SEQ + qmin + r) * DM + 256 + hh * 64;
#pragma unroll
            for (int db = 0; db < 2; ++db)
#pragma unroll
                for (int g = 0; g < 4; ++g) { u32x2 w2; w2.x = pk2(o[db][4 * g] * il, o[db][4 * g + 1] * il); w2.y = pk2(o[db][4 * g + 2] * il, o[db][4 * g + 3] * il); *(u32x2*)(orow + db * 32 + 8 * g + 4 * h) = w2; }
        }
        }
    }
}

namespace rk {
constexpr int PITCH = 72, BUFB = 64 * PITCH * 2;
enum { B_RT = 0, B_ATT, B_BHT, B_KHT, B_VT, B_NBRT, B_MAK, B_PA, B_PB, B_PC, B_PD, B_PE, NBUF };
constexpr int OFF_MFD = NBUF * BUFB, OFF_TOT = OFF_MFD + 4096, OFF_ECUM = OFF_TOT + 2048;
static_assert(OFF_ECUM + 256 <= 131072, "rk lds");
constexpr int REC = 32768;
#define RKBUF(id) ((LAS bf16_t*)(lds + (id) * BUFB))
DI f32x16 mm_block(const LAS bf16_t* A, int mb, const LAS bf16_t* Bt, int nb, f32x16 acc, int lane) {
    const int r = lane & 31, h = lane >> 5;
    const LAS bf16_t* ap = A + (mb * 32 + r) * PITCH + 8 * h; const LAS bf16_t* bp = Bt + (nb * 32 + r) * PITCH + 8 * h;
#pragma unroll
    for (int ks = 0; ks < 4; ++ks) acc = __builtin_amdgcn_mfma_f32_32x32x16_bf16(*(const LAS bf16x8*)(ap + 16 * ks), *(const LAS bf16x8*)(bp + 16 * ks), acc, 0, 0, 0);
    return acc;
}
DI void store_T(LAS bf16_t* dst, int mb, int nb, const f32x16& acc, int lane) {
    const int r = lane & 31, h = lane >> 5;
#pragma unroll
    for (int g = 0; g < 4; ++g) { u32x2 w; w.x = pk2(acc[4 * g], acc[4 * g + 1]); w.y = pk2(acc[4 * g + 2], acc[4 * g + 3]); *(LAS u32x2*)(dst + (nb * 32 + r) * PITCH + mb * 32 + 8 * g + 4 * h) = w; }
}
DI void store_N(LAS bf16_t* dst, int mb, int nb, const f32x16& acc, int lane) {
    const int r = lane & 31, h = lane >> 5;
#pragma unroll
    for (int q = 0; q < 16; ++q) dst[(mb * 32 + crow(q, h)) * PITCH + nb * 32 + r] = f2bf(acc[q]);
}
DI f32x16 zero16() { const float z0 = ozero(); f32x16 z;
#pragma unroll
    for (int q = 0; q < 16; ++q) z[q] = z0;
    return z; }
}

DI void phase_rwkv_chunk(Ctx C, int layer) {
    using namespace rk;
    LAS unsigned char* lds = C.lds;
    const bf16_t* RR = (const bf16_t*)(C.ws + WS_RR); const bf16_t* RK = (const bf16_t*)(C.ws + WS_RK); const bf16_t* RV = (const bf16_t*)(C.ws + WS_RV);
    const bf16_t* RKK = (const bf16_t*)(C.ws + WS_RKK); const bf16_t* LO = (const bf16_t*)(C.ws + WS_LOUT);
    const int lane = C.lane, w = C.wave, r = lane & 31, h = lane >> 5;
    LAS float* tot = (LAS float*)(lds + OFF_TOT); LAS float* ecum = (LAS float*)(lds + OFF_ECUM); LAS float* mfd = (LAS float*)(lds + OFF_MFD);
    for (int job = blockIdx.x; job < NB * RH * (SEQ / 64); job += gridDim.x) {
        const int bh = job >> 6, c = job & 63, b = bh >> 2, hh = bh & 3;
        unsigned char* rec = C.ws + WS_CHK + (size_t)job * REC;
        {
            const int g = w, ch = lane; const size_t base = ((size_t)b * SEQ + c * 64 + g * 8) * RC + hh * 64 + ch;
            float lw[8], cum[8];
            float rv[8], kv[8], vv[8], kkv[8], bv[8];
            { const float w0 = INF(I_RW0)[layer * RC + hh * 64 + ch], a0 = INF(I_RA0)[layer * RC + hh * 64 + ch], ka = INF(I_RKA)[layer * RC + hh * 64 + ch];
              const size_t lbase = ((size_t)b * SEQ + c * 64 + g * 8) * 768 + hh * 64 + ch;
#pragma unroll
              for (int i = 0; i < 8; ++i) { const size_t o = base + (size_t)i * RC; rv[i] = bf2f(RR[o]); vv[i] = bf2f(RV[o]); kkv[i] = bf2f(RKK[o]);
                  const float kraw = bf2f(RK[o]), lin = bf2f(LO[lbase + (size_t)i * 768]), la = bf2f(LO[lbase + (size_t)i * 768 + 256]);
                  const float zz = -(w0 + lin); const float sp = fmaxf(zz, 0.f) + __logf(1.f + __expf(-fabsf(zz))); lw[i] = -__expf(-sp - 0.5f);
                  const float asig = fsigmoid(a0 + la); kv[i] = kraw * (1.f + (asig - 1.f) * ka); bv[i] = kkv[i] * asig; } }
            cum[0] = lw[0];
#pragma unroll
            for (int i = 1; i < 8; ++i) cum[i] = cum[i - 1] + lw[i];
            tot[g * 64 + ch] = cum[7];
            __syncthreads();
            float prefix = 0.f, total = 0.f;
#pragma unroll
            for (int q = 0; q < 8; ++q) { const float tq = tot[q * 64 + ch]; total += tq; prefix += (q < g) ? tq : 0.f; }
            if (g == 0) ecum[ch] = __expf(total);
            unsigned att[4], bht[4], kht[4], vt[4];
#pragma unroll
            for (int i = 0; i < 8; i += 2) {
                float o[2][8];
#pragma unroll
                for (int e = 0; e < 2; ++e) { const int ii = i + e; const float ci = cum[ii] + prefix, cx = ci - lw[ii];
                    const float ein = __expf(ci), eex = __expf(cx), eneg = __expf(-ci), eend = __expf(total - ci);
                    o[e][0] = -kkv[ii] * eex; o[e][1] = rv[ii] * ein; o[e][2] = bv[ii] * eneg; o[e][3] = kv[ii] * eneg; o[e][4] = bv[ii] * eend; o[e][5] = kv[ii] * eend; o[e][6] = vv[ii];
                    const int tok = g * 8 + ii;
                    RKBUF(B_PA)[tok * PITCH + ch] = f2bf(o[e][0]); RKBUF(B_RT)[tok * PITCH + ch] = f2bf(o[e][1]); RKBUF(B_PB)[tok * PITCH + ch] = f2bf(o[e][2]); RKBUF(B_PC)[tok * PITCH + ch] = f2bf(o[e][3]); }
                att[i >> 1] = pk2(o[0][0], o[1][0]); bht[i >> 1] = pk2(o[0][4], o[1][4]); kht[i >> 1] = pk2(o[0][5], o[1][5]); vt[i >> 1] = pk2(o[0][6], o[1][6]);
            }
            *(LAS u32x4*)(RKBUF(B_ATT) + ch * PITCH + g * 8) = (u32x4){att[0], att[1], att[2], att[3]};
            *(LAS u32x4*)(RKBUF(B_BHT) + ch * PITCH + g * 8) = (u32x4){bht[0], bht[1], bht[2], bht[3]};
            *(LAS u32x4*)(RKBUF(B_KHT) + ch * PITCH + g * 8) = (u32x4){kht[0], kht[1], kht[2], kht[3]};
            *(LAS u32x4*)(RKBUF(B_VT) + ch * PITCH + g * 8) = (u32x4){vt[0], vt[1], vt[2], vt[3]};
        }
        __syncthreads();
        const int blk = w & 3, mb = blk >> 1, nb = blk & 1;
        f32x16 nkr = zero16();
        {
            const LAS bf16_t* Aop = (w < 4) ? RKBUF(B_PB) : RKBUF(B_PC);
            f32x16 m1 = mm_block(Aop, mb, RKBUF(B_PA), nb, zero16(), lane);
            f32x16 m2 = mm_block(Aop, mb, RKBUF(B_RT), nb, zero16(), lane);
#pragma unroll
            for (int q = 0; q < 16; ++q) { const int sI = mb * 32 + crow(q, h), tI = nb * 32 + r; if (!(sI < tI)) m1[q] = 0.f; if (!(sI <= tI)) m2[q] = 0.f; }
            if (w < 4) {
                f32x16 moff = m1;
#pragma unroll
                for (int q = 0; q < 16; ++q) { const int sI = mb * 32 + crow(q, h), tI = nb * 32 + r; if ((sI >> 4) == (tI >> 4)) { mfd[(tI >> 4) * 256 + (tI & 15) * 16 + (sI & 15)] = m1[q]; moff[q] = 0.f; } }
                store_T(RKBUF(B_PD), mb, nb, moff, lane);
                store_T(RKBUF(B_NBRT), mb, nb, m2, lane);
            } else { store_N(RKBUF(B_MAK), mb, nb, m1, lane); nkr = m2; }
        }
        __syncthreads();
        if (w == 0) {
            const int d = lane >> 4, rr = lane & 15; float x[16];
#pragma unroll
            for (int t = 0; t < 16; ++t) { float acc = (t == rr) ? 1.f : 0.f;
#pragma unroll
                for (int sI = 0; sI < t; ++sI) acc += x[sI] * mfd[d * 256 + t * 16 + sI];
                x[t] = acc; }
            LAS bf16_t* Dn = RKBUF(B_PA); LAS bf16_t* Dt = RKBUF(B_PB); const int row = 16 * d + rr;
#pragma unroll
            for (int q = 0; q < 8; ++q) { *(LAS u32x4*)(Dn + row * PITCH + 8 * q) = (u32x4){0u, 0u, 0u, 0u}; *(LAS u32x4*)(Dt + row * PITCH + 8 * q) = (u32x4){0u, 0u, 0u, 0u}; }
            asm volatile("s_waitcnt lgkmcnt(0)" ::: "memory");
#pragma unroll
            for (int t = 0; t < 16; t += 2) *(LAS unsigned*)(Dn + row * PITCH + 16 * d + t) = pk2(x[t], x[t + 1]);
#pragma unroll
            for (int t = 0; t < 16; ++t) Dt[(16 * d + t) * PITCH + row] = f2bf(x[t]);
        }
        __syncthreads();
        f32x16 sig = zero16();
        if (w < 4) { sig = mm_block(RKBUF(B_PA), mb, RKBUF(B_PD), nb, zero16(), lane); store_N(RKBUF(B_PC), mb, nb, sig, lane); store_T(RKBUF(B_PE), mb, nb, sig, lane); }
        __syncthreads();
        if (w < 4) { const f32x16 w2 = mm_block(RKBUF(B_PC), mb, RKBUF(B_PE), nb, zero16(), lane); store_T(RKBUF(B_PD), mb, nb, w2, lane);
#pragma unroll
            for (int q = 0; q < 16; ++q) sig[q] += w2[q]; }
        __syncthreads();
        if (w < 4) { sig = mm_block(RKBUF(B_PC), mb, RKBUF(B_PD), nb, sig, lane);
#pragma unroll
            for (int q = 0; q < 16; ++q) if (mb * 32 + crow(q, h) == nb * 32 + r) sig[q] += 1.f;
            store_N(RKBUF(B_PA), mb, nb, sig, lane); }
        __syncthreads();
        if (w < 4) { const f32x16 tt = mm_block(RKBUF(B_PA), mb, RKBUF(B_PB), nb, zero16(), lane); store_T(RKBUF(B_PC), mb, nb, tt, lane); }
        __syncthreads();
        { const f32x16 x = mm_block((w < 4) ? RKBUF(B_ATT) : RKBUF(B_MAK), mb, RKBUF(B_PC), nb, zero16(), lane); store_N((w < 4) ? RKBUF(B_PA) : RKBUF(B_PB), mb, nb, x, lane); }
        __syncthreads();
        if (w < 4) {
            f32x16 qh = mm_block(RKBUF(B_PA), mb, RKBUF(B_NBRT), nb, zero16(), lane);
#pragma unroll
            for (int g = 0; g < 4; ++g) { const u32x2 rw = *(const LAS u32x2*)(RKBUF(B_RT) + (nb * 32 + r) * PITCH + mb * 32 + 8 * g + 4 * h);
                qh[4 * g] += __uint_as_float(rw.x << 16); qh[4 * g + 1] += __uint_as_float(rw.x & 0xffff0000u); qh[4 * g + 2] += __uint_as_float(rw.y << 16); qh[4 * g + 3] += __uint_as_float(rw.y & 0xffff0000u); }
            f32x16 ph = mm_block(RKBUF(B_PA), mb, RKBUF(B_BHT), nb, zero16(), lane);
#pragma unroll
            for (int q = 0; q < 16; ++q) if (mb * 32 + crow(q, h) == nb * 32 + r) ph[q] += ecum[nb * 32 + r];
#pragma unroll
            for (int sx = 0; sx < 2; ++sx) {
                u32x4 o; o.x = pk2(ph[8 * sx], ph[8 * sx + 1]); o.y = pk2(ph[8 * sx + 2], ph[8 * sx + 3]); o.z = pk2(ph[8 * sx + 4], ph[8 * sx + 5]); o.w = pk2(ph[8 * sx + 6], ph[8 * sx + 7]);
                *(u32x4*)(rec + (((nb * 2 + mb) * 2 + sx) * 64 + lane) * 16) = o;
                u32x4 p; p.x = pk2(qh[8 * sx], qh[8 * sx + 1]); p.y = pk2(qh[8 * sx + 2], qh[8 * sx + 3]); p.z = pk2(qh[8 * sx + 4], qh[8 * sx + 5]); p.w = pk2(qh[8 * sx + 6], qh[8 * sx + 7]);
                *(u32x4*)(rec + 8192 + (((nb * 2 + mb) * 2 + sx) * 64 + lane) * 16) = p; }
        } else {
            const f32x16 gg = mm_block(RKBUF(B_PB), mb, RKBUF(B_NBRT), nb, nkr, lane);
            f32x16 hm = mm_block(RKBUF(B_PB), mb, RKBUF(B_BHT), nb, zero16(), lane);
#pragma unroll
            for (int g = 0; g < 4; ++g) { const u32x2 kw = *(const LAS u32x2*)(RKBUF(B_KHT) + (nb * 32 + r) * PITCH + mb * 32 + 8 * g + 4 * h);
                hm[4 * g] += __uint_as_float(kw.x << 16); hm[4 * g + 1] += __uint_as_float(kw.x & 0xffff0000u); hm[4 * g + 2] += __uint_as_float(kw.y << 16); hm[4 * g + 3] += __uint_as_float(kw.y & 0xffff0000u); }
            store_T(RKBUF(B_PC), mb, nb, gg, lane); store_T(RKBUF(B_PD), mb, nb, hm, lane);
        }
        __syncthreads();
        { const f32x16 o = mm_block((w < 4) ? RKBUF(B_PD) : RKBUF(B_PC), mb, RKBUF(B_VT), nb, zero16(), lane);
          unsigned char* dst = rec + ((w < 4) ? 16384 : 24576) + ((nb * 2 + mb) * 64 + lane) * 32;
          u32x4 o0, o1; o0.x = pk2(o[0], o[1]); o0.y = pk2(o[2], o[3]); o0.z = pk2(o[4], o[5]); o0.w = pk2(o[6], o[7]); o1.x = pk2(o[8], o[9]); o1.y = pk2(o[10], o[11]); o1.z = pk2(o[12], o[13]); o1.w = pk2(o[14], o[15]);
          *(u32x4*)dst = o0; *(u32x4*)(dst + 16) = o1; }
        __syncthreads();
    }
}

DI void phase_rwkv_scan(Ctx C) {
    using namespace rk;
    LAS unsigned char* lds = C.lds;
    const int bh = blockIdx.x, b = bh >> 2, hh = bh & 3, w = C.wave, lane = C.lane, r = lane & 31, h = lane >> 5;
    const unsigned char* rec0 = C.ws + WS_CHK + (size_t)bh * 64 * REC;
    float* RY = (float*)(C.ws + WS_RY);
    constexpr int NCH = SEQ / 64;
#define RK_DMA(cc) do { if (w >= 4) { _Pragma("unroll") for (int p_ = 0; p_ < 8; ++p_) { const int pc_ = (w - 4) * 8 + p_; \
        __builtin_amdgcn_global_load_lds((const unsigned*)(rec0 + (size_t)(cc) * REC + pc_ * 1024 + lane * 16), (LAS unsigned*)(lds + ((cc) & 3) * REC + pc_ * 1024), 16, 0, 0); } } } while (0)
    RK_DMA(0); RK_DMA(1); RK_DMA(2);
    f32x16 st[2]; st[0] = zero16(); st[1] = zero16();
    for (int c = 0; c < NCH; ++c) {
        if (w >= 4) { if (c + 2 < NCH) asm volatile("s_waitcnt vmcnt(16)" ::: "memory"); else if (c + 1 < NCH) asm volatile("s_waitcnt vmcnt(8)" ::: "memory"); else asm volatile("s_waitcnt vmcnt(0)" ::: "memory"); }
        asm volatile("s_waitcnt lgkmcnt(0)" ::: "memory");
        __builtin_amdgcn_s_barrier();
        asm volatile("" ::: "memory");
        if (c + 3 < NCH) RK_DMA(c + 3);
        if (w < 2) {
            const LAS unsigned char* sb = lds + (c & 3) * REC; const int ib = w;
            bf16x8 bfr[2][2];
#pragma unroll
            for (int jb = 0; jb < 2; ++jb)
#pragma unroll
                for (int sx = 0; sx < 2; ++sx) { u32x4 p; p.x = pk2(st[jb][8 * sx], st[jb][8 * sx + 1]); p.y = pk2(st[jb][8 * sx + 2], st[jb][8 * sx + 3]); p.z = pk2(st[jb][8 * sx + 4], st[jb][8 * sx + 5]); p.w = pk2(st[jb][8 * sx + 6], st[jb][8 * sx + 7]); bfr[jb][sx] = __builtin_bit_cast(bf16x8, p); }
            f32x16 y[2], sn[2];
#pragma unroll
            for (int ob = 0; ob < 2; ++ob) {
                const u32x4 y0 = *(const LAS u32x4*)(sb + 24576 + ((ib * 2 + ob) * 64 + lane) * 32), y1 = *(const LAS u32x4*)(sb + 24576 + ((ib * 2 + ob) * 64 + lane) * 32 + 16);
                const u32x4 p0 = *(const LAS u32x4*)(sb + 16384 + ((ib * 2 + ob) * 64 + lane) * 32), p1 = *(const LAS u32x4*)(sb + 16384 + ((ib * 2 + ob) * 64 + lane) * 32 + 16);
#pragma unroll
                for (int q = 0; q < 4; ++q) { y[ob][2 * q] = __uint_as_float(y0[q] << 16); y[ob][2 * q + 1] = __uint_as_float(y0[q] & 0xffff0000u); y[ob][8 + 2 * q] = __uint_as_float(y1[q] << 16); y[ob][8 + 2 * q + 1] = __uint_as_float(y1[q] & 0xffff0000u);
                    sn[ob][2 * q] = __uint_as_float(p0[q] << 16); sn[ob][2 * q + 1] = __uint_as_float(p0[q] & 0xffff0000u); sn[ob][8 + 2 * q] = __uint_as_float(p1[q] << 16); sn[ob][8 + 2 * q + 1] = __uint_as_float(p1[q] & 0xffff0000u); }
#pragma unroll
                for (int jb = 0; jb < 2; ++jb)
#pragma unroll
                    for (int sx = 0; sx < 2; ++sx) {
                        const bf16x8 qa = *(const LAS bf16x8*)(sb + 8192 + (((ob * 2 + jb) * 2 + sx) * 64 + lane) * 16);
                        const bf16x8 pa = *(const LAS bf16x8*)(sb + (((ob * 2 + jb) * 2 + sx) * 64 + lane) * 16);
                        y[ob] = __builtin_amdgcn_mfma_f32_32x32x16_bf16(qa, bfr[jb][sx], y[ob], 0, 0, 0);
                        sn[ob] = __builtin_amdgcn_mfma_f32_32x32x16_bf16(pa, bfr[jb][sx], sn[ob], 0, 0, 0);
                    }
            }
#pragma unroll
            for (int ob = 0; ob < 2; ++ob)
#pragma unroll
                for (int q = 0; q < 16; ++q) RY[((size_t)b * SEQ + c * 64 + ob * 32 + crow(q, h)) * RC + hh * 64 + ib * 32 + r] = y[ob][q];
            st[0] = sn[0]; st[1] = sn[1];
        }
    }
#undef RK_DMA
    asm volatile("s_waitcnt vmcnt(0) lgkmcnt(0)" ::: "memory");
    __builtin_amdgcn_s_barrier();
}

DI void phase_rwkv_out(Ctx C, int layer) {
    const bf16_t* RR = (const bf16_t*)(C.ws + WS_RR); const bf16_t* RK = (const bf16_t*)(C.ws + WS_RK); const bf16_t* RV = (const bf16_t*)(C.ws + WS_RV); const bf16_t* LO = (const bf16_t*)(C.ws + WS_LOUT);
    const float* RY = (const float*)(C.ws + WS_RY); bf16_t* MX = (bf16_t*)(C.ws + WS_MIXED);
    const int l = C.lane;
    const f32x4 lg = ld4(INF(I_RLNG) + layer * RC + l * 4), lb = ld4(INF(I_RLNB) + layer * RC + l * 4), rk = ld4(INF(I_RRK) + layer * RC + l * 4);
    const f32x4 a0 = ld4(INF(I_RA0) + layer * RC + l * 4), ka = ld4(INF(I_RKA) + layer * RC + l * 4);
    const int rpw = (M + C.NGW - 1) / C.NGW, m0 = C.gw * rpw, m1 = (m0 + rpw < M) ? m0 + rpw : M;
    f32x4 ny; u32x2 nwr, nwk, nwv, nwg, nwa;
#define RO_LOAD(mm) do { const size_t o_ = (size_t)(mm) * RC + l * 4; ny = ld4(RY + o_); nwr = *(const u32x2*)(RR + o_); nwk = *(const u32x2*)(RK + o_); nwv = *(const u32x2*)(RV + o_); \
        nwg = *(const u32x2*)(LO + (size_t)(mm) * 768 + 512 + l * 4); nwa = *(const u32x2*)(LO + (size_t)(mm) * 768 + 256 + l * 4); } while (0)
    if (m0 < m1) RO_LOAD(m0);
    for (int m = m0; m < m1; ++m) {
        const f32x4 y = ny; const u32x2 wr = nwr, wk = nwk, wv = nwv, wg = nwg, wa = nwa;
        if (m + 1 < m1) RO_LOAD(m + 1);
        const f32x4 r = {bflo(wr.x), bfhi(wr.x), bflo(wr.y), bfhi(wr.y)}, kraw = {bflo(wk.x), bfhi(wk.x), bflo(wk.y), bfhi(wk.y)}, v = {bflo(wv.x), bfhi(wv.x), bflo(wv.y), bfhi(wv.y)}, g = {bflo(wg.x), bfhi(wg.x), bflo(wg.y), bfhi(wg.y)};
        const f32x4 la = {bflo(wa.x), bfhi(wa.x), bflo(wa.y), bfhi(wa.y)};
        f32x4 k;
#pragma unroll
        for (int i = 0; i < 4; ++i) { const float asig = sigmoidf_(a0[i] + la[i]); k[i] = kraw[i] * (1.f + (asig - 1.f) * ka[i]); }
        float sm = y.x + y.y + y.z + y.w; const f32x4 rkk = r * k * rk; float bn = rkk.x + rkk.y + rkk.z + rkk.w;
#pragma unroll
        for (int o = 1; o < 16; o <<= 1) { sm += shx(sm, o); bn += shx(bn, o); }
        const float mean = sm * (1.f / 64.f); const f32x4 d = y - mean; float vr = d.x * d.x + d.y * d.y + d.z * d.z + d.w * d.w;
#pragma unroll
        for (int o = 1; o < 16; o <<= 1) vr += shx(vr, o);
        const f32x4 yn = d * rsqrtf(vr * (1.f / 64.f) + 64e-5f) * lg + lb;
        const f32x4 res = (yn + bn * v) * g;
        u32x2 o2; o2.x = pk2(res.x, res.y); o2.y = pk2(res.z, res.w); *(u32x2*)(MX + (size_t)m * DM + 768 + l * 4) = o2;
    }
}

constexpr int LDS_BYTES = 163840;
constexpr int MISC_OFF = 131072 + 320;
constexpr int PH_PER_LAYER = 11, N_PHASES = 1 + NL * PH_PER_LAYER + 1;

__global__ void __launch_bounds__(NTHREADS, 2) __attribute__((amdgpu_waves_per_eu(2, 2))) mega(Args args) {
    extern __shared__ __attribute__((aligned(16))) unsigned char lds[];
    Ctx C; C.ka = (const CAS char*)__builtin_amdgcn_kernarg_segment_ptr(); C.ws = args.ws; C.lds = (LAS unsigned char*)lds;
    C.tid = threadIdx.x; C.lane = C.tid & 63; C.wave = __builtin_amdgcn_readfirstlane(C.tid >> 6);
    C.gw = blockIdx.x * NWAVES + C.wave; C.NGW = gridDim.x * NWAVES; C.gtid = blockIdx.x * NTHREADS + C.tid; C.NT = gridDim.x * NTHREADS;
    volatile LAS unsigned* MISC = (volatile LAS unsigned*)((LAS unsigned char*)lds + MISC_OFF);
    if (C.tid < 32) MISC[C.tid] = 0u;
    __syncthreads();
    unsigned* ctl = (unsigned*)(args.ws + WS_CTL);
    XcdBarrier bar; bar.bar = ctl + CW_BAR; bar.x = 0; bar.st = nullptr;
    const int lo = args.ph_lo, hi = args.ph_hi;
    if (hi - lo > 1) bar = xcd_barrier_post(ctl + CW_BAR, MISC + 8);
    int pid = 0;
#ifndef PHMASK
#define PHMASK 0xFFFF
#endif
#define PH_ON(k) ((PHMASK >> (k)) & 1)
#define PH_BEGIN if (pid >= lo && pid < hi) { Ctx P; P.ka = C.ka; P.lds = C.lds; P.NGW = C.NGW; P.NT = C.NT; P.wave = C.wave; unsigned mk_ = ~0u; asm volatile("" : "+s"(P.wave), "+s"(P.ka), "+s"(mk_)); \
        P.lane = (int)__builtin_amdgcn_mbcnt_hi(mk_, __builtin_amdgcn_mbcnt_lo(mk_, 0u)); P.tid = P.wave * 64 + P.lane; P.gw = blockIdx.x * NWAVES + P.wave; P.gtid = blockIdx.x * NTHREADS + P.tid; P.ws = KARG(P, 312, unsigned char*);
#define PH_END } if (pid + 1 < hi) xcd_barrier(bar, P.tid); } ++pid;

    PH_BEGIN if (PH_ON(0)) { phase_prologue(P); PH_END
    for (int layer = 0; layer < NL; ++layer) {
        const bool moe = layer & 1; const int fi = layer >> 1;
        PH_BEGIN if (PH_ON(1)) { phase_norm(P, layer, 0, layer > 0 && ((layer - 1) & 1), false); PH_END
        PH_BEGIN if (PH_ON(2)) { const bf16_t* A = (const bf16_t*)(P.ws + WS_H); g8::DenseOrder S; S.init(A, DM, (const bf16_t*)(P.ws + WS_WIN) + (size_t)layer * INCP * DM, DM, M, INCP, gridDim.x, blockIdx.x);
            g8::EpiStore E{(bf16_t*)(P.ws + WS_U), INCP}; g8::gemm_phase<g8::EpiStore, g8::DenseOrder, false>(P.tid, P.lds, A, DM, DM, S, E); PH_END
        PH_BEGIN if (PH_ON(3)) { phase_conv(P, layer); phase_prep1(P, layer); PH_END
        PH_BEGIN if (PH_ON(4)) { phase_upgemms(P, layer); PH_END
        PH_BEGIN if (PH_ON(5)) { phase_prep2(P, layer); phase_rwkv_chunk(P, layer); PH_END
        PH_BEGIN if (PH_ON(6)) { if (blockIdx.x < NB * RH) phase_rwkv_scan(P); phase_attn2(P, ctl + CW_QH + 64 * layer, layer); PH_END
        PH_BEGIN if (PH_ON(8)) { phase_rwkv_out(P, layer); PH_END
        PH_BEGIN if (PH_ON(9)) { const bf16_t* A = (const bf16_t*)(P.ws + WS_MIXED); g8::DenseOrder S; S.init(A, DM, (const bf16_t*)(P.ws + WS_WOUT) + (size_t)layer * DM * DM, DM, M, DM, gridDim.x, blockIdx.x);
            g8::EpiResid E{(layer == 0) ? KARG(P, 8 * I_X, const float*) : (const float*)OUTP(P), OUTP(P), (const float*)(P.ws + WS_COND) + 2 * 1024, KARG(P, 8 * I_ADALB, const float*) + layer * 6144 + 2 * 1024};
            g8::gemm_phase<g8::EpiResid, g8::DenseOrder, false>(P.tid, P.lds, A, DM, DM, S, E); PH_END
        PH_BEGIN if (PH_ON(10)) { phase_norm(P, layer, 1, false, moe); PH_END
        if (!moe) {
            PH_BEGIN if (PH_ON(11)) { const bf16_t* H = (const bf16_t*)(P.ws + WS_H);
                g8::DenseOrder S; S.init(H, DM, (const bf16_t*)(P.ws + WS_FGU) + (size_t)fi * 2 * FF * DM, DM, M, 2 * FF, gridDim.x, blockIdx.x);
#if DENSE_DN8
                g8::EpiGlu8 E{(unsigned char*)(P.ws + WS_ACT), FF}; g8::gemm_phase<g8::EpiGlu8, g8::DenseOrder, false>(P.tid, P.lds, H, DM, DM, S, E);
#else
                g8::EpiGlu E{(bf16_t*)(P.ws + WS_ACT), FF}; g8::gemm_phase<g8::EpiGlu, g8::DenseOrder, false>(P.tid, P.lds, H, DM, DM, S, E);
#endif
            PH_END
            PH_BEGIN if (PH_ON(12)) { const bf16_t* ACT = (const bf16_t*)(P.ws + WS_ACT);
                g8::EpiResid E{(const float*)OUTP(P), OUTP(P), (const float*)(P.ws + WS_COND) + 5 * 1024, KARG(P, 8 * I_ADALB, const float*) + layer * 6144 + 5 * 1024};
#if DENSE_DN8
                g8::DenseOrder S; S.init(ACT, FF / 2, (const bf16_t*)(P.ws + WS_FD + (size_t)fi * DM * FF), FF / 2, M, DM, gridDim.x, blockIdx.x);
                g8::gemm_phase<g8::EpiResid, g8::DenseOrder, false, 0x7C7C7C7Cu>(P.tid, P.lds, ACT, FF / 2, FF / 2, S, E);
#else
                g8::DenseOrder S; S.init(ACT, FF, (const bf16_t*)(P.ws + WS_FD) + (size_t)fi * DM * FF, FF, M, DM, gridDim.x, blockIdx.x);
                g8::gemm_phase<g8::EpiResid, g8::DenseOrder, false>(P.tid, P.lds, ACT, FF, FF, S, E);
#endif
            PH_END
        } else {
            PH_BEGIN if (PH_ON(11)) { const unsigned* cnt = ctl + CW_CNT + 16 * fi; moe_tables(P, cnt, 256);
                const bf16_t* XS = (const bf16_t*)(P.ws + WS_XS8);
                g8::MoeOrder S; S.init(P, cnt, (const char*)XS, DM / 2, (const char*)(P.ws + WS_MGU) + (size_t)fi * NE * 2 * MFF * DM, (size_t)2 * MFF * DM, DM / 2, 2 * MFF); S.xs = true;
                g8::EpiGlu8 E{(unsigned char*)(P.ws + WS_ACT), MFF}; g8::gemm_phase<g8::EpiGlu8, g8::MoeOrder, false, 0x7C7C7C7Cu>(P.tid, P.lds, XS, DM / 2, DM / 2, S, E);
            PH_END
            PH_BEGIN if (PH_ON(12)) { const unsigned* cnt = ctl + CW_CNT + 16 * fi; moe_tables(P, cnt, 256);
                const bf16_t* ACT = (const bf16_t*)(P.ws + WS_ACT);
                g8::MoeOrder S; S.init(P, cnt, (const char*)ACT, MFF / 2, (const char*)(P.ws + WS_MD) + (size_t)fi * NE * DM * MFF, (size_t)DM * MFF, MFF / 2, DM);
                g8::EpiStoreB E{(bf16_t*)(P.ws + WS_YS), DM}; g8::gemm_phase<g8::EpiStoreB, g8::MoeOrder, false, 0x7C7C7C7Cu>(P.tid, P.lds, ACT, MFF / 2, MFF / 2, S, E);
                if (layer == 1) late_convert(P, ctl + CW_LATE);
            PH_END
        }
    }
    PH_BEGIN if (PH_ON(13)) { phase_norm(P, NL, 2, true, false); PH_END
#undef PH_BEGIN
#undef PH_END
}

extern "C" void kernel_launch(void* const* d_in, const int* in_sizes, int n_in, void* d_out, int out_size, void* d_ws, size_t ws_size, hipStream_t stream) {
    static int grid = 0;
    if (grid == 0) {
        if (n_in != 38 || out_size != M * DM || ws_size < WS_END) { fprintf(stderr, "kernel_launch: unexpected problem (n_in %d out %d ws %zu need %zu)\n", n_in, out_size, ws_size, (size_t)WS_END); grid = -1; return; }
        int dev = 0, cus = 0, per_cu = 0;
        if (hipGetDevice(&dev) != hipSuccess || hipDeviceGetAttribute(&cus, hipDeviceAttributeMultiprocessorCount, dev) != hipSuccess) { grid = -1; return; }
        if (hipFuncSetAttribute((const void*)mega, hipFuncAttributeMaxDynamicSharedMemorySize, LDS_BYTES) != hipSuccess) { fprintf(stderr, "kernel_launch: hipFuncSetAttribute failed\n"); grid = -1; return; }
        if (hipOccupancyMaxActiveBlocksPerMultiprocessor(&per_cu, (const void*)mega, NTHREADS, LDS_BYTES) != hipSuccess || per_cu < 1) fprintf(stderr, "kernel_launch: occupancy query reports %d\n", per_cu);
        (void)hipGetLastError();
        grid = cus;
    }
    if (grid < 0) return;
    (void)hipMemsetAsync((char*)d_ws + WS_CTL, 0, CTL_BYTES, stream);
    Args a{};
    for (int i = 0; i < 38; ++i) a.in[i] = d_in[i];
    a.out = (float*)d_out; a.ws = (unsigned char*)d_ws;
#if MK_ONE_LAUNCH
    a.ph_lo = 0; a.ph_hi = N_PHASES;
    hipLaunchKernelGGL(mega, dim3(grid), dim3(NTHREADS), LDS_BYTES, stream, a);
#ifdef PROBE_PID
    { const int plist[] = {PROBE_PID}; for (int r = 0; r < PROBE_N; ++r) for (int pi = 0; pi < (int)(sizeof(plist) / sizeof(int)); ++pi) { (void)hipMemsetAsync((char*)d_ws + WS_CTL + (CW_QH + 64 * 3) * 4, 0, 4, stream); a.ph_lo = plist[pi]; a.ph_hi = plist[pi] + 1; hipLaunchKernelGGL(mega, dim3(grid), dim3(NTHREADS), LDS_BYTES, stream, a); } }
#endif
#else
    for (int p = 0; p < N_PHASES; ++p) { a.ph_lo = p; a.ph_hi = p + 1; hipLaunchKernelGGL(mega, dim3(grid), dim3(NTHREADS), LDS_BYTES, stream, a); }
#endif
}
```

```cpp
#ifndef FUSE_NORM
#define FUSE_NORM 1
#endif
#ifndef DENSE_DN8
#define DENSE_DN8 1
#endif
#include <hip/hip_runtime.h>
#include <cstdio>
#include <cstdint>

#ifndef MK_ONE_LAUNCH
#define MK_ONE_LAUNCH 1
#endif

#define GAS __attribute__((address_space(1)))
#define LAS __attribute__((address_space(3)))
#define DI __device__ __forceinline__
typedef unsigned short bf16_t;
typedef short bf16x8 __attribute__((ext_vector_type(8)));
typedef short s16x4 __attribute__((ext_vector_type(4)));
typedef float f32x4 __attribute__((ext_vector_type(4)));
typedef float f32x2 __attribute__((ext_vector_type(2)));
typedef float f32x16 __attribute__((ext_vector_type(16)));
typedef unsigned u32x4 __attribute__((ext_vector_type(4)));
typedef unsigned u32x2 __attribute__((ext_vector_type(2)));
typedef __bf16 bf16x2_t __attribute__((ext_vector_type(2)));
typedef int v4i_t __attribute__((ext_vector_type(4)));
typedef int v8i_t __attribute__((ext_vector_type(8)));

constexpr int NB = 4, SEQ = 4096, DM = 1024, M = NB * SEQ, NL = 4;
constexpr int INC = 1952, INCP = 2048;
constexpr int U_CQ = 512, U_CKV = 768, U_KR = 896, U_RW = 928;
constexpr int NH = 8, DQK = 96, DNOPE = 64, DROPE = 32, DV = 64;
constexpr int RH = 4, RN = 64, RC = 256;
constexpr int FF = 2816, MFF = 3584, NE = 8;
constexpr int CONVK = 31, CONVC = 256;
constexpr int MOE_CAP = 34816;
constexpr int NWAVES = 8, NTHREADS = 512;

constexpr size_t MiB = 1u << 20;
constexpr size_t WS_CTL = 0, CTL_BYTES = 1 * MiB;
constexpr size_t WS_COND = 1 * MiB;
constexpr size_t WS_COS = 2 * MiB, WS_SIN = 3 * MiB;
constexpr size_t WS_WIN = 4 * MiB;
constexpr size_t WS_WOUT = 20 * MiB;
constexpr size_t WS_WUQ = 28 * MiB;
constexpr size_t WS_WUKV = 30 * MiB;
constexpr size_t WS_LORA = 32 * MiB;
constexpr size_t WS_FGU = 34 * MiB;
constexpr size_t WS_FD = 56 * MiB;
constexpr size_t WS_MGU = 68 * MiB;
constexpr size_t WS_MD = 292 * MiB;
constexpr size_t WS_H = 404 * MiB;
constexpr size_t WS_YS = 436 * MiB;
constexpr size_t WS_MOE = 504 * MiB;
constexpr size_t WS_LNS = 506 * MiB;
constexpr size_t WS_MIX = 508 * MiB;
constexpr size_t WS_U = WS_MIX;
constexpr size_t WS_MIXED = WS_MIX + 64 * MiB;
constexpr size_t WS_QRAW = WS_MIX + 96 * MiB;
constexpr size_t WS_KVRAW = WS_MIX + 120 * MiB;
constexpr size_t WS_Q = WS_MIX + 152 * MiB;
constexpr size_t WS_K = WS_MIX + 176 * MiB;
constexpr size_t WS_VT = WS_MIX + 200 * MiB;
constexpr size_t WS_RR = WS_MIX + 216 * MiB;
constexpr size_t WS_RK = WS_MIX + 224 * MiB;
constexpr size_t WS_RV = WS_MIX + 232 * MiB;
constexpr size_t WS_RKK = WS_MIX + 240 * MiB;
constexpr size_t WS_RB = WS_MIX + 248 * MiB;
constexpr size_t WS_RG = WS_MIX + 256 * MiB;
constexpr size_t WS_RLW = WS_MIX + 264 * MiB;
constexpr size_t WS_RY = WS_MIX + 280 * MiB;
constexpr size_t WS_LIN = WS_MIX + 296 * MiB;
constexpr size_t WS_LOUT = WS_MIX + 304 * MiB;
constexpr size_t WS_XS8 = WS_MIX + 128 * MiB;
constexpr size_t WS_ACT = WS_MIX;
constexpr size_t WS_CHK = WS_MIX + 330 * MiB;
constexpr size_t WS_END = WS_MIX + 362 * MiB;
static_assert((size_t)MOE_CAP * MFF * 2 <= 330 * MiB, "act fits");
constexpr size_t MOE_LTOK = 0;
constexpr size_t MOE_TE = 512 * 1024;
constexpr size_t MOE_TR = MOE_TE + 128 * 1024;
constexpr size_t MOE_TP = MOE_TR + 128 * 1024;
constexpr int CW_CNT = 64;
constexpr int CW_LATE = 448;
constexpr int CW_QH = 512;
constexpr int CW_PAN_TMO = 1536;
constexpr int CW_PAN = 16384;
constexpr int CW_LN = 49152;
constexpr int CW_RO = 65536;
constexpr int CW_BAR = 4096;

DI float shx(float v, int k) {
    if (k == 32) { auto rr = __builtin_amdgcn_permlane32_swap(__float_as_uint(v), __float_as_uint(v), false, false); const float a = __uint_as_float(rr[0]), b = __uint_as_float(rr[1]);
        unsigned mk_ = ~0u; asm volatile("" : "+s"(mk_));
        return (__builtin_amdgcn_mbcnt_hi(mk_, __builtin_amdgcn_mbcnt_lo(mk_, 0u)) < 32u) ? b : a; }
    switch (k) {
        case 1: return __int_as_float(__builtin_amdgcn_ds_swizzle(__float_as_int(v), (1 << 10) | 0x1f));
        case 2: return __int_as_float(__builtin_amdgcn_ds_swizzle(__float_as_int(v), (2 << 10) | 0x1f));
        case 4: return __int_as_float(__builtin_amdgcn_ds_swizzle(__float_as_int(v), (4 << 10) | 0x1f));
        case 8: return __int_as_float(__builtin_amdgcn_ds_swizzle(__float_as_int(v), (8 << 10) | 0x1f));
        default: return __int_as_float(__builtin_amdgcn_ds_swizzle(__float_as_int(v), (16 << 10) | 0x1f));
    }
}
DI float shx32_sum(float v) { auto rr = __builtin_amdgcn_permlane32_swap(__float_as_uint(v), __float_as_uint(v), false, false); return __uint_as_float(rr[0]) + __uint_as_float(rr[1]); }
DI float shx32_max(float v) { auto rr = __builtin_amdgcn_permlane32_swap(__float_as_uint(v), __float_as_uint(v), false, false); return fmaxf(__uint_as_float(rr[0]), __uint_as_float(rr[1])); }
DI float wave_sum(float v) {
#pragma unroll
    for (int o = 1; o < 32; o <<= 1) v += shx(v, o);
    v = shx32_sum(v);
    return v;
}
DI float wave_max(float v) {
#pragma unroll
    for (int o = 1; o < 32; o <<= 1) v = fmaxf(v, shx(v, o));
    v = shx32_max(v);
    return v;
}
DI unsigned pk2(float lo, float hi) { f32x2 v = {lo, hi}; bf16x2_t b = __builtin_convertvector(v, bf16x2_t); return __builtin_bit_cast(unsigned, b); }
DI bf16_t f2bf(float f) { return (bf16_t)(pk2(f, 0.f) & 0xffffu); }
DI float bf2f(bf16_t b) { return __uint_as_float((unsigned)b << 16); }
DI float sigmoidf_(float x) { return 1.f / (1.f + __expf(-x)); }
DI float siluf_(float x) { return x * __builtin_amdgcn_rcpf(1.f + __expf(-x)); }
DI float fsigmoid(float x) { return __builtin_amdgcn_rcpf(1.f + __expf(-x)); }
DI float ftanh(float x) { return 2.f * __builtin_amdgcn_rcpf(1.f + __expf(-2.f * x)) - 1.f; }
DI float ozero() { float z = 0.f; asm volatile("" : "+v"(z)); return z; }
DI int crow(int reg, int h) { return (reg & 3) + 8 * (reg >> 2) + 4 * h; }
DI float bflo(unsigned w) { return __uint_as_float(w << 16); }
DI float bfhi(unsigned w) { return __uint_as_float(w & 0xffff0000u); }
DI void unpack8(const u32x4& w, float* f) { f[0] = bflo(w.x); f[1] = bfhi(w.x); f[2] = bflo(w.y); f[3] = bfhi(w.y); f[4] = bflo(w.z); f[5] = bfhi(w.z); f[6] = bflo(w.w); f[7] = bfhi(w.w); }
DI u32x4 pack8(const float* f) { u32x4 w; w.x = pk2(f[0], f[1]); w.y = pk2(f[2], f[3]); w.z = pk2(f[4], f[5]); w.w = pk2(f[6], f[7]); return w; }
DI f32x4 ld4(const float* p) { return *(const f32x4*)p; }
DI unsigned pk4_fp8(float a, float b, float c, float d) { int w; asm volatile("" : "=v"(w));   w = __builtin_amdgcn_cvt_pk_fp8_f32(a, b, w, false); w = __builtin_amdgcn_cvt_pk_fp8_f32(c, d, w, true); return (unsigned)w; }

#define XB_TMO      128
#define XB_XCNT(j)  (256  + 64 * (j))
#define XB_XSUB(j)  (1280 + 64 * (j))
#define XB_XGEN(j)  (2304 + 64 * (j))
#define XB_TOP      3328
#define XB_TOPGEN   3392
#define XCD_BAR_WORDS 3456
#define XB_SPIN_CAP (1u << 18)
__device__ __forceinline__ unsigned xb_ld(unsigned* p)              { asm volatile("" : "+v"(p));   return __hip_atomic_load(p, __ATOMIC_RELAXED, __HIP_MEMORY_SCOPE_AGENT); }
__device__ __forceinline__ unsigned xb_add(unsigned* p, unsigned v) { return __hip_atomic_fetch_add(p, v, __ATOMIC_RELAXED, __HIP_MEMORY_SCOPE_AGENT); }
__device__ __forceinline__ unsigned xb_xcc_id() { return (unsigned)__builtin_amdgcn_s_getreg((3 << 11) | 20) & 0xFu; }
#define XB_SPIN(cond, bar) do { unsigned _sp = 0; while (cond) { __builtin_amdgcn_s_sleep(1); \
    if ((++_sp & 255u) == 0u) { if (xb_ld(&(bar)[XB_TMO])) break; if (_sp > XB_SPIN_CAP) { atomicAdd(&(bar)[XB_TMO], 1u); break; } } } } while (0)
struct XcdBarrier { unsigned* bar; unsigned x; volatile LAS unsigned* st; };
__device__ __forceinline__ XcdBarrier xcd_barrier_post(unsigned* bar, volatile LAS unsigned* st) {
    XcdBarrier b; b.bar = bar; b.x = xb_xcc_id(); b.st = st;
    if (threadIdx.x == 0) (void)xb_add(&bar[XB_XCNT(b.x)], 1u);
    return b;
}
__device__ __forceinline__ void xcd_barrier_complete(unsigned* bar, unsigned x, unsigned& nloc, unsigned& nx) {
    const unsigned G = gridDim.x * gridDim.y * gridDim.z;
    unsigned sum, cnt, mine, sp = 0u;
    for (;;) {
        sum = 0u; cnt = 0u; mine = 0u;
#pragma unroll
        for (unsigned j = 0; j < 16; ++j) { const unsigned c = xb_ld(&bar[XB_XCNT(j)]); sum += c; cnt += (c > 0u) ? 1u : 0u; mine = (j == x) ? c : mine; }
        if (sum == G) break;
        __builtin_amdgcn_s_sleep(1);
        if ((++sp & 255u) == 0u) { if (xb_ld(&bar[XB_TMO])) break; if (sp > XB_SPIN_CAP) { atomicAdd(&bar[XB_TMO], 1u); break; } }
    }
    nloc = mine > 0u ? mine : 1u; nx = cnt > 0u ? cnt : 1u;
}
__device__ __forceinline__ void xcd_barrier(const XcdBarrier& b, int tid_) {
    asm volatile("s_waitcnt vmcnt(0)" ::: "memory");
    __syncthreads();
    if (tid_ == 0) {
        unsigned* bar = b.bar;
        __builtin_amdgcn_s_waitcnt(0);
        unsigned nloc = b.st[0], nx = b.st[1];
        if (nloc == 0u) { xcd_barrier_complete(bar, b.x, nloc, nx); b.st[0] = nloc; b.st[1] = nx; }
        const unsigned old = xb_add(&bar[XB_XSUB(b.x)], 1u);
        const unsigned gen = old / nloc;
        if (old + 1u == (gen + 1u) * nloc) {
            __builtin_amdgcn_fence(__ATOMIC_RELEASE, "agent");
            asm volatile("s_waitcnt vmcnt(0)" ::: "memory");
            const unsigned og = xb_add(&bar[XB_TOP], 1u);
            const unsigned tg = og / nx;
            if (og + 1u == (tg + 1u) * nx) xb_add(&bar[XB_TOPGEN], 1u);
            else XB_SPIN(xb_ld(&bar[XB_TOPGEN]) == tg, bar);
            __builtin_amdgcn_fence(__ATOMIC_ACQUIRE, "agent");
            xb_add(&bar[XB_XGEN(b.x)], 1u);
            asm volatile("s_waitcnt vmcnt(0)" ::: "memory");
        } else {
            XB_SPIN(xb_ld(&bar[XB_XGEN(b.x)]) == gen, bar);
            __builtin_amdgcn_fence(__ATOMIC_ACQUIRE, "agent");
            asm volatile("s_waitcnt vmcnt(0)" ::: "memory");
        }
    }
    __syncthreads();
}

struct Args { const void* in[38]; float* out; unsigned char* ws; int ph_lo, ph_hi; };
enum { I_X = 0, I_C, I_POS, I_ADAW, I_ADAB, I_ADALB, I_N1G, I_N2G, I_WIN, I_WOUT, I_CONVW, I_CONVB, I_CONVLG, I_CONVLB, I_QNG, I_WUQ, I_KVNG, I_WUKV, I_QKQ, I_QKK,
       I_RMU, I_RW0, I_RWUP, I_RA0, I_RAUP, I_RGUP, I_RKK, I_RKA, I_RRK, I_RLNG, I_RLNB, I_FG, I_FU, I_FD, I_ROUTER, I_MG, I_MU, I_MD };

#define CAS __attribute__((address_space(4)))
struct Ctx {
    const CAS char* ka; unsigned char* ws; LAS unsigned char* lds;
    int tid, lane, wave, gw, NGW, gtid, NT;
};
#define KARG(C_, off, T) (*(T const CAS*)((C_).ka + (off)))
#define INF(i) KARG(C, 8 * (i), const float*)
#define OUTP(C_) KARG(C_, 304, float*)

constexpr float GLU_GS = -1.4426950408889634f, GLU_US = -0.6931471805599453f;
DI void tr_load(const float* W, int K, int N, int item, int lane, f32x4 (&t)[16]) {
    const int nblk = (N + 63) / 64, kb = item / nblk, nb = item % nblk, k0 = 64 * kb, n0 = 64 * nb;
    const int lr = lane >> 4, lc = (lane & 15) * 4;
    const bool cvalid = (n0 + lc) < N;
#pragma unroll
    for (int i = 0; i < 16; ++i) t[i] = cvalid ? __builtin_nontemporal_load((const f32x4*)(W + (size_t)(k0 + 4 * i + lr) * N + n0 + lc)) : (f32x4){0.f, 0.f, 0.f, 0.f};
}
DI void tr_emit(const f32x4 (&t)[16], int K, int N, bf16_t* WT, int ldk, int mode, LAS float* scr, int item, int lane, float f8scale, float wmul) {
    const int nblk = (N + 63) / 64, kb = item / nblk, nb = item % nblk, k0 = 64 * kb, n0 = 64 * nb;
    const int lr = lane >> 4, lc = (lane & 15) * 4;
#pragma unroll
    for (int i = 0; i < 16; ++i) *(LAS f32x4*)(scr + (4 * i + lr) * 68 + lc) = t[i];
    asm volatile("s_waitcnt lgkmcnt(0)" ::: "memory");
    const int c = lane & 7;
    const int r0 = (mode == 0) ? n0 : ((n0 / 128) * 256 + (n0 % 128) + (mode == 2 ? 128 : 0));
#pragma unroll
    for (int j = 0; j < 8; ++j) { const int n = (lane >> 3) + 8 * j; const LAS float* sp = scr + (8 * c) * 68 + n;
        if (f8scale != 0.f) { u32x2 o8; o8.x = pk4_fp8(sp[0 * 68] * f8scale, sp[1 * 68] * f8scale, sp[2 * 68] * f8scale, sp[3 * 68] * f8scale); o8.y = pk4_fp8(sp[4 * 68] * f8scale, sp[5 * 68] * f8scale, sp[6 * 68] * f8scale, sp[7 * 68] * f8scale);
            if (n0 + n < N) *(u32x2*)((unsigned char*)WT + (size_t)(r0 + n) * ldk + k0 + 8 * c) = o8; }
        else { u32x4 o; o.x = pk2(sp[0 * 68] * wmul, sp[1 * 68] * wmul); o.y = pk2(sp[2 * 68] * wmul, sp[3 * 68] * wmul); o.z = pk2(sp[4 * 68] * wmul, sp[5 * 68] * wmul); o.w = pk2(sp[6 * 68] * wmul, sp[7 * 68] * wmul);
            if (n0 + n < N) *(u32x4*)(WT + (size_t)(r0 + n) * ldk + k0 + 8 * c) = o; } }
    asm volatile("s_waitcnt lgkmcnt(0)" ::: "memory");
}
DI void tr_load8(const float* W, int K, int N, int item, int lane, f32x4 (&t)[16]) {
    const int nblk = N / 32, kb = item / nblk, nb = item % nblk, k0 = 128 * kb, n0 = 32 * nb;
    const int lr = lane >> 3, lc = (lane & 7) * 4;
#pragma unroll
    for (int i = 0; i < 16; ++i) t[i] = __builtin_nontemporal_load((const f32x4*)(W + (size_t)(k0 + 8 * i + lr) * N + n0 + lc));
}
DI void tr_emit8(const f32x4 (&t)[16], int K, int N, unsigned char* WT, int ldk, int mode, LAS float* scr, int item, int lane, float f8scale) {
    const int nblk = N / 32, kb = item / nblk, nb = item % nblk, k0 = 128 * kb, n0 = 32 * nb;
    const int lr = lane >> 3, lc = (lane & 7) * 4;
#pragma unroll
    for (int i = 0; i < 16; ++i) *(LAS f32x4*)(scr + (8 * i + lr) * 36 + lc) = t[i];
    asm volatile("s_waitcnt lgkmcnt(0)" ::: "memory");
    const int n = lane & 31, h = lane >> 5;
    const int r0 = (mode == 0) ? n0 : ((n0 / 128) * 256 + (n0 % 128) + (mode == 2 ? 128 : 0));
    unsigned char* rowp = WT + (size_t)(r0 + n) * ldk + k0;
#pragma unroll
    for (int j = 0; j < 4; ++j) { const int pc = 2 * j + h; const LAS float* sp = scr + (16 * pc) * 36 + n; u32x4 o;
        o.x = pk4_fp8(sp[0 * 36] * f8scale, sp[1 * 36] * f8scale, sp[2 * 36] * f8scale, sp[3 * 36] * f8scale); o.y = pk4_fp8(sp[4 * 36] * f8scale, sp[5 * 36] * f8scale, sp[6 * 36] * f8scale, sp[7 * 36] * f8scale);
        o.z = pk4_fp8(sp[8 * 36] * f8scale, sp[9 * 36] * f8scale, sp[10 * 36] * f8scale, sp[11 * 36] * f8scale); o.w = pk4_fp8(sp[12 * 36] * f8scale, sp[13 * 36] * f8scale, sp[14 * 36] * f8scale, sp[15 * 36] * f8scale);
        *(u32x4*)(rowp + 16 * pc) = o; }
    asm volatile("s_waitcnt lgkmcnt(0)" ::: "memory");
}
DI void transpose_item(const float* W, int K, int N, bf16_t* WT, int ldk, int mode, LAS float* scr, int item, int lane, float f8scale = 0.f, float wmul = 1.f) {
    f32x4 t[16];
    if (f8scale != 0.f) { tr_load8(W, K, N, item, lane, t); tr_emit8(t, K, N, (unsigned char*)WT, ldk, mode, scr, item, lane, f8scale); }
    else { tr_load(W, K, N, item, lane, t); tr_emit(t, K, N, WT, ldk, mode, scr, item, lane, f8scale, wmul); }
}

struct TrItem { const float* W; int K, N; bf16_t* WT; int ldk, mode; float f8, wm; int item; bool ok; };
DI TrItem tr_decode(const Ctx& C, int g) {
    TrItem r; r.ok = false; r.W = nullptr; r.K = 64; r.N = 64; r.WT = nullptr; r.ldk = 0; r.mode = 0; r.f8 = 0.f; r.wm = 1.f; r.item = 0;
    bool done = false;
#define TJ(in_, K_, N_, dst_, ldk_, mode_, nmat_, ss_, dsb_, f8_, wm_) if (!done) { const int per = ((K_) / 64) * (((N_) + 63) / 64), tot = per * (nmat_); \
        if (g < tot) { const int mi = g / per; r.item = g - mi * per; r.W = INF(in_) + (size_t)mi * (ss_); r.K = (K_); r.N = (N_); r.WT = (bf16_t*)(C.ws + (dst_) + (size_t)mi * (dsb_)); r.ldk = (ldk_); r.mode = (mode_); r.f8 = (f8_); r.wm = (wm_); r.ok = true; done = true; } else g -= tot; }
    TJ(I_MG, 1024, MFF, WS_MGU, 1024, 1, 16, (size_t)1024 * MFF, (size_t)2 * MFF * 1024, 64.f * GLU_GS, 1.f)
    TJ(I_MU, 1024, MFF, WS_MGU, 1024, 2, 16, (size_t)1024 * MFF, (size_t)2 * MFF * 1024, 64.f * GLU_US, 1.f)
    TJ(I_MD, MFF, 1024, WS_MD, MFF, 0, 8, (size_t)MFF * 1024, (size_t)1024 * MFF, 64.f, 1.f)
    TJ(I_WIN, 1024, INC, WS_WIN, 1024, 0, NL, (size_t)1024 * INC, (size_t)INCP * 1024 * 2, 0.f, 1.f)
    TJ(I_WOUT, 1024, 1024, WS_WOUT, 1024, 0, NL, (size_t)1024 * 1024, (size_t)1024 * 1024 * 2, 0.f, 1.f)
    TJ(I_WUQ, 256, 768, WS_WUQ, 256, 0, NL, (size_t)256 * 768, (size_t)768 * 256 * 2, 0.f, 1.f)
    TJ(I_FG, 1024, FF, WS_FGU, 1024, 1, 2, (size_t)1024 * FF, (size_t)2 * FF * 1024 * 2, 0.f, GLU_GS)
    TJ(I_FU, 1024, FF, WS_FGU, 1024, 2, 2, (size_t)1024 * FF, (size_t)2 * FF * 1024 * 2, 0.f, GLU_US)
    TJ(I_WUKV, 128, 1024, WS_WUKV, 256, 0, NL, (size_t)128 * 1024, (size_t)1024 * 256 * 2, 0.f, 1.f)
    TJ(I_RWUP, 64, 256, WS_LORA, 256, 0, NL, (size_t)64 * 256, (size_t)768 * 256 * 2, 0.f, 1.f)
    TJ(I_RAUP, 64, 256, WS_LORA + (size_t)(256 * 256 + 64) * 2, 256, 0, NL, (size_t)64 * 256, (size_t)768 * 256 * 2, 0.f, 1.f)
    TJ(I_RGUP, 128, 256, WS_LORA + (size_t)(512 * 256 + 128) * 2, 256, 0, NL, (size_t)128 * 256, (size_t)768 * 256 * 2, 0.f, 1.f)
#if DENSE_DN8
    TJ(I_FD, FF, 1024, WS_FD, FF, 0, 2, (size_t)FF * 1024, (size_t)1024 * FF, 64.f, 1.f)
#else
    TJ(I_FD, FF, 1024, WS_FD, FF, 0, 2, (size_t)FF * 1024, (size_t)1024 * FF * 2, 0.f, 1.f)
#endif
#undef TJ
    return r;
}

DI void phase_prologue(Ctx C) {
    LAS float* scr = (LAS float*)(C.lds + (C.wave < 7 ? C.wave * 18432 : 131072 + 4096));
    {
        TrItem cur = tr_decode(C, C.gw); f32x4 t[16];
        if (cur.ok) { if (cur.f8 != 0.f) tr_load8(cur.W, cur.K, cur.N, cur.item, C.lane, t); else tr_load(cur.W, cur.K, cur.N, cur.item, C.lane, t); }
        for (int g = C.gw; cur.ok; g += C.NGW) {
            const TrItem nxt = tr_decode(C, g + C.NGW); f32x4 tn[16];
            if (nxt.ok) { if (nxt.f8 != 0.f) tr_load8(nxt.W, nxt.K, nxt.N, nxt.item, C.lane, tn); else tr_load(nxt.W, nxt.K, nxt.N, nxt.item, C.lane, tn); }
            if (cur.f8 != 0.f) tr_emit8(t, cur.K, cur.N, (unsigned char*)cur.WT, cur.ldk, cur.mode, scr, cur.item, C.lane, cur.f8);
            else tr_emit(t, cur.K, cur.N, cur.WT, cur.ldk, cur.mode, scr, cur.item, C.lane, cur.f8, cur.wm);
#pragma unroll
            for (int i = 0; i < 16; ++i) t[i] = tn[i];
            cur = nxt;
        }
    }
    {
        for (int i = C.gtid; i < NL * 96 * 1024; i += C.NT) { const int l = i / (96 * 1024), r = i % (96 * 1024); ((bf16_t*)(C.ws + WS_WIN))[(size_t)l * INCP * 1024 + (size_t)INC * 1024 + r] = 0; }
        for (int i = C.gtid; i < NL * 1024 * 16; i += C.NT) { const int row = i >> 4, c = i & 15; *(u32x4*)((bf16_t*)(C.ws + WS_WUKV) + (size_t)row * 256 + 128 + c * 8) = (u32x4){0u, 0u, 0u, 0u}; }
        for (int i = C.gtid; i < NL * 768 * 32; i += C.NT) { const int row = i >> 5, c8 = (i & 31) * 8, n = row % 768;
            const bool z = (n < 256) ? (c8 >= 64) : (n < 512) ? (c8 < 64 || c8 >= 128) : (c8 < 128);
            if (z) *(u32x4*)((bf16_t*)(C.ws + WS_LORA) + (size_t)row * 256 + c8) = (u32x4){0u, 0u, 0u, 0u}; }
        const int* pos = KARG(C, 8 * I_POS, const int*);
        for (int i = C.gtid; i < M * 16; i += C.NT) { const int m = i >> 4, f = i & 15; const float inv = powf(10000.0f, -(float)(2 * f) / 32.0f); const float ang = (float)pos[m] * inv;
            ((float*)(C.ws + WS_COS))[i] = cosf(ang); ((float*)(C.ws + WS_SIN))[i] = sinf(ang); }
    }
    {
        LAS float* red = (LAS float*)(C.lds);
        LAS float* sc = (LAS float*)(C.lds + 8192);
        __syncthreads();
        if (blockIdx.x < 6144 / 64) { for (int i = C.tid; i < 4096; i += NTHREADS) sc[(i & 1023) * 4 + (i >> 10)] = siluf_(INF(I_C)[i]); }
        for (int it = blockIdx.x; it < 6144 / 64; it += gridDim.x) {
            __syncthreads();
            const int n = it * 64 + C.lane; float acc[4] = {0.f, 0.f, 0.f, 0.f};
#pragma unroll 8
            for (int k = C.wave * 128; k < C.wave * 128 + 128; ++k) { const float w = INF(I_ADAW)[(size_t)k * 6144 + n]; const f32x4 s4 = *(const LAS f32x4*)(sc + k * 4);
#pragma unroll
                for (int b = 0; b < 4; ++b) acc[b] += s4[b] * w; }
#pragma unroll
            for (int b = 0; b < 4; ++b) red[(C.wave * 4 + b) * 64 + C.lane] = acc[b];
            __syncthreads();
            if (C.tid < 256) { const int b = C.tid >> 6, l = C.tid & 63; float s = INF(I_ADAB)[it * 64 + l];
                for (int w = 0; w < 8; ++w) s += red[(w * 4 + b) * 64 + l];
                ((float*)(C.ws + WS_COND))[b * 6144 + it * 64 + l] = s; }
        }
        __syncthreads();
    }
}


DI void late_convert(Ctx C, unsigned* qctr) {
    LAS float* scr = (LAS float*)(C.lds + (C.wave < 7 ? C.wave * 18432 : 131072 + 4096));
    constexpr int P_M = 16 * 56, NTOT = 8 * P_M;
    for (;;) {
        unsigned base = 0; if (C.lane == 0) base = __hip_atomic_fetch_add(qctr, 8u, __ATOMIC_RELAXED, __HIP_MEMORY_SCOPE_AGENT);
        base = __builtin_amdgcn_readfirstlane(base);
        if (base >= (unsigned)NTOT) break;
        for (int q = 0; q < 8; ++q) { const int it = (int)base + q; if (it >= NTOT) break; const int mi = 8 + it / P_M;
            transpose_item(INF(I_MD) + (size_t)mi * MFF * 1024, MFF, 1024, (bf16_t*)(C.ws + WS_MD + (size_t)mi * 1024 * MFF), MFF, 0, scr, it % P_M, C.lane, 64.f); }
    }
}

DI void phase_norm(Ctx C, int layer, int which_norm, bool combine_prev, bool route) {
    const float* xin = (layer == 0 && which_norm == 0) ? INF(I_X) : OUTP(C);
    float* xout = OUTP(C);
    bf16_t* H = (bf16_t*)(C.ws + WS_H);
    const int prev = layer - 1, mi_prev = prev >> 1;
    unsigned* ctl = (unsigned*)(C.ws + WS_CTL);
    const float* cond = (const float*)(C.ws + WS_COND); const float* lbias = INF(I_ADALB);
    LAS float* rt = (LAS float*)C.lds;
    const int mi = layer >> 1;
    LAS int* sel_e = (LAS int*)(C.lds + 40960); LAS float* sel_p = (LAS float*)(C.lds + 40960 + 4096); LAS int* lcnt = (LAS int*)(C.lds + 40960 + 8192);
    f32x4 rw[16][2];
    if (route) { const float* R = INF(I_ROUTER) + (size_t)mi * DM * NE;
#pragma unroll
        for (int j = 0; j < 4; ++j)
#pragma unroll
            for (int k = 0; k < 4; ++k) { const float* rp = R + (size_t)(C.lane * 4 + 256 * j + k) * NE; rw[j * 4 + k][0] = ld4(rp); rw[j * 4 + k][1] = ld4(rp + 4); }
        if (C.tid < 16) lcnt[C.tid] = 0;
        __syncthreads(); }
    int pst[8];
    if (combine_prev) { const unsigned* cnt = ctl + CW_CNT + 16 * mi_prev; int acc = 0;
#pragma unroll
        for (int e = 0; e < 8; ++e) { pst[e] = acc; acc += ((int)cnt[e] + 255) / 256 * 256; } }
    const int rpw = (M + C.NGW - 1) / C.NGW, m0 = C.gw * rpw, m1 = (m0 + rpw < M) ? m0 + rpw : M;
    int bcur = -1; f32x4 scl[4], sft[4], gtp[4];
    const int wsh = which_norm == 0 ? 0 : 3, wsc = wsh + 1;
    f32x4 vn[4];
    if (m0 < m1) {
#pragma unroll
        for (int j = 0; j < 4; ++j) vn[j] = *(const f32x4*)(xin + (size_t)m0 * DM + C.lane * 4 + 256 * j); }
    for (int m = m0; m < m1; ++m) {
        const int b = m / SEQ;
        if (b != bcur) { bcur = b;
#pragma unroll
            for (int j = 0; j < 4; ++j) { const int c = C.lane * 4 + 256 * j;
                if (which_norm != 2) { const f32x4 g = ld4(INF(which_norm == 0 ? I_N1G : I_N2G) + layer * DM + c);
                    scl[j] = g * (1.f + ld4(cond + b * 6144 + wsc * 1024 + c) + ld4(lbias + layer * 6144 + wsc * 1024 + c)); sft[j] = ld4(cond + b * 6144 + wsh * 1024 + c) + ld4(lbias + layer * 6144 + wsh * 1024 + c); }
                if (combine_prev) gtp[j] = ld4(cond + b * 6144 + 5 * 1024 + c) + ld4(lbias + prev * 6144 + 5 * 1024 + c); } }
        f32x4 v[4];
#pragma unroll
        for (int j = 0; j < 4; ++j) v[j] = vn[j];
        if (m + 1 < m1) {
#pragma unroll
            for (int j = 0; j < 4; ++j) vn[j] = *(const f32x4*)(xin + (size_t)(m + 1) * DM + C.lane * 4 + 256 * j); }
        if (combine_prev) {
            const int* te = (const int*)(C.ws + WS_MOE + MOE_TE); const int* tr = (const int*)(C.ws + WS_MOE + MOE_TR); const float* tp = (const float*)(C.ws + WS_MOE + MOE_TP);
            const bf16_t* YS = (const bf16_t*)(C.ws + WS_YS);
#pragma unroll
            for (int k = 0; k < 2; ++k) {
                const int e = te[m * 2 + k], r = tr[m * 2 + k]; const float p = tp[m * 2 + k];
                int base = 0;
#pragma unroll
                for (int q = 0; q < 8; ++q) base = (q == e) ? pst[q] : base;
                const bf16_t* yr = YS + (size_t)(base + r) * DM;
#pragma unroll
                for (int j = 0; j < 4; ++j) { const u32x2 w = *(const u32x2*)(yr + C.lane * 4 + 256 * j);
                    v[j] += gtp[j] * p * (f32x4){bflo(w.x), bfhi(w.x), bflo(w.y), bfhi(w.y)}; }
            }
#pragma unroll
            for (int j = 0; j < 4; ++j) *(f32x4*)(xout + (size_t)m * DM + C.lane * 4 + 256 * j) = v[j];
        }
        if (which_norm == 2) continue;
        float s = 0.f;
#pragma unroll
        for (int j = 0; j < 4; ++j) s += v[j].x * v[j].x + v[j].y * v[j].y + v[j].z * v[j].z + v[j].w * v[j].w;
        const float rs = rsqrtf(wave_sum(s) * (1.f / DM) + 1e-6f);
        f32x4 hn[4];
#pragma unroll
        for (int j = 0; j < 4; ++j) { hn[j] = v[j] * rs * scl[j] + sft[j];
            if (route) *(LAS unsigned*)(C.lds + 65536 + (C.wave * 8 + (m - m0)) * 1024 + C.lane * 4 + 256 * j) = pk4_fp8(hn[j].x, hn[j].y, hn[j].z, hn[j].w);
            else { u32x2 w; w.x = pk2(hn[j].x, hn[j].y); w.y = pk2(hn[j].z, hn[j].w); *(u32x2*)(H + (size_t)m * DM + C.lane * 4 + 256 * j) = w; } }
        if (route) {
            float lg[8];
            { float a[8];
#pragma unroll
              for (int e = 0; e < 8; ++e) a[e] = 0.f;
#pragma unroll
              for (int j = 0; j < 4; ++j)
#pragma unroll
                  for (int k = 0; k < 4; ++k) { const float hv = hn[j][k]; const f32x4 w0 = rw[j * 4 + k][0], w1 = rw[j * 4 + k][1];
                      a[0] += hv * w0.x; a[1] += hv * w0.y; a[2] += hv * w0.z; a[3] += hv * w0.w; a[4] += hv * w1.x; a[5] += hv * w1.y; a[6] += hv * w1.z; a[7] += hv * w1.w; }
              const bool u32 = (C.lane & 32) != 0, u16 = (C.lane & 16) != 0, u8 = (C.lane & 8) != 0;
              float b4[4], c2[2];
#pragma unroll
              for (int i = 0; i < 4; ++i) b4[i] = (u32 ? a[i + 4] : a[i]) + shx(u32 ? a[i] : a[i + 4], 32);
#pragma unroll
              for (int i = 0; i < 2; ++i) c2[i] = (u16 ? b4[i + 2] : b4[i]) + shx(u16 ? b4[i] : b4[i + 2], 16);
              float d1 = (u8 ? c2[1] : c2[0]) + shx(u8 ? c2[0] : c2[1], 8);
              d1 += shx(d1, 4); d1 += shx(d1, 2); d1 += shx(d1, 1);
#pragma unroll
              for (int e = 0; e < 8; ++e) lg[e] = __builtin_bit_cast(float, __builtin_amdgcn_readlane(__builtin_bit_cast(int, d1), 32 * (e >> 2) + 16 * ((e >> 1) & 1) + 8 * (e & 1))); }
            float mx = lg[0];
#pragma unroll
            for (int e = 1; e < 8; ++e) mx = fmaxf(mx, lg[e]);
            float pe[8];
#pragma unroll
            for (int e = 0; e < 8; ++e) pe[e] = __expf(lg[e] - mx);
            int e0 = 0; float p0 = pe[0];
#pragma unroll
            for (int e = 1; e < 8; ++e) if (pe[e] > p0) { p0 = pe[e]; e0 = e; }
            int e1 = -1; float p1 = -1.f;
#pragma unroll
            for (int e = 0; e < 8; ++e) if (e != e0 && pe[e] > p1) { p1 = pe[e]; e1 = e; }
            const float inv = 1.f / (p0 + p1);
            if (C.lane == 0) { const int si = C.wave * 64 + (m - m0); sel_e[si * 2] = e0; sel_e[si * 2 + 1] = e1; sel_p[si * 2] = p0 * inv; sel_p[si * 2 + 1] = p1 * inv; }
        }
    }
    if (route) {
        __syncthreads();
        const int w = C.tid >> 6, i = C.tid & 63; const int wm0 = (blockIdx.x * NWAVES + w) * rpw, wm1 = (wm0 + rpw < M) ? wm0 + rpw : M; const bool act = (wm0 + i) < wm1 && i < 64;
        int e0 = 0, e1 = 0, r0 = 0, r1 = 0;
        if (act) { e0 = sel_e[C.tid * 2]; e1 = sel_e[C.tid * 2 + 1]; r0 = __hip_atomic_fetch_add(&lcnt[e0], 1, __ATOMIC_RELAXED, __HIP_MEMORY_SCOPE_WORKGROUP); r1 = __hip_atomic_fetch_add(&lcnt[e1], 1, __ATOMIC_RELAXED, __HIP_MEMORY_SCOPE_WORKGROUP); }
        __syncthreads();
        if (C.tid < 8) lcnt[8 + C.tid] = (int)atomicAdd(ctl + CW_CNT + 16 * mi + C.tid, (unsigned)lcnt[C.tid]);
        __syncthreads();
        if (act) { const int m = wm0 + i; const int s0 = lcnt[8 + e0] + r0, s1 = lcnt[8 + e1] + r1;
            int* ltok = (int*)(C.ws + WS_MOE + MOE_LTOK); int* te = (int*)(C.ws + WS_MOE + MOE_TE); int* tr = (int*)(C.ws + WS_MOE + MOE_TR); float* tp = (float*)(C.ws + WS_MOE + MOE_TP);
            ltok[e0 * 16384 + s0] = m; ltok[e1 * 16384 + s1] = m;
            te[m * 2] = e0; te[m * 2 + 1] = e1; tr[m * 2] = s0; tr[m * 2 + 1] = s1; tp[m * 2] = sel_p[C.tid * 2]; tp[m * 2 + 1] = sel_p[C.tid * 2 + 1];
            sel_e[C.tid * 2] = e0 * 16384 + s0; sel_e[C.tid * 2 + 1] = e1 * 16384 + s1; }
        __syncthreads();
        { unsigned char* XS = C.ws + WS_XS8;
          for (int q = C.tid; q < 64 * 2 * 64; q += NTHREADS) { const int row = q >> 7, kk = (q >> 6) & 1, pc = q & 63; const int ww = row >> 3, ii = row & 7;
              if ((blockIdx.x * NWAVES + ww) * rpw + ii < M && ii < rpw) { const int dst = sel_e[(ww * 64 + ii) * 2 + kk];
                  *(u32x4*)(XS + (size_t)dst * 1024 + pc * 16) = *(const LAS u32x4*)(C.lds + 65536 + row * 1024 + pc * 16); } } }
        __syncthreads();
    }
}

namespace g8 {
constexpr int BM = 256, BK = 64, HALF = 128, HTB = HALF * BK * 2, STAGE_BYTES = 8 * HTB;
DI int lds_byte(int r, int c) { const int st = (r >> 4) * 2 + (c >> 5), rr = r & 15, cc = c & 31, ob = rr * 64 + cc * 2; return st * 1024 + (ob ^ (((ob >> 9) & 1) << 5)); }
DI void stage_rc(int b, int& R, int& C) { const int st = b / 1024, sb = b % 1024, swz = sb ^ (((sb >> 9) & 1) << 5); R = (st >> 1) * 16 + swz / 64; C = (st & 1) * 32 + (swz % 64) / 2; }
DI int perm32(int rho) { const int n = rho >> 4, i = rho & 15; return 8 * (i >> 2) + 4 * n + (i & 3); }
struct Unit { int pm, pn, orow, e; };

struct EpiStore {
    static constexpr bool PERM = true;
    bf16_t* O; int ldc;
    DI void operator()(const f32x4 (&acc)[2][2][4][2], const Unit& u, int wr, int wc, int fr, int fq) const {
        bf16_t* base = O + (size_t)(u.orow + wr * 64 + fr) * ldc + u.pn * BM + wc * 32 + 8 * fq;
#pragma unroll
        for (int ai = 0; ai < 2; ++ai)
#pragma unroll
            for (int m = 0; m < 4; ++m) { bf16_t* rowp = base + (size_t)(ai * HALF + m * 16) * ldc;
#pragma unroll
                for (int bj = 0; bj < 2; ++bj) { const f32x4 v0 = acc[ai][bj][m][0], v1 = acc[ai][bj][m][1];
                    u32x4 w; w.x = pk2(v0[0], v0[1]); w.y = pk2(v0[2], v0[3]); w.z = pk2(v1[0], v1[1]); w.w = pk2(v1[2], v1[3]);
                    *(u32x4*)(rowp + bj * HALF) = w; } }
    }
};
struct EpiGlu {
    static constexpr bool PERM = true;
    bf16_t* O; int ldc;
    DI void operator()(const f32x4 (&acc)[2][2][4][2], const Unit& u, int wr, int wc, int fr, int fq) const {
        bf16_t* base = O + (size_t)(u.orow + wr * 64 + fr) * ldc + u.pn * HALF + wc * 32 + 8 * fq;
#pragma unroll
        for (int ai = 0; ai < 2; ++ai)
#pragma unroll
            for (int m = 0; m < 4; ++m) { float o[8];
#pragma unroll
                for (int n = 0; n < 2; ++n)
#pragma unroll
                    for (int q = 0; q < 4; q += 2) { const f32x2 g = {acc[ai][0][m][n][q], acc[ai][0][m][n][q + 1]}, uu = {acc[ai][1][m][n][q], acc[ai][1][m][n][q + 1]};
                        f32x2 e; e.x = __builtin_amdgcn_exp2f(g.x); e.y = __builtin_amdgcn_exp2f(g.y); const f32x2 d = e + 1.f; f32x2 r; r.x = __builtin_amdgcn_rcpf(d.x); r.y = __builtin_amdgcn_rcpf(d.y);
                        const f32x2 ov = (g * uu) * r; o[n * 4 + q] = ov.x; o[n * 4 + q + 1] = ov.y; }
                u32x4 w; w.x = pk2(o[0], o[1]); w.y = pk2(o[2], o[3]); w.z = pk2(o[4], o[5]); w.w = pk2(o[6], o[7]);
                *(u32x4*)(base + (size_t)(ai * HALF + m * 16) * ldc) = w; }
    }
};
template <int AUX  > struct EpiGlu8T {
    static constexpr bool PERM = true;
    unsigned char* O; int ldc;
    DI void operator()(const f32x4 (&acc)[2][2][4][2], const Unit& u, int wr, int wc, int fr, int fq) const {
        const __amdgpu_buffer_rsrc_t rs = __builtin_amdgcn_make_buffer_rsrc((void*)O, (short)0, -1, 0x00020000);
        const int voff = (wr * 64 + fr) * ldc + wc * 32 + 8 * fq, sbase = u.orow * ldc + u.pn * HALF;
#pragma unroll
        for (int ai = 0; ai < 2; ++ai)
#pragma unroll
            for (int m = 0; m < 4; ++m) { float o[8];
#pragma unroll
                for (int n = 0; n < 2; ++n)
#pragma unroll
                    for (int q = 0; q < 4; q += 2) { const f32x2 g = {acc[ai][0][m][n][q], acc[ai][0][m][n][q + 1]}, uu = {acc[ai][1][m][n][q], acc[ai][1][m][n][q + 1]};
                        f32x2 e; e.x = __builtin_amdgcn_exp2f(g.x); e.y = __builtin_amdgcn_exp2f(g.y); const f32x2 d = e + 1.f; f32x2 r; r.x = __builtin_amdgcn_rcpf(d.x); r.y = __builtin_amdgcn_rcpf(d.y);
                        const f32x2 ov = (g * uu) * r; o[n * 4 + q] = ov.x; o[n * 4 + q + 1] = ov.y; }
                u32x2 w; w.x = pk4_fp8(o[0], o[1], o[2], o[3]); w.y = pk4_fp8(o[4], o[5], o[6], o[7]);
                __builtin_amdgcn_raw_buffer_store_b64(w, rs, voff, sbase + (ai * HALF + m * 16) * ldc, AUX); }
    }
};
typedef EpiGlu8T<0> EpiGlu8;
struct EpiStoreB {
    static constexpr bool PERM = true;
    bf16_t* O; int ldc;
    DI void operator()(const f32x4 (&acc)[2][2][4][2], const Unit& u, int wr, int wc, int fr, int fq) const {
        const __amdgpu_buffer_rsrc_t rs = __builtin_amdgcn_make_buffer_rsrc((void*)O, (short)0, -1, 0x00020000);
        const int voff = ((wr * 64 + fr) * ldc + wc * 32 + 8 * fq) * 2, sbase = (u.orow * ldc + u.pn * BM) * 2;
#pragma unroll
        for (int ai = 0; ai < 2; ++ai)
#pragma unroll
            for (int m = 0; m < 4; ++m)
#pragma unroll
                for (int bj = 0; bj < 2; ++bj) { const f32x4 v0 = acc[ai][bj][m][0], v1 = acc[ai][bj][m][1];
                    u32x4 w; w.x = pk2(v0[0], v0[1]); w.y = pk2(v0[2], v0[3]); w.z = pk2(v1[0], v1[1]); w.w = pk2(v1[2], v1[3]);
                    __builtin_amdgcn_raw_buffer_store_b128(w, rs, voff, sbase + ((ai * HALF + m * 16) * ldc + bj * HALF) * 2, 0); }
    }
};
struct EpiResid {
    static constexpr bool PERM = false;
    const float* xin; float* xout; const float* gc; const float* gl;
    DI void operator()(const f32x4 (&acc)[2][2][4][2], const Unit& u, int wr, int wc, int fr, int fq) const {
        const int b = u.orow / SEQ; const int col0 = u.pn * BM + wc * 32 + 4 * fq;
        f32x4 gt[2][2];
#pragma unroll
        for (int bj = 0; bj < 2; ++bj)
#pragma unroll
            for (int n = 0; n < 2; ++n) { const int c = col0 + bj * HALF + n * 16; gt[bj][n] = *(const f32x4*)(gc + b * 6144 + c) + *(const f32x4*)(gl + c); }
#pragma unroll
        for (int ai = 0; ai < 2; ++ai)
#pragma unroll
            for (int m = 0; m < 4; ++m) { const size_t off = (size_t)(u.orow + ai * HALF + wr * 64 + m * 16 + fr) * DM + col0;
#pragma unroll
                for (int bj = 0; bj < 2; ++bj)
#pragma unroll
                    for (int n = 0; n < 2; ++n) { const f32x4 x = *(const f32x4*)(xin + off + bj * HALF + n * 16); *(f32x4*)(xout + off + bj * HALF + n * 16) = x + gt[bj][n] * acc[ai][bj][m][n]; } }
    }
};

struct EpiResidNorm {
    static constexpr bool PERM = false;
    const CAS char* ka; unsigned char* ws; LAS unsigned char* lds; int layer, grow, nlayer, nsh, site; bool first, n2;
    DI void operator()(f32x4 (&acc)[2][2][4][2], const Unit& u, int wr, int wc, int fr, int fq) const {
        const CAS char* k2 = ka; unsigned char* w2 = ws; asm volatile("" : "+s"(k2), "+s"(w2));
        const float* xin = first ? *(const float* const CAS*)(k2 + 8 * I_X) : (const float*)*(float* const CAS*)(k2 + 304); float* xout = *(float* const CAS*)(k2 + 304);
        const float* lb = *(const float* const CAS*)(k2 + 8 * I_ADALB); const float* cond = (const float*)(w2 + WS_COND);
        const float* gc = cond + grow * 1024; const float* gl = lb + layer * 6144 + grow * 1024;
        const float* ng = *(const float* const CAS*)(k2 + 8 * (n2 ? I_N2G : I_N1G)) + nlayer * DM; const float* mc = cond + nsh * 1024; const float* ml = lb + nlayer * 6144 + nsh * 1024;
        bf16_t* H = (bf16_t*)(w2 + WS_H); float* slots = (float*)(w2 + WS_LNS) + (size_t)site * 65536; unsigned* cnt = (unsigned*)(w2 + WS_CTL) + CW_LN + site * 4096; unsigned* tmo = (unsigned*)(w2 + WS_CTL) + CW_PAN_TMO;
        const int b = u.orow / SEQ; const int col0 = u.pn * BM + wc * 32 + 4 * fq;
        LAS float* part = (LAS float*)(lds + 131072 + 4096); LAS float* rsv = part + 1024;
        const int wid = wr * 4 + wc, tid = wid * 64 + fq * 16 + fr;
        {
            f32x4 gt[2][2];
#pragma unroll
            for (int bj = 0; bj < 2; ++bj)
#pragma unroll
                for (int n = 0; n < 2; ++n) { const int c = col0 + bj * HALF + n * 16; gt[bj][n] = *(const f32x4*)(gc + b * 6144 + c) + *(const f32x4*)(gl + c); }
#pragma unroll
            for (int ai = 0; ai < 2; ++ai)
#pragma unroll
                for (int m = 0; m < 4; ++m) { const size_t off = (size_t)(u.orow + ai * HALF + wr * 64 + m * 16 + fr) * DM + col0; float ss = 0.f;
#pragma unroll
                    for (int bj = 0; bj < 2; ++bj)
#pragma unroll
                        for (int n = 0; n < 2; ++n) { const f32x4 x = *(const f32x4*)(xin + off + bj * HALF + n * 16); const f32x4 v = x + gt[bj][n] * acc[ai][bj][m][n];
                            *(f32x4*)(xout + off + bj * HALF + n * 16) = v; acc[ai][bj][m][n] = v; ss += v.x * v.x + v.y * v.y + v.z * v.z + v.w * v.w; }
                    ss += shx(ss, 16); ss = shx32_sum(ss);
                    if (fq == 0) part[wc * 256 + ai * HALF + wr * 64 + m * 16 + fr] = ss; }
        }
        asm volatile("s_waitcnt lgkmcnt(0)" ::: "memory"); __builtin_amdgcn_s_barrier(); asm volatile("" ::: "memory");
        unsigned* pc_ = cnt + 64 * u.pm;
        if (tid < 256) { const float p = part[tid] + part[256 + tid] + part[512 + tid] + part[768 + tid];
            const __amdgpu_buffer_rsrc_t rs = __builtin_amdgcn_make_buffer_rsrc((void*)slots, (short)0, -1, 0x00020000);
            __builtin_amdgcn_raw_buffer_store_b32(__float_as_uint(p), rs, tid * 4, (u.pm * 4 + u.pn) * 1024, 16);
            asm volatile("s_waitcnt vmcnt(0)" ::: "memory");
            if ((tid & 63) == 0) (void)__hip_atomic_fetch_add(pc_, 1u, __ATOMIC_RELAXED, __HIP_MEMORY_SCOPE_AGENT); }
        f32x4 scl[2][2], sft[2][2];
#pragma unroll
        for (int bj = 0; bj < 2; ++bj)
#pragma unroll
            for (int n = 0; n < 2; ++n) { const int c = col0 + bj * HALF + n * 16;
                scl[bj][n] = *(const f32x4*)(ng + c) * (1.f + *(const f32x4*)(mc + b * 6144 + 1024 + c) + *(const f32x4*)(ml + 1024 + c)); sft[bj][n] = *(const f32x4*)(mc + b * 6144 + c) + *(const f32x4*)(ml + c); }
        if (wid == 0) { unsigned sp = 0;
            while ((unsigned)__builtin_amdgcn_readfirstlane(__hip_atomic_load(pc_, __ATOMIC_RELAXED, __HIP_MEMORY_SCOPE_AGENT)) < 16u) {
                __builtin_amdgcn_s_sleep(1);
                if (++sp > (1u << 22)) { if ((tid & 63) == 0) __hip_atomic_store(tmo, 1u, __ATOMIC_RELAXED, __HIP_MEMORY_SCOPE_AGENT); break; } }
            __builtin_amdgcn_fence(__ATOMIC_ACQUIRE, "agent");
            asm volatile("s_waitcnt vmcnt(0)" ::: "memory"); }
        asm volatile("" ::: "memory"); __builtin_amdgcn_s_barrier(); asm volatile("" ::: "memory");
        if (tid < 256) { const float* q = slots + (size_t)(u.pm * 4) * 256 + tid; const float tot = q[0] + q[256] + q[512] + q[768];
            rsv[tid] = rsqrtf(tot * (1.f / DM) + 1e-6f); }
        asm volatile("s_waitcnt lgkmcnt(0)" ::: "memory"); __builtin_amdgcn_s_barrier(); asm volatile("" ::: "memory");
#pragma unroll
        for (int ai = 0; ai < 2; ++ai)
#pragma unroll
            for (int m = 0; m < 4; ++m) { const int rl = ai * HALF + wr * 64 + m * 16 + fr; const float r = rsv[rl]; bf16_t* hp = H + (size_t)(u.orow + rl) * DM + col0;
#pragma unroll
                for (int bj = 0; bj < 2; ++bj)
#pragma unroll
                    for (int n = 0; n < 2; ++n) { const f32x4 hv = acc[ai][bj][m][n] * r * scl[bj][n] + sft[bj][n]; u32x2 w; w.x = pk2(hv.x, hv.y); w.y = pk2(hv.z, hv.w); *(u32x2*)(hp + bj * HALF + n * 16) = w; } }
    }
};

template <class Epi, class Sched, bool GATHER, unsigned F8W = 0u  >
DI void gemm_phase(int tid, LAS unsigned char* lds, const bf16_t* A, int lda, int K, const Sched& S, const Epi& E) {
    const int wid = __builtin_amdgcn_readfirstlane(tid >> 6), lane = tid & 63, wr = wid >> 2, wc = wid & 3, fr = lane & 15, fq = lane >> 4;
    const int nt = K / BK;
    unsigned voffA, voffB;
    { int R, C; stage_rc(tid * 16, R, C); const int Rb = Epi::PERM ? ((R & ~31) + perm32(R & 31)) : R; voffA = (unsigned)(R * lda + C) * 2u; voffB = (unsigned)(Rb * K + C) * 2u; }
    const unsigned p1A = 64u * (unsigned)lda * 2u, p1B = 64u * (unsigned)K * 2u;
    const unsigned kstep = (unsigned)(BK * 2);
    const unsigned hstepA = (unsigned)HALF * (unsigned)lda * 2u, hstepB = (unsigned)HALF * (unsigned)K * 2u;
    const __amdgpu_buffer_rsrc_t rsA = __builtin_amdgcn_make_buffer_rsrc((void*)A, (short)0, -1, 0x00020000);
    const __amdgpu_buffer_rsrc_t rsB = __builtin_amdgcn_make_buffer_rsrc((void*)S.bmat(), (short)0, -1, 0x00020000);
    const unsigned ldsw = (unsigned)wid * 1024u;
    const int aoff = lds_byte(wr * 64 + fr, fq * 8), boff = lds_byte(wc * 32 + fr, fq * 8) + 4 * HTB;
#define G8_SA(b, h) (((b) * 2 + (h)) * HTB)
#define G8_SB(b, h) ((4 + (b) * 2 + (h)) * HTB)
#define G8_SBR(b, h) (((b) * 2 + (h)) * HTB)
#define G8_STAGE(bufoff, rs, soff, voff) do { __builtin_amdgcn_raw_ptr_buffer_load_lds(rs, (LAS unsigned*)(lds + (bufoff) + ldsw), 16, (int)(voff), (int)(soff), 0, 0); \
        __builtin_amdgcn_raw_ptr_buffer_load_lds(rs, (LAS unsigned*)(lds + (bufoff) + ldsw + 8192), 16, (int)(voff), (int)((soff) + p1##voff), 0, 0); } while (0)
#define p1voffA p1A
#define p1voffB p1B
#define G8_LDA(dst, b, h) do { if constexpr (F8W != 0u) { _Pragma("unroll") for (int m = 0; m < 4; ++m) dst##8[m] = __builtin_shufflevector(*(const LAS v4i_t*)(lds + G8_SA(b, h) + aoff + m * 2048), *(const LAS v4i_t*)(lds + G8_SA(b, h) + aoff + m * 2048 + 1024), 0, 1, 2, 3, 4, 5, 6, 7); } \
        else { _Pragma("unroll") for (int m = 0; m < 4; ++m) _Pragma("unroll") for (int k = 0; k < 2; ++k) dst[m][k] = *(const LAS bf16x8*)(lds + G8_SA(b, h) + aoff + m * 2048 + k * 1024); } } while (0)
#define G8_LDB(dst, b, h) do { if constexpr (F8W != 0u) { _Pragma("unroll") for (int n = 0; n < 2; ++n) dst##8[n] = __builtin_shufflevector(*(const LAS v4i_t*)(lds + G8_SBR(b, h) + boff + n * 2048), *(const LAS v4i_t*)(lds + G8_SBR(b, h) + boff + n * 2048 + 1024), 0, 1, 2, 3, 4, 5, 6, 7); } \
        else { _Pragma("unroll") for (int n = 0; n < 2; ++n) _Pragma("unroll") for (int k = 0; k < 2; ++k) dst[n][k] = *(const LAS bf16x8*)(lds + G8_SBR(b, h) + boff + n * 2048 + k * 1024); } } while (0)
#define G8_MMA(ai, bj, At, Bt) do { __builtin_amdgcn_s_setprio(1); if constexpr (F8W != 0u) { _Pragma("unroll") for (int m = 0; m < 4; ++m) _Pragma("unroll") for (int n = 0; n < 2; ++n) \
        acc[ai][bj][m][n] = __builtin_amdgcn_mfma_scale_f32_16x16x128_f8f6f4(Bt##8[n], At##8[m], acc[ai][bj][m][n], 0, 0, 0, (int)F8W, 0, (int)F8W); } else { \
        _Pragma("unroll") for (int m = 0; m < 4; ++m) _Pragma("unroll") for (int n = 0; n < 2; ++n) _Pragma("unroll") for (int k = 0; k < 2; ++k) \
        acc[ai][bj][m][n] = __builtin_amdgcn_mfma_f32_16x16x32_bf16(Bt[n][k], At[m][k], acc[ai][bj][m][n], 0, 0, 0); } __builtin_amdgcn_s_setprio(0); } while (0)
#define G8_LDA_H(b, h, mh) do { _Pragma("unroll") for (int m = 0; m < 2; ++m) At8[m] = __builtin_shufflevector(*(const LAS v4i_t*)(lds + G8_SA(b, h) + aoff + ((mh) * 2 + m) * 2048), *(const LAS v4i_t*)(lds + G8_SA(b, h) + aoff + ((mh) * 2 + m) * 2048 + 1024), 0, 1, 2, 3, 4, 5, 6, 7); } while (0)
#define G8_MMA_H(ai, bj, Bt, mh) do { __builtin_amdgcn_s_setprio(1); _Pragma("unroll") for (int m = 0; m < 2; ++m) _Pragma("unroll") for (int n = 0; n < 2; ++n) \
        acc[ai][bj][(mh) * 2 + m][n] = __builtin_amdgcn_mfma_scale_f32_16x16x128_f8f6f4(Bt##8[n], At8[m], acc[ai][bj][(mh) * 2 + m][n], 0, 0, 0, (int)F8W, 0, (int)F8W); __builtin_amdgcn_s_setprio(0); } while (0)
#define G8_WAIT_V(n) asm volatile("s_waitcnt vmcnt(" #n ")" ::: "memory")
#define G8_WAIT_L(n) asm volatile("s_waitcnt lgkmcnt(" #n ")" ::: "memory")
#define G8_BAR __builtin_amdgcn_s_barrier()
#define G8_SCHED __builtin_amdgcn_sched_barrier(0)
    Unit cur, nxt; int ui = 0;
    if (!S.next(0, cur)) return;
    f32x4 acc[2][2][4][2]; const float z0 = ozero();
#pragma unroll
    for (int a = 0; a < 2; ++a)
#pragma unroll
        for (int b = 0; b < 2; ++b)
#pragma unroll
            for (int m = 0; m < 4; ++m)
#pragma unroll
                for (int n = 0; n < 2; ++n) acc[a][b][m][n] = (f32x4){z0, z0, z0, z0};
    bf16x8 At[4][2], B0[2][2], B1[2][2]; v8i_t At8[4], B08[2], B18[2];
    unsigned cA = 0u;
    LAS unsigned* gtab = (LAS unsigned*)(lds + STAGE_BYTES + 4096) + tid * 4;
#define G8_GOFF(p, unit) do { u32x4 o_; { int R_, C_; stage_rc(tid * 16, R_, C_); o_.x = S.arow(unit, R_) + (unsigned)C_ * 2u; o_.z = S.arow(unit, HALF + R_) + (unsigned)C_ * 2u; } \
        { int R_, C_; stage_rc(tid * 16 + 8192, R_, C_); o_.y = S.arow(unit, R_) + (unsigned)C_ * 2u; o_.w = S.arow(unit, HALF + R_) + (unsigned)C_ * 2u; } *(LAS u32x4*)(gtab + (p) * 2048) = o_; } while (0)
#define G8_STAGE_G(bufoff, soff, p, h) do { const u32x2 v_ = *(const LAS u32x2*)(gtab + (p) * 2048 + (h) * 2); \
        __builtin_amdgcn_raw_ptr_buffer_load_lds(rsA, (LAS unsigned*)(lds + (bufoff) + ldsw), 16, (int)v_.x, (int)(soff), 0, 0); \
        __builtin_amdgcn_raw_ptr_buffer_load_lds(rsA, (LAS unsigned*)(lds + (bufoff) + ldsw + 8192), 16, (int)v_.y, (int)(soff), 0, 0); } while (0)
    if constexpr (GATHER) { G8_GOFF(0, cur); cA = 0u; } else { cA = S.aoffs(cur); }
    unsigned cB = S.boffs(cur);
#define G8_STA_C(bufoff, h, kb) do { if constexpr (GATHER) { G8_STAGE_G(bufoff, cA + (kb), ui & 1, h); } else { G8_STAGE(bufoff, rsA, cA + (h) * hstepA + (kb), voffA); } } while (0)
    G8_STAGE(G8_SB(0, 0), rsB, cB, voffB); G8_STAGE(G8_SB(0, 1), rsB, cB + hstepB, voffB); G8_STA_C(G8_SA(0, 0), 0, 0); G8_STA_C(G8_SA(0, 1), 1, 0);
    if (wr == 1) G8_BAR;
    G8_WAIT_V(2); G8_BAR;
    G8_STAGE(G8_SB(1, 0), rsB, cB + kstep, voffB); G8_STA_C(G8_SA(1, 0), 0, kstep); G8_STAGE(G8_SB(1, 1), rsB, cB + hstepB + kstep, voffB);
    G8_WAIT_V(6); G8_BAR;
    for (;;) {
        const bool has_next = S.next(ui + 1, nxt);
        unsigned nA = cA; const unsigned nB = has_next ? S.boffs(nxt) : cB;
        if constexpr (GATHER) { if (has_next) { G8_GOFF((ui + 1) & 1, nxt); } else { G8_GOFF((ui + 1) & 1, cur); } } else { nA = has_next ? S.aoffs(nxt) : cA; }
#pragma nounroll
        for (int t = 0; t < nt; t += 2) {
            const bool last = (t == nt - 2);
            const unsigned k1 = (unsigned)(t + 1) * kstep;
            const unsigned b2 = last ? nB : cB + (unsigned)(t + 2) * kstep; const unsigned b3 = b2 + kstep;
            unsigned a2 = 0u;
            if constexpr (GATHER) { a2 = last ? cA : cA + (unsigned)(t + 2) * kstep; } else { a2 = last ? nA : cA + (unsigned)(t + 2) * kstep; }
            const unsigned a3 = a2 + kstep;
#define G8_STA_2(bufoff, h, base) do { if constexpr (GATHER) { G8_STAGE_G(bufoff, base, (ui + (last ? 1 : 0)) & 1, h); } else { G8_STAGE(bufoff, rsA, (base) + (h) * hstepA, voffA); } } while (0)
            G8_LDB(B0, 0, 0); G8_LDB(B1, 0, 1); G8_SCHED; G8_LDA(At, 0, 0); G8_STA_C(G8_SA(1, 1), 1, k1);
            G8_WAIT_V(8); G8_WAIT_L(0); G8_BAR; G8_MMA(0, 0, At, B0); G8_MMA(0, 1, At, B1); G8_BAR; G8_SCHED;
            G8_LDA(At, 0, 1); G8_STAGE(G8_SB(0, 0), rsB, b2, voffB); G8_STAGE(G8_SB(0, 1), rsB, b2 + hstepB, voffB); G8_STA_2(G8_SA(0, 0), 0, a2);
            G8_WAIT_V(8); G8_WAIT_L(0); G8_BAR; G8_MMA(1, 0, At, B0); G8_MMA(1, 1, At, B1); G8_BAR; G8_SCHED;
            G8_LDB(B0, 1, 0); G8_LDB(B1, 1, 1); G8_SCHED; G8_LDA(At, 1, 0); G8_STA_2(G8_SA(0, 1), 1, a2);
            G8_WAIT_V(8); G8_WAIT_L(0); G8_BAR; G8_MMA(0, 0, At, B0); G8_MMA(0, 1, At, B1); G8_BAR; G8_SCHED;
            G8_LDA(At, 1, 1); G8_STAGE(G8_SB(1, 0), rsB, b3, voffB); G8_STAGE(G8_SB(1, 1), rsB, b3 + hstepB, voffB); G8_STA_2(G8_SA(1, 0), 0, a3);
            G8_WAIT_V(8); G8_WAIT_L(0); G8_BAR; G8_MMA(1, 0, At, B0); G8_MMA(1, 1, At, B1); G8_BAR; G8_SCHED;
#undef G8_STA_2
        }
        if (wr == 0) G8_BAR;
        { int te = tid; asm volatile("" : "+v"(te)); const int fre = te & 15, fqe = (te & 63) >> 4;
          E(acc, cur, wr, wc, fre, fqe); }
        if (!has_next) break;
#pragma unroll
        for (int a = 0; a < 2; ++a)
#pragma unroll
            for (int b = 0; b < 2; ++b)
#pragma unroll
                for (int m = 0; m < 4; ++m)
#pragma unroll
                    for (int n = 0; n < 2; ++n) acc[a][b][m][n] = (f32x4){z0, z0, z0, z0};
        cur = nxt; cB = nB; ++ui;
        if constexpr (!GATHER) { cA = nA; }
        if (wr == 1) G8_BAR;
    }
    G8_WAIT_V(0);
    G8_BAR;
#undef G8_STA_C
#undef G8_GOFF
#undef G8_STAGE_G
#undef G8_SA
#undef G8_SB
#undef G8_SBR
#undef G8_STAGE
#undef p1voffA
#undef p1voffB
#undef G8_LDA
#undef G8_LDB
#undef G8_MMA
#undef G8_MMA_H
#undef G8_LDA_H
#undef G8_WAIT_V
#undef G8_WAIT_L
#undef G8_BAR
#undef G8_SCHED
}

struct DenseOrder {
    const char* A; const char* Bt; int lda, K, nM, nN, nwg, G, c;
    DI void init(const bf16_t* A_, int lda_, const bf16_t* Bt_, int K_, int M_, int N_, int G_, int c_) { A = (const char*)A_; Bt = (const char*)Bt_; lda = lda_; K = K_; nM = M_ / BM; nN = N_ / BM; nwg = nM * nN; G = G_; c = c_; }
    DI bool next(int i, Unit& u) const {
        const long L = (long)i * G + c; if (L >= nwg) return false;
        int wgid = (int)L; { const int q = nwg / 8, r = nwg % 8, xcd = wgid % 8, off = wgid / 8; wgid = (xcd < r ? xcd * (q + 1) : r * (q + 1) + (xcd - r) * q) + off; }
        const int nig = 8 * nN, gid = wgid / nig, fm = gid * 8, gsz = (nM - fm) < 8 ? (nM - fm) : 8;
        u.pm = fm + ((wgid % nig) % gsz); u.pn = (wgid % nig) / gsz; u.orow = u.pm * BM; u.e = 0; return true;
    }
    DI unsigned aoffs(const Unit& u) const { return (unsigned)u.pm * (unsigned)(BM * 2) * (unsigned)lda; }
    DI unsigned boffs(const Unit& u) const { return (unsigned)u.pn * (unsigned)(BM * 2) * (unsigned)K; }
    DI const char* bmat() const { return Bt; }
    DI unsigned arow(const Unit&, int) const { return 0u; }
};
}

constexpr int TAB_OFF = 131072 + 1024;
DI void moe_tables(const Ctx& C, const unsigned* cnt, int gran) {
    __syncthreads();
    if (C.tid == 0) { LAS int* tst = (LAS int*)(C.lds + TAB_OFF); LAS int* pst = tst + 16; int a1 = 0, a2 = 0;
        for (int e = 0; e < 8; ++e) { const int c = (int)cnt[e]; tst[e] = a1; pst[e] = a2; a1 += (c + gran - 1) / gran; a2 += (c + 255) / 256 * 256; }
        tst[8] = a1; }
    __syncthreads();
}

namespace g8 {
struct MoeOrder {
    const int* ltok; const unsigned* cnt; const LAS int* tst; const LAS int* pst; const char* A; const char* Bt; size_t bstride; int lda, K, nN, nU, G, c; bool xs;
    DI void init(const Ctx& C, const unsigned* cnt_, const char* A_, int lda_, const char* Bt_, size_t bstride_, int K_, int N_) {
        ltok = (const int*)(C.ws + WS_MOE + MOE_LTOK); cnt = cnt_; tst = (const LAS int*)(C.lds + TAB_OFF); pst = tst + 16; A = A_; Bt = Bt_; bstride = bstride_; lda = lda_; K = K_; nN = N_ / BM; xs = false;
        nU = tst[8] * nN; G = gridDim.x; c = blockIdx.x; }
    DI bool next(int i, Unit& u) const {
        const int L = i * G + c; if (L >= nU) return false;
        const int tile = L / nN; int e = 0;
#pragma unroll
        for (int q = 1; q < 8; ++q) if (tile >= tst[q]) e = q;
        e = __builtin_amdgcn_readfirstlane(e);
        u.e = e; u.pm = tile - tst[e]; u.pn = L % nN; u.orow = pst[e] + u.pm * BM; return true;
    }
    DI unsigned arow(const Unit& u, int lr) const { const int r = u.pm * BM + lr; const int tok = (r < (int)cnt[u.e]) ? ltok[u.e * 16384 + r] : 0; return (unsigned)tok * (unsigned)lda * 2u; }
    DI unsigned aoffs(const Unit& u) const { return (xs ? (unsigned)(u.e * 16384 + u.pm * BM) : (unsigned)u.orow) * (unsigned)lda * 2u; }
    DI unsigned boffs(const Unit& u) const { return (unsigned)u.e * (unsigned)bstride + (unsigned)u.pn * (unsigned)(BM * 2) * (unsigned)K; }
    DI const char* bmat() const { return Bt; }
};

struct FUnit { int ty, tile, pm, pn, orow, e; };
struct MoeFusedOrder {
    const LAS int* tst; const LAS int* pst; int nGu, nDn, G, c, RA, rr, H; bool plain; unsigned gu_b, dn_b;
    DI void init(const Ctx& C, int fi) { tst = (const LAS int*)(C.lds + TAB_OFF); pst = tst + 16; nGu = tst[8] * 28; nDn = tst[8] * 4; G = gridDim.x; c = blockIdx.x;
        gu_b = (unsigned)(WS_MGU + (size_t)fi * NE * 2 * MFF * DM); dn_b = (unsigned)(WS_MD + (size_t)fi * NE * DM * MFF);
        const int kmax = (nDn + G - 1) / G; H = nDn - (kmax - 1) * G; plain = (H >= G) || (nGu < 3 * (G - H) + G); RA = 0; rr = 0;
        if (!plain) { RA = (nGu - 3 * (G - H)) / G; rr = nGu - 3 * (G - H) - RA * G; } }
    DI bool next(int i, FUnit& u) const {
        int L, nn = 28; u.ty = 0;
        if (plain) { const int Lc = i * G + c; if (Lc < nGu) L = Lc; else { L = Lc - nGu; if (L >= nDn) return false; nn = 4; u.ty = 1; } }
        else { int k = i;
            if (k < RA) L = k * G + c;
            else { k -= RA; const int nC = (c < rr) ? 1 : 0, nB = (c >= H) ? 3 : 0;
                if (k < nC) L = RA * G + c;
                else { k -= nC;
                    if (k < nB) L = RA * G + rr + (c - H) + k * (G - H);
                    else { k -= nB; L = c + G * k; if (L >= nDn) return false; nn = 4; u.ty = 1; } } } }
        const int tile = L / nn; int e = 0;
#pragma unroll
        for (int q = 1; q < 8; ++q) if (tile >= tst[q]) e = q;
        e = __builtin_amdgcn_readfirstlane(e);
        u.tile = tile; u.e = e; u.pm = tile - tst[e]; u.pn = L - tile * nn; u.orow = pst[e] + u.pm * BM; return true;
    }
    DI unsigned pitch(const FUnit& u) const { return u.ty ? (unsigned)MFF : (unsigned)DM; }
    DI unsigned aoffs(const FUnit& u) const { return u.ty ? (unsigned)WS_ACT + (unsigned)u.orow * (unsigned)MFF : (unsigned)WS_XS8 + (unsigned)(u.e * 16384 + u.pm * BM) * (unsigned)DM; }
    DI unsigned boffs(const FUnit& u) const { return u.ty ? dn_b + (unsigned)u.e * (unsigned)(DM * MFF) + (unsigned)u.pn * (unsigned)(BM * MFF) : gu_b + (unsigned)u.e * (unsigned)(2 * MFF * DM) + (unsigned)u.pn * (unsigned)(BM * DM); }
};
constexpr unsigned FUSED_NEED = 28u * 8u;
DI void fused_a_ready(const FUnit& u, unsigned* pan, int wid, int lane, unsigned* tmo) {
    if (u.ty == 1) {
        if (wid == 0) { unsigned* w = pan + 64 * u.tile; unsigned sp = 0;
            while ((unsigned)__builtin_amdgcn_readfirstlane(__hip_atomic_load(w, __ATOMIC_RELAXED, __HIP_MEMORY_SCOPE_AGENT)) < FUSED_NEED) {
                __builtin_amdgcn_s_sleep(2);
                if (++sp > (1u << 22)) { if (lane == 0) __hip_atomic_store(tmo, 1u, __ATOMIC_RELAXED, __HIP_MEMORY_SCOPE_AGENT); break; } }
            __builtin_amdgcn_fence(__ATOMIC_ACQUIRE, "agent");
            asm volatile("s_waitcnt vmcnt(0)" ::: "memory"); }
        asm volatile("" ::: "memory"); __builtin_amdgcn_s_barrier(); asm volatile("" ::: "memory");
    }
}
template <unsigned F8W>
DI void gemm_moe_fused(int tid, LAS unsigned char* lds, const unsigned char* ws, const MoeFusedOrder& S, const EpiGlu8T<16>& E1, const EpiStoreB& E2, unsigned* pan, unsigned* tmo) {
    const int wid = __builtin_amdgcn_readfirstlane(tid >> 6), lane = tid & 63, wr = wid >> 2, wc = wid & 3;
#define GF_VOFF(pit, va, vb) do { int t_ = tid; asm volatile("" : "+v"(t_)); int R_, C_; stage_rc(t_ * 16, R_, C_); const int Rb_ = (R_ & ~31) + perm32(R_ & 31); \
        va = (unsigned)R_ * (pit) + (unsigned)C_ * 2u; vb = (unsigned)Rb_ * (pit) + (unsigned)C_ * 2u; } while (0)
    const unsigned kstep = (unsigned)(BK * 2);
    const __amdgpu_buffer_rsrc_t rs = __builtin_amdgcn_make_buffer_rsrc((void*)ws, (short)0, -1, 0x00020000);
    const unsigned ldsw = (unsigned)wid * 1024u;
    const int fr0 = lane & 15, fq0 = lane >> 4;
    const int aoff = lds_byte(wr * 64 + fr0, fq0 * 8), boff = lds_byte(wc * 32 + fr0, fq0 * 8) + 4 * HTB;
#define GF_SA(b, h) (((b) * 2 + (h)) * HTB)
#define GF_SB(b, h) ((4 + (b) * 2 + (h)) * HTB)
#define GF_SBR(b, h) (((b) * 2 + (h)) * HTB)
#define GF_STAGE(bufoff, soff, voff, pit) do { __builtin_amdgcn_raw_ptr_buffer_load_lds(rs, (LAS unsigned*)(lds + (bufoff) + ldsw), 16, (int)(voff), (int)(soff), 0, 0); \
        __builtin_amdgcn_raw_ptr_buffer_load_lds(rs, (LAS unsigned*)(lds + (bufoff) + ldsw + 8192), 16, (int)(voff), (int)((soff) + 64u * (pit)), 0, 0); } while (0)
#define GF_LDA(b, h) do { _Pragma("unroll") for (int m = 0; m < 4; ++m) At8[m] = __builtin_shufflevector(*(const LAS v4i_t*)(lds + GF_SA(b, h) + aoff + m * 2048), *(const LAS v4i_t*)(lds + GF_SA(b, h) + aoff + m * 2048 + 1024), 0, 1, 2, 3, 4, 5, 6, 7); } while (0)
#define GF_LDB(dst, b, h) do { _Pragma("unroll") for (int n = 0; n < 2; ++n) dst[n] = __builtin_shufflevector(*(const LAS v4i_t*)(lds + GF_SBR(b, h) + boff + n * 2048), *(const LAS v4i_t*)(lds + GF_SBR(b, h) + boff + n * 2048 + 1024), 0, 1, 2, 3, 4, 5, 6, 7); } while (0)
#define GF_MMA(ai, bj, Bt) do { __builtin_amdgcn_s_setprio(1); _Pragma("unroll") for (int m = 0; m < 4; ++m) _Pragma("unroll") for (int n = 0; n < 2; ++n) \
        acc[ai][bj][m][n] = __builtin_amdgcn_mfma_scale_f32_16x16x128_f8f6f4(Bt[n], At8[m], acc[ai][bj][m][n], 0, 0, 0, (int)F8W, 0, (int)F8W); __builtin_amdgcn_s_setprio(0); } while (0)
#define GF_WAIT_V(n) asm volatile("s_waitcnt vmcnt(" #n ")" ::: "memory")
#define GF_WAIT_L(n) asm volatile("s_waitcnt lgkmcnt(" #n ")" ::: "memory")
#define GF_BAR __builtin_amdgcn_s_barrier()
#define GF_SCHED __builtin_amdgcn_sched_barrier(0)
    FUnit cur, nxt; int ui = 0;
    if (!S.next(0, cur)) return;
    f32x4 acc[2][2][4][2]; const float z0 = ozero();
#pragma unroll
    for (int a = 0; a < 2; ++a)
#pragma unroll
        for (int b = 0; b < 2; ++b)
#pragma unroll
            for (int m = 0; m < 4; ++m)
#pragma unroll
                for (int n = 0; n < 2; ++n) acc[a][b][m][n] = (f32x4){z0, z0, z0, z0};
    v8i_t At8[4], B08[2], B18[2];
    int pend = -1;
#define GF_PUBLISH() do { if (pend >= 0) { asm volatile("s_waitcnt vmcnt(0)" ::: "memory"); if (lane == 0) (void)__hip_atomic_fetch_add(pan + 64 * pend, 1u, __ATOMIC_RELAXED, __HIP_MEMORY_SCOPE_AGENT); pend = -1; } } while (0)
    unsigned pc = S.pitch(cur), cA = S.aoffs(cur), cB = S.boffs(cur);
    unsigned vA, vB; GF_VOFF(pc, vA, vB);
    fused_a_ready(cur, pan, wid, lane, tmo);
    GF_STAGE(GF_SB(0, 0), cB, vB, pc); GF_STAGE(GF_SB(0, 1), cB + 128u * pc, vB, pc); GF_STAGE(GF_SA(0, 0), cA, vA, pc); GF_STAGE(GF_SA(0, 1), cA + 128u * pc, vA, pc);
    if (wr == 1) GF_BAR;
    GF_WAIT_V(2); GF_BAR;
    GF_STAGE(GF_SB(1, 0), cB + kstep, vB, pc); GF_STAGE(GF_SA(1, 0), cA + kstep, vA, pc); GF_STAGE(GF_SB(1, 1), cB + 128u * pc + kstep, vB, pc);
    GF_WAIT_V(6); GF_BAR;
    for (;;) {
        const bool has_next = S.next(ui + 1, nxt);
        const unsigned pnx = has_next ? S.pitch(nxt) : pc, nA = has_next ? S.aoffs(nxt) : cA, nB = has_next ? S.boffs(nxt) : cB;
        const int nt = (int)(pc >> 7); unsigned ps = pc;
#pragma nounroll
        for (int t = 0; t < nt; t += 2) {
            const bool last = (t == nt - 2);
            if (last && has_next && nxt.ty == 1) { GF_PUBLISH(); fused_a_ready(nxt, pan, wid, lane, tmo); }
            const unsigned k1 = (unsigned)(t + 1) * kstep;
            const unsigned b2 = last ? nB : cB + (unsigned)(t + 2) * kstep, b3 = b2 + kstep, a2 = last ? nA : cA + (unsigned)(t + 2) * kstep, a3 = a2 + kstep;
            GF_LDB(B08, 0, 0); GF_LDB(B18, 0, 1); GF_SCHED; GF_LDA(0, 0); GF_STAGE(GF_SA(1, 1), cA + 128u * pc + k1, vA, pc);
            if (last && has_next && pnx != pc) { ps = pnx; GF_VOFF(ps, vA, vB); }
            GF_WAIT_V(8); GF_WAIT_L(0); GF_BAR; GF_MMA(0, 0, B08); GF_MMA(0, 1, B18); GF_BAR; GF_SCHED;
            GF_LDA(0, 1); GF_STAGE(GF_SB(0, 0), b2, vB, ps); GF_STAGE(GF_SB(0, 1), b2 + 128u * ps, vB, ps); GF_STAGE(GF_SA(0, 0), a2, vA, ps);
            GF_WAIT_V(8); GF_WAIT_L(0); GF_BAR; GF_MMA(1, 0, B08); GF_MMA(1, 1, B18); GF_BAR; GF_SCHED;
            GF_LDB(B08, 1, 0); GF_LDB(B18, 1, 1); GF_SCHED; GF_LDA(1, 0); GF_STAGE(GF_SA(0, 1), a2 + 128u * ps, vA, ps);
            GF_WAIT_V(8); GF_WAIT_L(0); GF_BAR; GF_MMA(0, 0, B08); GF_MMA(0, 1, B18); GF_BAR; GF_SCHED;
            GF_LDA(1, 1); GF_STAGE(GF_SB(1, 0), b3, vB, ps); GF_STAGE(GF_SB(1, 1), b3 + 128u * ps, vB, ps); GF_STAGE(GF_SA(1, 0), a3, vA, ps);
            GF_WAIT_V(8); GF_WAIT_L(0); GF_BAR; GF_MMA(1, 0, B08); GF_MMA(1, 1, B18); GF_BAR; GF_SCHED;
        }
        if (wr == 0) GF_BAR;
        { int te = tid; asm volatile("" : "+v"(te)); const int fre = te & 15, fqe = (te & 63) >> 4;
          Unit uu; uu.pm = cur.pm; uu.pn = cur.pn; uu.orow = cur.orow; uu.e = cur.e;
          GF_PUBLISH();
          if (cur.ty == 0) { E1(acc, uu, wr, wc, fre, fqe); pend = cur.tile; if (!has_next || nxt.ty == 1) GF_PUBLISH(); }
          else E2(acc, uu, wr, wc, fre, fqe); }
        if (!has_next) break;
#pragma unroll
        for (int a = 0; a < 2; ++a)
#pragma unroll
            for (int b = 0; b < 2; ++b)
#pragma unroll
                for (int m = 0; m < 4; ++m)
#pragma unroll
                    for (int n = 0; n < 2; ++n) acc[a][b][m][n] = (f32x4){z0, z0, z0, z0};
        cur = nxt; cA = nA; cB = nB; pc = pnx; ++ui;
        if (wr == 1) GF_BAR;
    }
    GF_PUBLISH();
    GF_WAIT_V(0);
    GF_BAR;
#undef GF_PUBLISH
#undef GF_SA
#undef GF_SB
#undef GF_SBR
#undef GF_STAGE
#undef GF_VOFF
#undef GF_LDA
#undef GF_LDB
#undef GF_MMA
#undef GF_WAIT_V
#undef GF_WAIT_L
#undef GF_BAR
#undef GF_SCHED
}
}

DI void phase_conv(Ctx C, int layer) {
    const bf16_t* U = (const bf16_t*)(C.ws + WS_U); bf16_t* MX = (bf16_t*)(C.ws + WS_MIXED);
    LAS float* z = (LAS float*)C.lds;
    const int ch = C.tid & 255, half = C.tid >> 8;
    float w[CONVK];
#pragma unroll
    for (int i = 0; i < CONVK; ++i) w[i] = INF(I_CONVW)[(size_t)layer * CONVK * CONVC + i * CONVC + ch];
    const float bias = INF(I_CONVB)[layer * CONVC + ch];
    for (int it = blockIdx.x; it < M / 64; it += gridDim.x) {
        const int b = it / (SEQ / 64), t0 = (it % (SEQ / 64)) * 64;
        __syncthreads();
        { u32x4 ra[6], rg[6];
#pragma unroll
          for (int q = 0; q < 6; ++q) { const int p = C.tid + q * NTHREADS; const int i = p >> 5, c8 = (p & 31) * 8, t = t0 - 30 + i;
              if (p < 94 * 32 && t >= 0) { const size_t m = (size_t)b * SEQ + t; ra[q] = *(const u32x4*)(U + m * INCP + c8); rg[q] = *(const u32x4*)(U + m * INCP + 256 + c8); }
              else { ra[q] = (u32x4){0u, 0u, 0u, 0u}; rg[q] = (u32x4){0u, 0u, 0u, 0u}; } }
#pragma unroll
          for (int q = 0; q < 6; ++q) { const int p = C.tid + q * NTHREADS; const int i = p >> 5, c8 = (p & 31) * 8;
              if (p < 94 * 32) { float a[8], g[8], zz[8]; unpack8(ra[q], a); unpack8(rg[q], g);
#pragma unroll
                  for (int e = 0; e < 8; ++e) zz[e] = a[e] * fsigmoid(g[e]);
                  *(LAS f32x4*)(z + i * 256 + c8) = (f32x4){zz[0], zz[1], zz[2], zz[3]}; *(LAS f32x4*)(z + i * 256 + c8 + 4) = (f32x4){zz[4], zz[5], zz[6], zz[7]}; } } }
        __syncthreads();
        float o[32];
        { float zr[62];
#pragma unroll
          for (int i = 0; i < 62; ++i) zr[i] = z[(half * 32 + i) * 256 + ch];
#pragma unroll
          for (int tt = 0; tt < 32; ++tt) { float acc = bias;
#pragma unroll
              for (int i = 0; i < CONVK; ++i) acc += zr[tt + i] * w[i];
              o[tt] = acc; } }
        __syncthreads();
#pragma unroll
        for (int tt = 0; tt < 32; ++tt) z[(half * 32 + tt) * 256 + ch] = o[tt];
        __syncthreads();
        for (int tt = C.wave * 8; tt < C.wave * 8 + 8; ++tt) {
            const f32x4 v = *(const LAS f32x4*)(z + tt * 256 + C.lane * 4);
            const float mean = wave_sum(v.x + v.y + v.z + v.w) * (1.f / 256.f);
            const f32x4 d = v - mean;
            const float var = wave_sum(d.x * d.x + d.y * d.y + d.z * d.z + d.w * d.w) * (1.f / 256.f);
            const float rs = rsqrtf(var + 1e-5f);
            const f32x4 lg = *(const f32x4*)(INF(I_CONVLG) + layer * 256 + C.lane * 4), lb = *(const f32x4*)(INF(I_CONVLB) + layer * 256 + C.lane * 4);
            f32x4 y = d * rs * lg + lb;
            u32x2 o2; o2.x = pk2(siluf_(y.x), siluf_(y.y)); o2.y = pk2(siluf_(y.z), siluf_(y.w));
            *(u32x2*)(MX + ((size_t)b * SEQ + t0 + tt) * DM + C.lane * 4) = o2;
        }
    }
    __syncthreads();
}

DI void phase_prep1(Ctx C, int layer) {
    bf16_t* U = (bf16_t*)(C.ws + WS_U);
    bf16_t* RR = (bf16_t*)(C.ws + WS_RR); bf16_t* RK = (bf16_t*)(C.ws + WS_RK); bf16_t* RV = (bf16_t*)(C.ws + WS_RV); bf16_t* RKK = (bf16_t*)(C.ws + WS_RKK); bf16_t* LIN = (bf16_t*)(C.ws + WS_LIN);
    const int l = C.lane;
    float mu[16], kkw[16];
    { const float* mup = INF(I_RMU) + layer * 1024 + l * 16;
#pragma unroll
      for (int i = 0; i < 16; i += 4) { const f32x4 t4 = ld4(mup + i); mu[i] = t4.x; mu[i + 1] = t4.y; mu[i + 2] = t4.z; mu[i + 3] = t4.w; }
      const float* kp = INF(I_RKK) + layer * RC + ((l >= 16 && l < 32) ? (l - 16) * 16 : 0);
#pragma unroll
      for (int i = 0; i < 16; i += 4) { const f32x4 t4 = ld4(kp + i); kkw[i] = t4.x; kkw[i + 1] = t4.y; kkw[i + 2] = t4.z; kkw[i + 3] = t4.w; } }
    const f32x4 gq = ld4(INF(I_QNG) + layer * 256 + l * 4); const f32x2 gkv = *(const f32x2*)(INF(I_KVNG) + layer * 128 + l * 2);
    const int rpw = (M + C.NGW - 1) / C.NGW, m0 = C.gw * rpw, m1 = (m0 + rpw < M) ? m0 + rpw : M;
    bf16_t* dst0 = (l < 16) ? RR + l * 16 : (l < 32) ? RK + (l - 16) * 16 : (l < 48) ? RV + (l - 32) * 16 : LIN + (l - 48) * 16; const int dpitch = RC;
    const bool actraw = (l >= 52 && l < 56); const float acta = (l < 52) ? 2.f : 1.f, actb = (l < 52) ? 2.f : 1.f, actc = (l < 52) ? -1.f : 0.f;
    float prv[16];
    u32x4 nr0, nr1; u32x2 nq; unsigned nkv;
    if (m0 < m1) { const bf16_t* rw = U + (size_t)m0 * INCP; nr0 = *(const u32x4*)(rw + U_RW + l * 16); nr1 = *(const u32x4*)(rw + U_RW + l * 16 + 8); nq = *(const u32x2*)(rw + U_CQ + l * 4); nkv = *(const unsigned*)(rw + U_CKV + l * 2); }
    for (int m = m0; m < m1; ++m) {
        bf16_t* row = U + (size_t)m * INCP;
        float cur[16]; unpack8(nr0, cur); unpack8(nr1, cur + 8);
        const u32x2 w = nq; const unsigned w2 = nkv;
        if (m + 1 < m1) { const bf16_t* rw = row + INCP; nr0 = *(const u32x4*)(rw + U_RW + l * 16); nr1 = *(const u32x4*)(rw + U_RW + l * 16 + 8); nq = *(const u32x2*)(rw + U_CQ + l * 4); nkv = *(const unsigned*)(rw + U_CKV + l * 2); }
        if (m == m0) { if (m % SEQ != 0) { unpack8(*(const u32x4*)(row - INCP + U_RW + l * 16), prv); unpack8(*(const u32x4*)(row - INCP + U_RW + l * 16 + 8), prv + 8); } }
        if (m % SEQ == 0) {
#pragma unroll
            for (int i = 0; i < 16; ++i) prv[i] = 0.f; }
        { const float v0 = bflo(w.x), v1 = bfhi(w.x), v2 = bflo(w.y), v3 = bfhi(w.y);
          const float c0 = bflo(w2), c1 = bfhi(w2);
          float sq = v0 * v0 + v1 * v1 + v2 * v2 + v3 * v3, sk = c0 * c0 + c1 * c1;
#pragma unroll
          for (int o = 1; o < 32; o <<= 1) { sq += shx(sq, o); sk += shx(sk, o); }
          sq = shx32_sum(sq); sk = shx32_sum(sk);
          const float rq = rsqrtf(sq * (1.f / 256.f) + 1e-6f), rk = rsqrtf(sk * (1.f / 128.f) + 1e-6f);
          u32x2 o; o.x = pk2(v0 * rq * gq.x, v1 * rq * gq.y); o.y = pk2(v2 * rq * gq.z, v3 * rq * gq.w); *(u32x2*)(row + U_CQ + l * 4) = o;
          *(unsigned*)(row + U_CKV + l * 2) = pk2(c0 * rk * gkv.x, c1 * rk * gkv.y); }
        float uf[16];
#pragma unroll
        for (int i = 0; i < 16; ++i) { uf[i] = cur[i] + (prv[i] - cur[i]) * mu[i]; prv[i] = cur[i]; }
        float kk[16]; float ss = 0.f;
#pragma unroll
        for (int i = 0; i < 16; ++i) { kk[i] = uf[i] * kkw[i]; ss += kk[i] * kk[i]; }
        ss += shx(ss, 1); ss += shx(ss, 2);
        const float inrm = 1.f / fmaxf(sqrtf(ss), 1e-12f);
        if (l >= 48) {
#pragma unroll
            for (int i = 0; i < 16; ++i) { const float sg = __builtin_amdgcn_rcpf(1.f + __expf(-actb * uf[i])); uf[i] = actraw ? uf[i] : acta * sg + actc; } }
        *(u32x4*)(dst0 + (size_t)m * dpitch) = pack8(uf); *(u32x4*)(dst0 + (size_t)m * dpitch + 8) = pack8(uf + 8);
        if (l >= 16 && l < 32) {
#pragma unroll
            for (int i = 0; i < 16; ++i) kk[i] *= inrm;
            *(u32x4*)(RKK + (size_t)m * RC + (l - 16) * 16) = pack8(kk); *(u32x4*)(RKK + (size_t)m * RC + (l - 16) * 16 + 8) = pack8(kk + 8); }
    }
}

namespace g8 {
struct UpOrder {
    int layer, G, c;
    DI bool next(int i, Unit& u) const {
        const int L = i * G + c; if (L >= 640) return false;
        if (L < 256) { u.e = 1; u.pm = L & 63; u.pn = L >> 6; }
        else if (L < 448) { const int q = L - 256; u.e = 0; u.pm = q & 63; u.pn = q >> 6; }
        else { const int q = L - 448; u.e = 2; u.pm = q & 63; u.pn = q >> 6; }
        u.orow = u.pm * BM; return true;
    }
    DI unsigned arow(const Unit& u, int lr) const {
        const unsigned r = (unsigned)(u.pm * BM + lr);
        return (u.e == 2) ? (unsigned)WS_LIN + r * 512u : (unsigned)WS_U + r * (unsigned)(INCP * 2) + (unsigned)((u.e == 0 ? U_CQ : U_CKV) * 2);
    }
    DI unsigned aoffs(const Unit&) const { return 0u; }
    DI size_t boff(const Unit& u) const {
        return (u.e == 0 ? WS_WUQ + (size_t)layer * 768 * 256 * 2 : u.e == 1 ? WS_WUKV + (size_t)layer * 1024 * 256 * 2 : WS_LORA + (size_t)layer * 768 * 256 * 2) + (size_t)u.pn * BM * 256 * 2;
    }
    const char* ws;
    DI unsigned boffs(const Unit& u) const { return (unsigned)boff(u); }
    DI const char* bmat() const { return ws; }
};
struct EpiStore3 {
    static constexpr bool PERM = true;
    unsigned char* ws;
    DI void operator()(const f32x4 (&acc)[2][2][4][2], const Unit& u, int wr, int wc, int fr, int fq) const {
        const int ldc = (u.e == 1) ? 1024 : 768;
        bf16_t* O = (bf16_t*)(ws + (u.e == 0 ? WS_QRAW : u.e == 1 ? WS_KVRAW : WS_LOUT));
        EpiStore E{O, ldc}; E(acc, u, wr, wc, fr, fq);
    }
};
}
DI void phase_upgemms(Ctx C, int layer) {
    g8::UpOrder S; S.layer = layer; S.G = gridDim.x; S.c = blockIdx.x; S.ws = (const char*)C.ws;
    g8::EpiStore3 E{C.ws};
    g8::gemm_phase<g8::EpiStore3, g8::UpOrder, true>(C.tid, C.lds, (const bf16_t*)C.ws, 0, 256, S, E);
}

DI void phase_prep2(Ctx C, int layer) {
    const bf16_t* U = (const bf16_t*)(C.ws + WS_U); const bf16_t* KVR = (const bf16_t*)(C.ws + WS_KVRAW);
    bf16_t* K = (bf16_t*)(C.ws + WS_K); bf16_t* V = (bf16_t*)(C.ws + WS_VT);
    const float* cs = (const float*)(C.ws + WS_COS); const float* sn = (const float*)(C.ws + WS_SIN);
    const int l = C.lane, hd = l >> 3, sub = l & 7;
    float gkn[8], gkr[4];
#pragma unroll
    for (int i = 0; i < 8; ++i) gkn[i] = INF(I_QKK)[layer * 96 + sub * 8 + i];
#pragma unroll
    for (int i = 0; i < 4; ++i) gkr[i] = INF(I_QKK)[layer * 96 + 64 + sub * 4 + i];
    const int rpw = (M + C.NGW - 1) / C.NGW, m0 = C.gw * rpw, m1 = (m0 + rpw < M) ? m0 + rpw : M;
    const bool vt_lds = (rpw == 8) && (M % (8 * rpw) == 0);
    LAS bf16_t* vst = (LAS bf16_t*)C.lds;
    u32x4 nkn, nv; u32x2 nkr;
#define P2_LOAD(mm) do { \
        nkn = *(const u32x4*)(KVR + (size_t)(mm) * 1024 + hd * 128 + sub * 8); nkr = *(const u32x2*)(U + (size_t)(mm) * INCP + U_KR + sub * 4); \
        nv = *(const u32x4*)(KVR + (size_t)(mm) * 1024 + hd * 128 + 64 + sub * 8); } while (0)
    if (m0 < m1) P2_LOAD(m0);
    for (int m = m0; m < m1; ++m) {
        const int b = m / SEQ, t = m % SEQ, bh = b * NH + hd;
        float kn[8]; unpack8(nkn, kn);
        float kr[4] = {bflo(nkr.x), bfhi(nkr.x), bflo(nkr.y), bfhi(nkr.y)};
        const u32x4 vraw = nv;
        if (m + 1 < m1) P2_LOAD(m + 1);
        const f32x4 c4 = ld4(cs + m * 16 + (sub & 3) * 4), s4 = ld4(sn + m * 16 + (sub & 3) * 4);
        float sk = 0.f;
#pragma unroll
        for (int i = 0; i < 8; ++i) sk += kn[i] * kn[i];
#pragma unroll
        for (int i = 0; i < 4; ++i) sk += kr[i] * kr[i];
#pragma unroll
        for (int o = 1; o < 8; o <<= 1) sk += shx(sk, o);
        const float rk = rsqrtf(sk * (1.f / 96.f) + 1e-6f);
#pragma unroll
        for (int i = 0; i < 8; ++i) kn[i] *= rk * gkn[i];
        float ko4[4];
#pragma unroll
        for (int i = 0; i < 4; ++i) { const float kv = kr[i] * rk * gkr[i]; const float kp = shx(kv, 4);
            const float cc = c4[i], ss = s4[i];
            ko4[i] = (sub < 4) ? (kv * cc - kp * ss) : (kp * ss + kv * cc); }
        bf16_t* ko = K + ((size_t)bh * SEQ + t) * DQK;
        *(u32x4*)(ko + sub * 8) = pack8(kn);
        u32x2 w2;
        w2.x = pk2(ko4[0], ko4[1]); w2.y = pk2(ko4[2], ko4[3]); *(u32x2*)(ko + 64 + sub * 4) = w2;
        if (vt_lds) *(LAS u32x4*)(vst + ((C.wave * 8 + (m - m0)) * 512 + hd * 64 + sub * 8)) = vraw;
        else {
#pragma unroll
            for (int e = 0; e < 8; ++e) V[((size_t)bh * DV + sub * 8 + e) * SEQ + t] = (bf16_t)(((e & 1) ? (vraw[e >> 1] >> 16) : (vraw[e >> 1] & 0xffffu))); }
    }
#undef P2_LOAD
    if (vt_lds) {
        __syncthreads();
        const int hd2 = C.tid >> 6, d2 = C.tid & 63, mb0 = blockIdx.x * 64, b2 = mb0 / SEQ, t0 = mb0 % SEQ;
        unsigned w[32];
#pragma unroll
        for (int i = 0; i < 32; ++i) w[i] = (unsigned)vst[(2 * i) * 512 + hd2 * 64 + d2] | ((unsigned)vst[(2 * i + 1) * 512 + hd2 * 64 + d2] << 16);
        bf16_t* dst = V + ((size_t)(b2 * NH + hd2) * DV + d2) * SEQ + t0;
#pragma unroll
        for (int i = 0; i < 8; ++i) *(u32x4*)(dst + 8 * i) = (u32x4){w[4 * i], w[4 * i + 1], w[4 * i + 2], w[4 * i + 3]};
        __syncthreads();
    }
}

DI float att_add(float a, float b) { float r; asm("v_add_f32 %0, %1, %2" : "=v"(r) : "v"(a), "v"(b)); return r; }
DI void phase_attn2(Ctx C, unsigned* qhead, int layer) {
    constexpr int KP = 104, VP = 68, KBYTES = 64 * KP * 2, SLOT = KBYTES + 64 * VP * 2 + 64;
    LAS unsigned char* lds = C.lds;
    const bf16_t* QR = (const bf16_t*)(C.ws + WS_QRAW); const bf16_t* K = (const bf16_t*)(C.ws + WS_K); const bf16_t* V = (const bf16_t*)(C.ws + WS_VT); bf16_t* MX = (bf16_t*)(C.ws + WS_MIXED);
    const float* cs = (const float*)(C.ws + WS_COS); const float* sn = (const float*)(C.ws + WS_SIN);
    const int tid = C.tid, lane = C.lane, wid = C.wave, r = lane & 31, h = lane >> 5;
    const int kp0 = tid, kp1 = tid + 512;
    const int kr0 = kp0 / 12, kc0 = (kp0 % 12) * 8, kr1 = kp1 / 12, kc1 = (kp1 % 12) * 8;
    const int vr = tid >> 3, vc = (tid & 7) * 8;
    volatile LAS int* qslot = (volatile LAS int*)(lds + 131072 + 2048);
    float gqm = 0.f, gkm = 0.f;
    for (int i = lane; i < 96; i += 64) { gqm = fmaxf(gqm, fabsf(INF(I_QKQ)[layer * 96 + i])); gkm = fmaxf(gkm, fabsf(INF(I_QKK)[layer * 96 + i])); }
    gqm = wave_max(gqm); gkm = wave_max(gkm);
    const float shift = 9.797958971132712f * 1.4426950408889634f * gqm * gkm * 1.02f + 0.5f;
    f32x16 negc;
#pragma unroll
    for (int q = 0; q < 16; ++q) negc[q] = -shift;
    for (;;) {
        __syncthreads();
        if (tid == 0) qslot[0] = (int)__hip_atomic_fetch_add(qhead, 1u, __ATOMIC_RELAXED, __HIP_MEMORY_SCOPE_AGENT);
        __syncthreads();
        const int item = __builtin_amdgcn_readfirstlane(qslot[0]);
        if (item >= 512) break;
        {
        const int bh = item & 31, b = bh >> 3, hh = bh & 7;
        const bf16_t* Kg = K + (size_t)bh * SEQ * DQK; const bf16_t* Vg = V + (size_t)bh * DV * SEQ;
        {
            const int qb = 15 - (item >> 5), NT = 4 * qb + 4, qmin = 256 * qb + 32 * wid;
            bf16x8 qf[6];
            u32x4 kg0, kg1, vg;
            kg0 = *(const u32x4*)(Kg + (size_t)kr0 * DQK + kc0); if (tid < 256) kg1 = *(const u32x4*)(Kg + (size_t)kr1 * DQK + kc1); vg = *(const u32x4*)(Vg + (size_t)vr * SEQ + vc);
#define ATT_WRITE(slot) do { LAS unsigned char* sb_ = lds + (slot) * SLOT; *(LAS u32x4*)(sb_ + (kr0 * KP + kc0) * 2) = kg0; if (tid < 256) *(LAS u32x4*)(sb_ + (kr1 * KP + kc1) * 2) = kg1; \
                LAS bf16_t* vt_ = (LAS bf16_t*)(sb_ + KBYTES); *(LAS u32x2*)(vt_ + vr * VP + vc) = (u32x2){vg.x, vg.y}; *(LAS u32x2*)(vt_ + vr * VP + vc + 4) = (u32x2){vg.z, vg.w}; } while (0)
            { u32x4 kh0, kh1 = kg0, vh;
              { const size_t ko = 64; kh0 = *(const u32x4*)(Kg + (ko + kr0) * DQK + kc0); if (tid < 256) kh1 = *(const u32x4*)(Kg + (ko + kr1) * DQK + kc1); vh = *(const u32x4*)(Vg + (size_t)vr * SEQ + ko + vc); }
              {
                  const size_t mrow = (size_t)b * SEQ + qmin + r; const bf16_t* qp = QR + mrow * 768 + hh * 96 + 8 * h;
                  u32x4 raw[6];
#pragma unroll
                  for (int sx = 0; sx < 6; ++sx) raw[sx] = *(const u32x4*)(qp + 16 * sx);
                  const f32x4 c0 = ld4(cs + mrow * 16 + 8 * h), c1 = ld4(cs + mrow * 16 + 8 * h + 4), s0 = ld4(sn + mrow * 16 + 8 * h), s1 = ld4(sn + mrow * 16 + 8 * h + 4);
                  const float* gq = INF(I_QKQ) + layer * 96 + 8 * h;
                  const float qscale = 0.10206207261596575f * 1.4426950408889634f;
                  float ssq = 0.f;
#pragma unroll
                  for (int sx = 0; sx < 6; ++sx) { float t8[8]; unpack8(raw[sx], t8);
#pragma unroll
                      for (int i = 0; i < 8; ++i) ssq += t8[i] * t8[i]; }
                  ssq = shx32_sum(ssq);
                  const float rq = rsqrtf(ssq * (1.f / 96.f) + 1e-6f);
#pragma unroll
                  for (int sx = 0; sx < 4; ++sx) { const f32x4 g0 = ld4(gq + 16 * sx), g1 = ld4(gq + 16 * sx + 4); float t8[8]; unpack8(raw[sx], t8);
#pragma unroll
                      for (int i = 0; i < 8; ++i) t8[i] *= rq * qscale * (i < 4 ? g0[i] : g1[i - 4]);
                      qf[sx] = __builtin_bit_cast(bf16x8, pack8(t8)); }
                  { const f32x4 a0 = ld4(gq + 64), a1 = ld4(gq + 68), b0 = ld4(gq + 80), b1 = ld4(gq + 84); float xa[8], xb[8]; unpack8(raw[4], xa); unpack8(raw[5], xb);
#pragma unroll
                    for (int i = 0; i < 8; ++i) { const float xj = xa[i] * rq * (i < 4 ? a0[i] : a1[i - 4]), xk = xb[i] * rq * (i < 4 ? b0[i] : b1[i - 4]);
                        const float cc = (i < 4 ? c0[i] : c1[i - 4]), sv = (i < 4 ? s0[i] : s1[i - 4]);
                        xa[i] = (xj * cc - xk * sv) * qscale; xb[i] = (xj * sv + xk * cc) * qscale; }
                    qf[4] = __builtin_bit_cast(bf16x8, pack8(xa)); qf[5] = __builtin_bit_cast(bf16x8, pack8(xb)); }
              }
              ATT_WRITE(0);
              kg0 = kh0; kg1 = kh1; vg = vh; }
            ATT_WRITE(1);
            { const size_t ko = 128; kg0 = *(const u32x4*)(Kg + (ko + kr0) * DQK + kc0); if (tid < 256) kg1 = *(const u32x4*)(Kg + (ko + kr1) * DQK + kc1); vg = *(const u32x4*)(Vg + (size_t)vr * SEQ + ko + vc); }
            __syncthreads();
            f32x16 o[2]; float lrun = 0.f;
            { const float z0 = ozero();
#pragma unroll
            for (int q = 0; q < 16; ++q) { o[0][q] = z0; o[1][q] = z0; } }
#pragma unroll 2
            for (int t = 0; t < NT; ++t) {
                u32x4 ng0 = kg0, ng1 = kg0, nvg = kg0;
                if (t + 3 < NT) { const size_t ko = (size_t)(t + 3) * 64;
                    ng0 = *(const u32x4*)(Kg + (ko + kr0) * DQK + kc0); if (tid < 256) ng1 = *(const u32x4*)(Kg + (ko + kr1) * DQK + kc1); nvg = *(const u32x4*)(Vg + (size_t)vr * SEQ + ko + vc); }
                const int key0 = 64 * t;
                if (key0 <= qmin + 31) {
                    const LAS unsigned char* sb = lds + (t & 3) * SLOT;
                    const LAS bf16_t* kl = (const LAS bf16_t*)sb + r * KP + 8 * h; const LAS bf16_t* vl = (const LAS bf16_t*)(sb + KBYTES) + r * VP + 4 * h;
                    f32x16 p0 = negc, p1 = negc;
                    bf16x8 ka[6], kb[6];
#pragma unroll
                    for (int sx = 0; sx < 6; ++sx) { ka[sx] = *(const LAS bf16x8*)(kl + 16 * sx); kb[sx] = *(const LAS bf16x8*)(kl + 32 * KP + 16 * sx); }
                    __builtin_amdgcn_sched_barrier(0);
#pragma unroll
                    for (int sx = 0; sx < 6; ++sx) { p0 = __builtin_amdgcn_mfma_f32_32x32x16_bf16(ka[sx], qf[sx], p0, 0, 0, 0); p1 = __builtin_amdgcn_mfma_f32_32x32x16_bf16(kb[sx], qf[sx], p1, 0, 0, 0); }
                    u32x2 vlo[2][4], vhi[2][4];
#pragma unroll
                    for (int sx = 0; sx < 4; ++sx)
#pragma unroll
                        for (int db = 0; db < 2; ++db) { vlo[db][sx] = *(const LAS u32x2*)(vl + db * 32 * VP + 16 * sx); vhi[db][sx] = *(const LAS u32x2*)(vl + db * 32 * VP + 16 * sx + 8); }
                    __builtin_amdgcn_sched_barrier(0);
                    if (key0 + 63 > qmin) { const int qa = qmin + r;
#pragma unroll
                        for (int q = 0; q < 16; ++q) { const int ky = key0 + crow(q, h); if (ky > qa) p0[q] = -INFINITY; if (ky + 32 > qa) p1[q] = -INFINITY; } }
#pragma unroll
                    for (int q = 0; q < 16; ++q) { p0[q] = __builtin_amdgcn_exp2f(p0[q]); p1[q] = __builtin_amdgcn_exp2f(p1[q]); }
                    float ps0 = 0.f, ps1 = 0.f, ps2 = 0.f, ps3 = 0.f;
#pragma unroll
                    for (int q = 0; q < 16; q += 2) { ps0 = att_add(ps0, p0[q]); ps1 = att_add(ps1, p1[q]); ps2 = att_add(ps2, p0[q + 1]); ps3 = att_add(ps3, p1[q + 1]); }
                    lrun += att_add(att_add(ps0, ps1), att_add(ps2, ps3));
#pragma unroll
                    for (int sx = 0; sx < 4; ++sx) {
                        u32x4 pw;
                        if (sx < 2) { pw.x = pk2(p0[8 * sx + 0], p0[8 * sx + 1]); pw.y = pk2(p0[8 * sx + 2], p0[8 * sx + 3]); pw.z = pk2(p0[8 * sx + 4], p0[8 * sx + 5]); pw.w = pk2(p0[8 * sx + 6], p0[8 * sx + 7]); }
                        else { const int s2 = sx - 2; pw.x = pk2(p1[8 * s2 + 0], p1[8 * s2 + 1]); pw.y = pk2(p1[8 * s2 + 2], p1[8 * s2 + 3]); pw.z = pk2(p1[8 * s2 + 4], p1[8 * s2 + 5]); pw.w = pk2(p1[8 * s2 + 6], p1[8 * s2 + 7]); }
                        const bf16x8 pf = __builtin_bit_cast(bf16x8, pw);
#pragma unroll
                        for (int db = 0; db < 2; ++db) { u32x4 vw4; vw4.x = vlo[db][sx].x; vw4.y = vlo[db][sx].y; vw4.z = vhi[db][sx].x; vw4.w = vhi[db][sx].y;
                            o[db] = __builtin_amdgcn_mfma_f32_32x32x16_bf16(__builtin_bit_cast(bf16x8, vw4), pf, o[db], 0, 0, 0); }
                    }
                }
                if (t + 2 < NT) ATT_WRITE((t + 2) & 3);
                kg0 = ng0; kg1 = ng1; vg = nvg;
                if ((t & 1) == 0) { asm volatile("s_waitcnt lgkmcnt(0)" ::: "memory"); __builtin_amdgcn_s_barrier(); asm volatile("" ::: "memory"); }
            }
#undef ATT_WRITE
            lrun = shx32_sum(lrun);
            const float il = 1.f / lrun;
            bf16_t* orow = MX + ((size_t)b * SEQ + qmin + r) * DM + 256 + hh * 64;
#pragma unroll
            for (int db = 0; db < 2; ++db)
#pragma unroll
                for (int g = 0; g < 4; ++g) { u32x2 w2; w2.x = pk2(o[db][4 * g] * il, o[db][4 * g + 1] * il); w2.y = pk2(o[db][4 * g + 2] * il, o[db][4 * g + 3] * il); *(u32x2*)(orow + db * 32 + 8 * g + 4 * h) = w2; }
        }
        }
    }
}

namespace rk {
constexpr int PITCH = 72, BUFB = 64 * PITCH * 2;
enum { B_RT = 0, B_ATT, B_BHT, B_KHT, B_VT, B_NBRT, B_MAK, B_PA, B_PB, B_PC, B_PD, B_PE, NBUF };
constexpr int OFF_MFD = NBUF * BUFB, OFF_TOT = OFF_MFD + 4096, OFF_ECUM = OFF_TOT + 2048;
static_assert(OFF_ECUM + 256 <= 131072, "rk lds");
constexpr int REC = 32768;
#define RKBUF(id) ((LAS bf16_t*)(lds + (id) * BUFB))
DI f32x16 mm_block(const LAS bf16_t* A, int mb, const LAS bf16_t* Bt, int nb, f32x16 acc, int lane) {
    const int r = lane & 31, h = lane >> 5;
    const LAS bf16_t* ap = A + (mb * 32 + r) * PITCH + 8 * h; const LAS bf16_t* bp = Bt + (nb * 32 + r) * PITCH + 8 * h;
#pragma unroll
    for (int ks = 0; ks < 4; ++ks) acc = __builtin_amdgcn_mfma_f32_32x32x16_bf16(*(const LAS bf16x8*)(ap + 16 * ks), *(const LAS bf16x8*)(bp + 16 * ks), acc, 0, 0, 0);
    return acc;
}
DI void store_T(LAS bf16_t* dst, int mb, int nb, const f32x16& acc, int lane) {
    const int r = lane & 31, h = lane >> 5;
#pragma unroll
    for (int g = 0; g < 4; ++g) { u32x2 w; w.x = pk2(acc[4 * g], acc[4 * g + 1]); w.y = pk2(acc[4 * g + 2], acc[4 * g + 3]); *(LAS u32x2*)(dst + (nb * 32 + r) * PITCH + mb * 32 + 8 * g + 4 * h) = w; }
}
DI void store_N(LAS bf16_t* dst, int mb, int nb, const f32x16& acc, int lane) {
    const int r = lane & 31, h = lane >> 5;
#pragma unroll
    for (int q = 0; q < 16; ++q) dst[(mb * 32 + crow(q, h)) * PITCH + nb * 32 + r] = f2bf(acc[q]);
}
DI f32x16 zero16() { const float z0 = ozero(); f32x16 z;
#pragma unroll
    for (int q = 0; q < 16; ++q) z[q] = z0;
    return z; }
}

DI void phase_rwkv_chunk(Ctx C, int layer) {
    using namespace rk;
    LAS unsigned char* lds = C.lds;
    const bf16_t* RR = (const bf16_t*)(C.ws + WS_RR); const bf16_t* RK = (const bf16_t*)(C.ws + WS_RK); const bf16_t* RV = (const bf16_t*)(C.ws + WS_RV);
    const bf16_t* RKK = (const bf16_t*)(C.ws + WS_RKK); const bf16_t* LO = (const bf16_t*)(C.ws + WS_LOUT);
    const int lane = C.lane, w = C.wave, r = lane & 31, h = lane >> 5;
    LAS float* tot = (LAS float*)(lds + OFF_TOT); LAS float* ecum = (LAS float*)(lds + OFF_ECUM); LAS float* mfd = (LAS float*)(lds + OFF_MFD);
    bf16_t raw[6][8];
#define CH_LOAD(job_) do { const int bh_ = (job_) >> 6, c_ = (job_) & 63, b_ = bh_ >> 2, hh_ = bh_ & 3; \
        const size_t base_ = ((size_t)b_ * SEQ + c_ * 64 + w * 8) * RC + hh_ * 64 + lane, lbase_ = ((size_t)b_ * SEQ + c_ * 64 + w * 8) * 768 + hh_ * 64 + lane; \
        _Pragma("unroll") for (int i = 0; i < 8; ++i) { const size_t o_ = base_ + (size_t)i * RC; raw[0][i] = RR[o_]; raw[1][i] = RV[o_]; raw[2][i] = RKK[o_]; raw[3][i] = RK[o_]; \
            raw[4][i] = LO[lbase_ + (size_t)i * 768]; raw[5][i] = LO[lbase_ + (size_t)i * 768 + 256]; } } while (0)
    if ((int)blockIdx.x < NB * RH * (SEQ / 64)) CH_LOAD((int)blockIdx.x);
    for (int job = blockIdx.x; job < NB * RH * (SEQ / 64); job += gridDim.x) {
        const int bh = job >> 6, c = job & 63, b = bh >> 2, hh = bh & 3;
        unsigned char* rec = C.ws + WS_CHK + (size_t)job * REC;
        {
            const int g = w, ch = lane; const size_t base = ((size_t)b * SEQ + c * 64 + g * 8) * RC + hh * 64 + ch;
            float lw[8], cum[8];
            float rv[8], kv[8], vv[8], kkv[8], bv[8];
            { const float w0 = INF(I_RW0)[layer * RC + hh * 64 + ch], a0 = INF(I_RA0)[layer * RC + hh * 64 + ch], ka = INF(I_RKA)[layer * RC + hh * 64 + ch];
#pragma unroll
              for (int i = 0; i < 8; ++i) { rv[i] = bf2f(raw[0][i]); vv[i] = bf2f(raw[1][i]); kkv[i] = bf2f(raw[2][i]);
                  const float kraw = bf2f(raw[3][i]), lin = bf2f(raw[4][i]), la = bf2f(raw[5][i]);
                  const float zz = -(w0 + lin); const float sp = fmaxf(zz, 0.f) + __logf(1.f + __expf(-fabsf(zz))); lw[i] = -__expf(-sp - 0.5f);
                  const float asig = fsigmoid(a0 + la); kv[i] = kraw * (1.f + (asig - 1.f) * ka); bv[i] = kkv[i] * asig; } }
            cum[0] = lw[0];
#pragma unroll
            for (int i = 1; i < 8; ++i) cum[i] = cum[i - 1] + lw[i];
            tot[g * 64 + ch] = cum[7];
            __syncthreads();
            float prefix = 0.f, total = 0.f;
#pragma unroll
            for (int q = 0; q < 8; ++q) { const float tq = tot[q * 64 + ch]; total += tq; prefix += (q < g) ? tq : 0.f; }
            if (g == 0) ecum[ch] = __expf(total);
            unsigned att[4], bht[4], kht[4], vt[4];
#pragma unroll
            for (int i = 0; i < 8; i += 2) {
                float o[2][8];
#pragma unroll
                for (int e = 0; e < 2; ++e) { const int ii = i + e; const float ci = cum[ii] + prefix, cx = ci - lw[ii];
                    const float ein = __expf(ci), eex = __expf(cx), eneg = __expf(-ci), eend = __expf(total - ci);
                    o[e][0] = -kkv[ii] * eex; o[e][1] = rv[ii] * ein; o[e][2] = bv[ii] * eneg; o[e][3] = kv[ii] * eneg; o[e][4] = bv[ii] * eend; o[e][5] = kv[ii] * eend; o[e][6] = vv[ii];
                    const int tok = g * 8 + ii;
                    RKBUF(B_PA)[tok * PITCH + ch] = f2bf(o[e][0]); RKBUF(B_RT)[tok * PITCH + ch] = f2bf(o[e][1]); RKBUF(B_PB)[tok * PITCH + ch] = f2bf(o[e][2]); RKBUF(B_PC)[tok * PITCH + ch] = f2bf(o[e][3]); }
                att[i >> 1] = pk2(o[0][0], o[1][0]); bht[i >> 1] = pk2(o[0][4], o[1][4]); kht[i >> 1] = pk2(o[0][5], o[1][5]); vt[i >> 1] = pk2(o[0][6], o[1][6]);
            }
            *(LAS u32x4*)(RKBUF(B_ATT) + ch * PITCH + g * 8) = (u32x4){att[0], att[1], att[2], att[3]};
            *(LAS u32x4*)(RKBUF(B_BHT) + ch * PITCH + g * 8) = (u32x4){bht[0], bht[1], bht[2], bht[3]};
            *(LAS u32x4*)(RKBUF(B_KHT) + ch * PITCH + g * 8) = (u32x4){kht[0], kht[1], kht[2], kht[3]};
            *(LAS u32x4*)(RKBUF(B_VT) + ch * PITCH + g * 8) = (u32x4){vt[0], vt[1], vt[2], vt[3]};
        }
        __syncthreads();
        const int blk = w & 3, mb = blk >> 1, nb = blk & 1;
        f32x16 nkr = zero16();
        {
            const LAS bf16_t* Aop = (w < 4) ? RKBUF(B_PB) : RKBUF(B_PC);
            f32x16 m1 = mm_block(Aop, mb, RKBUF(B_PA), nb, zero16(), lane);
            f32x16 m2 = mm_block(Aop, mb, RKBUF(B_RT), nb, zero16(), lane);
#pragma unroll
            for (int q = 0; q < 16; ++q) { const int sI = mb * 32 + crow(q, h), tI = nb * 32 + r; if (!(sI < tI)) m1[q] = 0.f; if (!(sI <= tI)) m2[q] = 0.f; }
            if (w < 4) {
                f32x16 moff = m1;
#pragma unroll
                for (int q = 0; q < 16; ++q) { const int sI = mb * 32 + crow(q, h), tI = nb * 32 + r; if ((sI >> 4) == (tI >> 4)) { mfd[(tI >> 4) * 256 + (tI & 15) * 16 + (sI & 15)] = m1[q]; moff[q] = 0.f; } }
                store_T(RKBUF(B_PD), mb, nb, moff, lane);
                store_T(RKBUF(B_NBRT), mb, nb, m2, lane);
            } else { store_N(RKBUF(B_MAK), mb, nb, m1, lane); nkr = m2; }
        }
        __syncthreads();
        if (w == 0) {
            const int d = lane >> 4, rr = lane & 15; float x[16];
#pragma unroll
            for (int t = 0; t < 16; ++t) { float acc = (t == rr) ? 1.f : 0.f;
#pragma unroll
                for (int sI = 0; sI < t; ++sI) acc += x[sI] * mfd[d * 256 + t * 16 + sI];
                x[t] = acc; }
            LAS bf16_t* Dn = RKBUF(B_PA); LAS bf16_t* Dt = RKBUF(B_PB); const int row = 16 * d + rr;
#pragma unroll
            for (int q = 0; q < 8; ++q) { *(LAS u32x4*)(Dn + row * PITCH + 8 * q) = (u32x4){0u, 0u, 0u, 0u}; *(LAS u32x4*)(Dt + row * PITCH + 8 * q) = (u32x4){0u, 0u, 0u, 0u}; }
            asm volatile("s_waitcnt lgkmcnt(0)" ::: "memory");
#pragma unroll
            for (int t = 0; t < 16; t += 2) *(LAS unsigned*)(Dn + row * PITCH + 16 * d + t) = pk2(x[t], x[t + 1]);
#pragma unroll
            for (int t = 0; t < 16; ++t) Dt[(16 * d + t) * PITCH + row] = f2bf(x[t]);
        }
        __syncthreads();
        if (job + (int)gridDim.x < NB * RH * (SEQ / 64)) CH_LOAD(job + (int)gridDim.x);
        f32x16 sig = zero16();
        if (w < 4) { sig = mm_block(RKBUF(B_PA), mb, RKBUF(B_PD), nb, zero16(), lane); store_N(RKBUF(B_PC), mb, nb, sig, lane); store_T(RKBUF(B_PE), mb, nb, sig, lane); }
        __syncthreads();
        if (w < 4) { const f32x16 w2 = mm_block(RKBUF(B_PC), mb, RKBUF(B_PE), nb, zero16(), lane); store_T(RKBUF(B_PD), mb, nb, w2, lane);
#pragma unroll
            for (int q = 0; q < 16; ++q) sig[q] += w2[q]; }
        __syncthreads();
        if (w < 4) { sig = mm_block(RKBUF(B_PC), mb, RKBUF(B_PD), nb, sig, lane);
#pragma unroll
            for (int q = 0; q < 16; ++q) if (mb * 32 + crow(q, h) == nb * 32 + r) sig[q] += 1.f;
            store_N(RKBUF(B_PA), mb, nb, sig, lane); }
        __syncthreads();
        if (w < 4) { const f32x16 tt = mm_block(RKBUF(B_PA), mb, RKBUF(B_PB), nb, zero16(), lane); store_T(RKBUF(B_PC), mb, nb, tt, lane); }
        __syncthreads();
        { const f32x16 x = mm_block((w < 4) ? RKBUF(B_ATT) : RKBUF(B_MAK), mb, RKBUF(B_PC), nb, zero16(), lane); store_N((w < 4) ? RKBUF(B_PA) : RKBUF(B_PB), mb, nb, x, lane); }
        __syncthreads();
        if (w < 4) {
            f32x16 qh = mm_block(RKBUF(B_PA), mb, RKBUF(B_NBRT), nb, zero16(), lane);
#pragma unroll
            for (int g = 0; g < 4; ++g) { const u32x2 rw = *(const LAS u32x2*)(RKBUF(B_RT) + (nb * 32 + r) * PITCH + mb * 32 + 8 * g + 4 * h);
                qh[4 * g] += __uint_as_float(rw.x << 16); qh[4 * g + 1] += __uint_as_float(rw.x & 0xffff0000u); qh[4 * g + 2] += __uint_as_float(rw.y << 16); qh[4 * g + 3] += __uint_as_float(rw.y & 0xffff0000u); }
            f32x16 ph = mm_block(RKBUF(B_PA), mb, RKBUF(B_BHT), nb, zero16(), lane);
#pragma unroll
            for (int q = 0; q < 16; ++q) if (mb * 32 + crow(q, h) == nb * 32 + r) ph[q] += ecum[nb * 32 + r];
#pragma unroll
            for (int sx = 0; sx < 2; ++sx) {
                u32x4 o; o.x = pk2(ph[8 * sx], ph[8 * sx + 1]); o.y = pk2(ph[8 * sx + 2], ph[8 * sx + 3]); o.z = pk2(ph[8 * sx + 4], ph[8 * sx + 5]); o.w = pk2(ph[8 * sx + 6], ph[8 * sx + 7]);
                *(u32x4*)(rec + (((nb * 2 + mb) * 2 + sx) * 64 + lane) * 16) = o;
                u32x4 p; p.x = pk2(qh[8 * sx], qh[8 * sx + 1]); p.y = pk2(qh[8 * sx + 2], qh[8 * sx + 3]); p.z = pk2(qh[8 * sx + 4], qh[8 * sx + 5]); p.w = pk2(qh[8 * sx + 6], qh[8 * sx + 7]);
                *(u32x4*)(rec + 8192 + (((nb * 2 + mb) * 2 + sx) * 64 + lane) * 16) = p; }
        } else {
            const f32x16 gg = mm_block(RKBUF(B_PB), mb, RKBUF(B_NBRT), nb, nkr, lane);
            f32x16 hm = mm_block(RKBUF(B_PB), mb, RKBUF(B_BHT), nb, zero16(), lane);
#pragma unroll
            for (int g = 0; g < 4; ++g) { const u32x2 kw = *(const LAS u32x2*)(RKBUF(B_KHT) + (nb * 32 + r) * PITCH + mb * 32 + 8 * g + 4 * h);
                hm[4 * g] += __uint_as_float(kw.x << 16); hm[4 * g + 1] += __uint_as_float(kw.x & 0xffff0000u); hm[4 * g + 2] += __uint_as_float(kw.y << 16); hm[4 * g + 3] += __uint_as_float(kw.y & 0xffff0000u); }
            store_T(RKBUF(B_PC), mb, nb, gg, lane); store_T(RKBUF(B_PD), mb, nb, hm, lane);
        }
        __syncthreads();
        { const f32x16 o = mm_block((w < 4) ? RKBUF(B_PD) : RKBUF(B_PC), mb, RKBUF(B_VT), nb, zero16(), lane);
          unsigned char* dst = rec + ((w < 4) ? 16384 : 24576) + ((nb * 2 + mb) * 64 + lane) * 32;
          u32x4 o0, o1; o0.x = pk2(o[0], o[1]); o0.y = pk2(o[2], o[3]); o0.z = pk2(o[4], o[5]); o0.w = pk2(o[6], o[7]); o1.x = pk2(o[8], o[9]); o1.y = pk2(o[10], o[11]); o1.z = pk2(o[12], o[13]); o1.w = pk2(o[14], o[15]);
          *(u32x4*)dst = o0; *(u32x4*)(dst + 16) = o1; }
        __syncthreads();
    }
}

DI void phase_rwkv_scan(Ctx C) {
    using namespace rk;
    LAS unsigned char* lds = C.lds;
    const int bh = blockIdx.x, b = bh >> 2, hh = bh & 3, w = C.wave, lane = C.lane, r = lane & 31, h = lane >> 5;
    const unsigned char* rec0 = C.ws + WS_CHK + (size_t)bh * 64 * REC;
    float* RY = (float*)(C.ws + WS_RY);
    constexpr int NCH = SEQ / 64;
#define RK_DMA(cc) do { if (w >= 4) { _Pragma("unroll") for (int p_ = 0; p_ < 8; ++p_) { const int pc_ = (w - 4) * 8 + p_; \
        __builtin_amdgcn_global_load_lds((const unsigned*)(rec0 + (size_t)(cc) * REC + pc_ * 1024 + lane * 16), (LAS unsigned*)(lds + ((cc) & 3) * REC + pc_ * 1024), 16, 0, 0); } } } while (0)
    RK_DMA(0); RK_DMA(1); RK_DMA(2);
    f32x16 st[2]; st[0] = zero16(); st[1] = zero16();
    for (int c = 0; c < NCH; ++c) {
        if (w >= 4) { if (c + 2 < NCH) asm volatile("s_waitcnt vmcnt(16)" ::: "memory"); else if (c + 1 < NCH) asm volatile("s_waitcnt vmcnt(8)" ::: "memory"); else asm volatile("s_waitcnt vmcnt(0)" ::: "memory"); }
        asm volatile("s_waitcnt lgkmcnt(0)" ::: "memory");
        __builtin_amdgcn_s_barrier();
        asm volatile("" ::: "memory");
        if (c + 3 < NCH) RK_DMA(c + 3);
        if (w < 2) {
            const LAS unsigned char* sb = lds + (c & 3) * REC; const int ib = w;
            bf16x8 bfr[2][2];
#pragma unroll
            for (int jb = 0; jb < 2; ++jb)
#pragma unroll
                for (int sx = 0; sx < 2; ++sx) { u32x4 p; p.x = pk2(st[jb][8 * sx], st[jb][8 * sx + 1]); p.y = pk2(st[jb][8 * sx + 2], st[jb][8 * sx + 3]); p.z = pk2(st[jb][8 * sx + 4], st[jb][8 * sx + 5]); p.w = pk2(st[jb][8 * sx + 6], st[jb][8 * sx + 7]); bfr[jb][sx] = __builtin_bit_cast(bf16x8, p); }
            f32x16 y[2], sn[2];
#pragma unroll
            for (int ob = 0; ob < 2; ++ob) {
                const u32x4 y0 = *(const LAS u32x4*)(sb + 24576 + ((ib * 2 + ob) * 64 + lane) * 32), y1 = *(const LAS u32x4*)(sb + 24576 + ((ib * 2 + ob) * 64 + lane) * 32 + 16);
                const u32x4 p0 = *(const LAS u32x4*)(sb + 16384 + ((ib * 2 + ob) * 64 + lane) * 32), p1 = *(const LAS u32x4*)(sb + 16384 + ((ib * 2 + ob) * 64 + lane) * 32 + 16);
#pragma unroll
                for (int q = 0; q < 4; ++q) { y[ob][2 * q] = __uint_as_float(y0[q] << 16); y[ob][2 * q + 1] = __uint_as_float(y0[q] & 0xffff0000u); y[ob][8 + 2 * q] = __uint_as_float(y1[q] << 16); y[ob][8 + 2 * q + 1] = __uint_as_float(y1[q] & 0xffff0000u);
                    sn[ob][2 * q] = __uint_as_float(p0[q] << 16); sn[ob][2 * q + 1] = __uint_as_float(p0[q] & 0xffff0000u); sn[ob][8 + 2 * q] = __uint_as_float(p1[q] << 16); sn[ob][8 + 2 * q + 1] = __uint_as_float(p1[q] & 0xffff0000u); }
#pragma unroll
                for (int jb = 0; jb < 2; ++jb)
#pragma unroll
                    for (int sx = 0; sx < 2; ++sx) {
                        const bf16x8 qa = *(const LAS bf16x8*)(sb + 8192 + (((ob * 2 + jb) * 2 + sx) * 64 + lane) * 16);
                        const bf16x8 pa = *(const LAS bf16x8*)(sb + (((ob * 2 + jb) * 2 + sx) * 64 + lane) * 16);
                        y[ob] = __builtin_amdgcn_mfma_f32_32x32x16_bf16(qa, bfr[jb][sx], y[ob], 0, 0, 0);
                        sn[ob] = __builtin_amdgcn_mfma_f32_32x32x16_bf16(pa, bfr[jb][sx], sn[ob], 0, 0, 0);
                    }
            }
#pragma unroll
            for (int ob = 0; ob < 2; ++ob)
#pragma unroll
                for (int q = 0; q < 16; ++q) RY[((size_t)b * SEQ + c * 64 + ob * 32 + crow(q, h)) * RC + hh * 64 + ib * 32 + r] = y[ob][q];
            st[0] = sn[0]; st[1] = sn[1];
        }
    }
#undef RK_DMA
    asm volatile("s_waitcnt vmcnt(0) lgkmcnt(0)" ::: "memory");
    __builtin_amdgcn_s_barrier();
}

DI void phase_rwkv_out(Ctx C, int layer, unsigned* pan = nullptr) {
    const bf16_t* RR = (const bf16_t*)(C.ws + WS_RR); const bf16_t* RK = (const bf16_t*)(C.ws + WS_RK); const bf16_t* RV = (const bf16_t*)(C.ws + WS_RV); const bf16_t* LO = (const bf16_t*)(C.ws + WS_LOUT);
    const float* RY = (const float*)(C.ws + WS_RY); bf16_t* MX = (bf16_t*)(C.ws + WS_MIXED);
    const int l = C.lane;
    const f32x4 lg = ld4(INF(I_RLNG) + layer * RC + l * 4), lb = ld4(INF(I_RLNB) + layer * RC + l * 4), rk = ld4(INF(I_RRK) + layer * RC + l * 4);
    const f32x4 a0 = ld4(INF(I_RA0) + layer * RC + l * 4), ka = ld4(INF(I_RKA) + layer * RC + l * 4);
    const int rpw = (M + C.NGW - 1) / C.NGW, m0 = C.gw * rpw, m1 = (m0 + rpw < M) ? m0 + rpw : M;
    f32x4 ny; u32x2 nwr, nwk, nwv, nwg, nwa;
#define RO_LOAD(mm) do { const size_t o_ = (size_t)(mm) * RC + l * 4; ny = ld4(RY + o_); nwr = *(const u32x2*)(RR + o_); nwk = *(const u32x2*)(RK + o_); nwv = *(const u32x2*)(RV + o_); \
        nwg = *(const u32x2*)(LO + (size_t)(mm) * 768 + 512 + l * 4); nwa = *(const u32x2*)(LO + (size_t)(mm) * 768 + 256 + l * 4); } while (0)
    if (m0 < m1) RO_LOAD(m0);
    for (int m = m0; m < m1; ++m) {
        const f32x4 y = ny; const u32x2 wr = nwr, wk = nwk, wv = nwv, wg = nwg, wa = nwa;
        if (m + 1 < m1) RO_LOAD(m + 1);
        const f32x4 r = {bflo(wr.x), bfhi(wr.x), bflo(wr.y), bfhi(wr.y)}, kraw = {bflo(wk.x), bfhi(wk.x), bflo(wk.y), bfhi(wk.y)}, v = {bflo(wv.x), bfhi(wv.x), bflo(wv.y), bfhi(wv.y)}, g = {bflo(wg.x), bfhi(wg.x), bflo(wg.y), bfhi(wg.y)};
        const f32x4 la = {bflo(wa.x), bfhi(wa.x), bflo(wa.y), bfhi(wa.y)};
        f32x4 k;
#pragma unroll
        for (int i = 0; i < 4; ++i) { const float asig = sigmoidf_(a0[i] + la[i]); k[i] = kraw[i] * (1.f + (asig - 1.f) * ka[i]); }
        float sm = y.x + y.y + y.z + y.w; const f32x4 rkk = r * k * rk; float bn = rkk.x + rkk.y + rkk.z + rkk.w;
#pragma unroll
        for (int o = 1; o < 16; o <<= 1) { sm += shx(sm, o); bn += shx(bn, o); }
        const float mean = sm * (1.f / 64.f); const f32x4 d = y - mean; float vr = d.x * d.x + d.y * d.y + d.z * d.z + d.w * d.w;
#pragma unroll
        for (int o = 1; o < 16; o <<= 1) vr += shx(vr, o);
        const f32x4 yn = d * rsqrtf(vr * (1.f / 64.f) + 64e-5f) * lg + lb;
        const f32x4 res = (yn + bn * v) * g;
        u32x2 o2; o2.x = pk2(res.x, res.y); o2.y = pk2(res.z, res.w);
        if (pan) { const __amdgpu_buffer_rsrc_t rs = __builtin_amdgcn_make_buffer_rsrc((void*)MX, (short)0, -1, 0x00020000); __builtin_amdgcn_raw_buffer_store_b64(o2, rs, (m * DM + 768 + l * 4) * 2, 0, 16); }
        else *(u32x2*)(MX + (size_t)m * DM + 768 + l * 4) = o2;
    }
    if (pan && m0 < m1) { asm volatile("s_waitcnt vmcnt(0)" ::: "memory"); if (l == 0) (void)__hip_atomic_fetch_add(pan + 64 * (m0 >> 8), 1u, __ATOMIC_RELAXED, __HIP_MEMORY_SCOPE_AGENT); }
}

constexpr int LDS_BYTES = 163840;
constexpr int MISC_OFF = 131072 + 320;
constexpr int PH_PER_LAYER = 11, N_PHASES = 1 + NL * PH_PER_LAYER + 1 - NL / 2 - (FUSE_NORM ? NL : 0) - NL;

__global__ void __launch_bounds__(NTHREADS, 2) __attribute__((amdgpu_waves_per_eu(2, 2))) mega(Args args) {
    extern __shared__ __attribute__((aligned(16))) unsigned char lds[];
    Ctx C; C.ka = (const CAS char*)__builtin_amdgcn_kernarg_segment_ptr(); C.ws = args.ws; C.lds = (LAS unsigned char*)lds;
    C.tid = threadIdx.x; C.lane = C.tid & 63; C.wave = __builtin_amdgcn_readfirstlane(C.tid >> 6);
    C.gw = blockIdx.x * NWAVES + C.wave; C.NGW = gridDim.x * NWAVES; C.gtid = blockIdx.x * NTHREADS + C.tid; C.NT = gridDim.x * NTHREADS;
    volatile LAS unsigned* MISC = (volatile LAS unsigned*)((LAS unsigned char*)lds + MISC_OFF);
    if (C.tid < 32) MISC[C.tid] = 0u;
    __syncthreads();
    unsigned* ctl = (unsigned*)(args.ws + WS_CTL);
    XcdBarrier bar; bar.bar = ctl + CW_BAR; bar.x = 0; bar.st = nullptr;
    const int lo = args.ph_lo, hi = args.ph_hi;
    if (hi - lo > 1) bar = xcd_barrier_post(ctl + CW_BAR, MISC + 8);
    int pid = 0;
#ifndef PHMASK
#define PHMASK 0xFFFF
#endif
#define PH_ON(k) ((PHMASK >> (k)) & 1)
#define PH_BEGIN if (pid >= lo && pid < hi) { Ctx P; P.ka = C.ka; P.lds = C.lds; P.NGW = C.NGW; P.NT = C.NT; P.wave = C.wave; unsigned mk_ = ~0u; asm volatile("" : "+s"(P.wave), "+s"(P.ka), "+s"(mk_)); \
        P.lane = (int)__builtin_amdgcn_mbcnt_hi(mk_, __builtin_amdgcn_mbcnt_lo(mk_, 0u)); P.tid = P.wave * 64 + P.lane; P.gw = blockIdx.x * NWAVES + P.wave; P.gtid = blockIdx.x * NTHREADS + P.tid; P.ws = KARG(P, 312, unsigned char*);
#define PH_END } if (pid + 1 < hi) xcd_barrier(bar, P.tid); } ++pid;

    PH_BEGIN if (PH_ON(0)) { phase_prologue(P); PH_END
    for (int layer = 0; layer < NL; ++layer) {
        const bool moe = layer & 1; const int fi = layer >> 1;
        if (!(FUSE_NORM && layer > 0 && !((layer - 1) & 1))) {
        PH_BEGIN if (PH_ON(1)) { phase_norm(P, layer, 0, layer > 0 && ((layer - 1) & 1), false); PH_END
        }
        PH_BEGIN if (PH_ON(2)) { const bf16_t* A = (const bf16_t*)(P.ws + WS_H); g8::DenseOrder S; S.init(A, DM, (const bf16_t*)(P.ws + WS_WIN) + (size_t)layer * INCP * DM, DM, M, INCP, gridDim.x, blockIdx.x);
            g8::EpiStore E{(bf16_t*)(P.ws + WS_U), INCP}; g8::gemm_phase<g8::EpiStore, g8::DenseOrder, false>(P.tid, P.lds, A, DM, DM, S, E); PH_END
        PH_BEGIN if (PH_ON(3)) { phase_conv(P, layer); phase_prep1(P, layer); PH_END
        PH_BEGIN if (PH_ON(4)) { phase_upgemms(P, layer); PH_END
        PH_BEGIN if (PH_ON(5)) { phase_prep2(P, layer); phase_rwkv_chunk(P, layer); PH_END
        PH_BEGIN if (PH_ON(6)) { if (blockIdx.x < NB * RH) phase_rwkv_scan(P); phase_attn2(P, ctl + CW_QH + 64 * layer, layer); PH_END
        PH_BEGIN if (PH_ON(9)) { const bf16_t* A = (const bf16_t*)(P.ws + WS_MIXED); g8::DenseOrder S; S.init(A, DM, (const bf16_t*)(P.ws + WS_WOUT) + (size_t)layer * DM * DM, DM, M, DM, gridDim.x, blockIdx.x);
            { const int rpw_ = (M + P.NGW - 1) / P.NGW; const bool hand = (256 % rpw_ == 0) && (M % rpw_ == 0); unsigned* ro = ctl + CW_RO + layer * 4096;
              phase_rwkv_out(P, layer, hand ? ro : nullptr);
              if (!hand) xcd_barrier(bar, P.tid);
              else { if (P.wave == 0) { g8::Unit u_; for (int i_ = 0; S.next(i_, u_); ++i_) { unsigned sp_ = 0;
                         while ((unsigned)__builtin_amdgcn_readfirstlane(__hip_atomic_load(ro + 64 * u_.pm, __ATOMIC_RELAXED, __HIP_MEMORY_SCOPE_AGENT)) < (unsigned)(256 / rpw_)) {
                             __builtin_amdgcn_s_sleep(1); if (++sp_ > (1u << 22)) { if (P.lane == 0) __hip_atomic_store(ctl + CW_PAN_TMO, 2u, __ATOMIC_RELAXED, __HIP_MEMORY_SCOPE_AGENT); break; } } }
                       __builtin_amdgcn_fence(__ATOMIC_ACQUIRE, "agent"); asm volatile("s_waitcnt vmcnt(0)" ::: "memory"); }
                     __syncthreads(); } }
            if (FUSE_NORM && !moe) {
                g8::EpiResidNorm E{P.ka, P.ws, P.lds, layer, 2, layer, 3, 2 * fi, layer == 0, true};
                g8::gemm_phase<g8::EpiResidNorm, g8::DenseOrder, false>(P.tid, P.lds, A, DM, DM, S, E);
            } else {
            g8::EpiResid E{(layer == 0) ? KARG(P, 8 * I_X, const float*) : (const float*)OUTP(P), OUTP(P), (const float*)(P.ws + WS_COND) + 2 * 1024, KARG(P, 8 * I_ADALB, const float*) + layer * 6144 + 2 * 1024};
            g8::gemm_phase<g8::EpiResid, g8::DenseOrder, false>(P.tid, P.lds, A, DM, DM, S, E); } PH_END
        if (!(FUSE_NORM && !moe)) {
        PH_BEGIN if (PH_ON(10)) { phase_norm(P, layer, 1, false, moe); PH_END
        }
        if (!moe) {
            PH_BEGIN if (PH_ON(11)) { const bf16_t* H = (const bf16_t*)(P.ws + WS_H);
                g8::DenseOrder S; S.init(H, DM, (const bf16_t*)(P.ws + WS_FGU) + (size_t)fi * 2 * FF * DM, DM, M, 2 * FF, gridDim.x, blockIdx.x);
#if DENSE_DN8
                g8::EpiGlu8 E{(unsigned char*)(P.ws + WS_ACT), FF}; g8::gemm_phase<g8::EpiGlu8, g8::DenseOrder, false>(P.tid, P.lds, H, DM, DM, S, E);
#else
                g8::EpiGlu E{(bf16_t*)(P.ws + WS_ACT), FF}; g8::gemm_phase<g8::EpiGlu, g8::DenseOrder, false>(P.tid, P.lds, H, DM, DM, S, E);
#endif
            PH_END
            PH_BEGIN if (PH_ON(12)) { const bf16_t* ACT = (const bf16_t*)(P.ws + WS_ACT);
#if DENSE_DN8
                g8::DenseOrder S; S.init(ACT, FF / 2, (const bf16_t*)(P.ws + WS_FD + (size_t)fi * DM * FF), FF / 2, M, DM, gridDim.x, blockIdx.x);
#if FUSE_NORM
                g8::EpiResidNorm E{P.ka, P.ws, P.lds, layer, 5, layer + 1, 0, 2 * fi + 1, false, false};
                g8::gemm_phase<g8::EpiResidNorm, g8::DenseOrder, false, 0x7C7C7C7Cu>(P.tid, P.lds, ACT, FF / 2, FF / 2, S, E);
#else
                g8::EpiResid E{(const float*)OUTP(P), OUTP(P), (const float*)(P.ws + WS_COND) + 5 * 1024, KARG(P, 8 * I_ADALB, const float*) + layer * 6144 + 5 * 1024};
                g8::gemm_phase<g8::EpiResid, g8::DenseOrder, false, 0x7C7C7C7Cu>(P.tid, P.lds, ACT, FF / 2, FF / 2, S, E);
#endif
#else
                g8::EpiResid E{(const float*)OUTP(P), OUTP(P), (const float*)(P.ws + WS_COND) + 5 * 1024, KARG(P, 8 * I_ADALB, const float*) + layer * 6144 + 5 * 1024};
                g8::DenseOrder S; S.init(ACT, FF, (const bf16_t*)(P.ws + WS_FD) + (size_t)fi * DM * FF, FF, M, DM, gridDim.x, blockIdx.x);
                g8::gemm_phase<g8::EpiResid, g8::DenseOrder, false>(P.tid, P.lds, ACT, FF, FF, S, E);
#endif
            PH_END
        } else {
            PH_BEGIN if (PH_ON(11)) { const unsigned* cnt = ctl + CW_CNT + 16 * fi; moe_tables(P, cnt, 256);
                g8::MoeFusedOrder S; S.init(P, fi);
                g8::EpiGlu8T<16> E1{(unsigned char*)(P.ws + WS_ACT), MFF}; g8::EpiStoreB E2{(bf16_t*)(P.ws + WS_YS), DM};
                g8::gemm_moe_fused<0x7C7C7C7Cu>(P.tid, P.lds, P.ws, S, E1, E2, ctl + CW_PAN + fi * 16384, ctl + CW_PAN_TMO);
                if (layer == 1) late_convert(P, ctl + CW_LATE);
            PH_END
        }
    }
    PH_BEGIN if (PH_ON(13)) { phase_norm(P, NL, 2, true, false); PH_END
#undef PH_BEGIN
#undef PH_END
}

extern "C" void kernel_launch(void* const* d_in, const int* in_sizes, int n_in, void* d_out, int out_size, void* d_ws, size_t ws_size, hipStream_t stream) {
    static int grid = 0;
    if (grid == 0) {
        if (n_in != 38 || out_size != M * DM || ws_size < WS_END) { fprintf(stderr, "kernel_launch: unexpected problem (n_in %d out %d ws %zu need %zu)\n", n_in, out_size, ws_size, (size_t)WS_END); grid = -1; return; }
        int dev = 0, cus = 0, per_cu = 0;
        if (hipGetDevice(&dev) != hipSuccess || hipDeviceGetAttribute(&cus, hipDeviceAttributeMultiprocessorCount, dev) != hipSuccess) { grid = -1; return; }
        if (hipFuncSetAttribute((const void*)mega, hipFuncAttributeMaxDynamicSharedMemorySize, LDS_BYTES) != hipSuccess) { fprintf(stderr, "kernel_launch: hipFuncSetAttribute failed\n"); grid = -1; return; }
        if (hipOccupancyMaxActiveBlocksPerMultiprocessor(&per_cu, (const void*)mega, NTHREADS, LDS_BYTES) != hipSuccess || per_cu < 1) fprintf(stderr, "kernel_launch: occupancy query reports %d\n", per_cu);
        (void)hipGetLastError();
        grid = cus;
    }
    if (grid < 0) return;
    static_assert((size_t)(CW_RO + NL * 4096) * 4 <= 384 * 1024, "control words");
    (void)hipMemsetAsync((char*)d_ws + WS_CTL, 0, 384 * 1024, stream);
    Args a{};
    for (int i = 0; i < 38; ++i) a.in[i] = d_in[i];
    a.out = (float*)d_out; a.ws = (unsigned char*)d_ws;
#if MK_ONE_LAUNCH
    a.ph_lo = 0; a.ph_hi = N_PHASES;
    hipLaunchKernelGGL(mega, dim3(grid), dim3(NTHREADS), LDS_BYTES, stream, a);
#ifdef PROBE_PID
    { const int plist[] = {PROBE_PID}; for (int r = 0; r < PROBE_N; ++r) for (int pi = 0; pi < (int)(sizeof(plist) / sizeof(int)); ++pi) { (void)hipMemsetAsync((char*)d_ws + WS_CTL + (CW_QH + 64 * 3) * 4, 0, 4, stream); a.ph_lo = plist[pi]; a.ph_hi = plist[pi] + 1; hipLaunchKernelGGL(mega, dim3(grid), dim3(NTHREADS), LDS_BYTES, stream, a); } }
#endif
#else
    for (int p = 0; p < N_PHASES; ++p) { a.ph_lo = p; a.ph_hi = p + 1; hipLaunchKernelGGL(mega, dim3(grid), dim3(NTHREADS), LDS_BYTES, stream, a); }
#endif
}
```
